# Optimizing an MI355X kernel written in HIP

```python
import math
import jax, jax.numpy as jnp
from jax import lax
import numpy as np

D_MODEL = 1024
BATCH = 2
SEQ = 8192
DEPTH = 1

MEM_LEN = 256
SSD_EXPAND = 2
SSD_D_INNER = SSD_EXPAND * D_MODEL
SSD_HEAD_DIM = 64
SSD_HEADS = SSD_D_INNER // SSD_HEAD_DIM
SSD_GROUPS = 4
SSD_HEADS_PER_GROUP = SSD_HEADS // SSD_GROUPS
SSD_STATE = 128
SSD_CONV = 4
SSD_CHUNK = 128
SSD_CONV_DIM = SSD_D_INNER + 2 * SSD_GROUPS * SSD_STATE
GMLP_WIDTH = D_MODEL
GMLP_CHUNK = 128
GMLP_GROUPS = 8
GMLP_GROUP_DIM = GMLP_WIDTH // GMLP_GROUPS
MEM_HEADS = 4
MEM_HEAD_DIM = 64
MEM_WIDTH = MEM_HEADS * MEM_HEAD_DIM
D_FF = ((8 * D_MODEL // 3 + 127) // 128) * 128
N_BRANCH = 3
EPS = 1e-6

_IN_SIZES = (SSD_D_INNER, SSD_CONV_DIM, SSD_HEADS, 2 * GMLP_WIDTH, MEM_WIDTH, N_BRANCH * D_MODEL)
IN_WIDTH = sum(_IN_SIZES)
_IN_SPLITS = tuple(sum(_IN_SIZES[:i + 1]) for i in range(len(_IN_SIZES) - 1))

kernel_name = "hybrid_ssd_gmlp_memory_gated_block"


def rmsnorm(x, g):
    xf = x.astype(jnp.float32)
    y = xf * lax.rsqrt(jnp.mean(xf * xf, axis=-1, keepdims=True) + EPS)
    return (y * g.astype(jnp.float32)).astype(x.dtype)


def swiglu(x, w_gate, w_up, w_down):
    return (jax.nn.silu(x @ w_gate) * (x @ w_up)) @ w_down


def causal_dwconv(x, w, b):
    k, c = w.shape
    y = lax.conv_general_dilated(
        x, w[:, None, :].astype(x.dtype), window_strides=(1,), padding=[(k - 1, 0)],
        dimension_numbers=("NWC", "WIO", "NWC"), feature_group_count=c)
    return y + b.astype(x.dtype)


def ssd_chunked(xh, dt, a, bm, cm):
    bsz, s, h, p = xh.shape
    g, n = bm.shape[-2:]
    r = h // g
    l = SSD_CHUNK
    c = s // l
    x = (xh.astype(jnp.float32) * dt[..., None]).reshape(bsz, c, l, g, r, p)
    bm = bm.astype(jnp.float32).reshape(bsz, c, l, g, n)
    cm = cm.astype(jnp.float32).reshape(bsz, c, l, g, n)
    a_cs = jnp.cumsum((dt * a).reshape(bsz, c, l, g, r), axis=2)
    causal = jnp.tril(jnp.ones((l, l), dtype=bool))[:, :, None, None]
    seg = a_cs[:, :, :, None] - a_cs[:, :, None, :]
    decay = jnp.exp(jnp.where(causal, seg, -jnp.inf))
    cb = jnp.einsum("bclgn,bcsgn->bclsg", cm, bm)
    y_diag = jnp.einsum("bclsgr,bcsgrp->bclgrp", cb[..., None] * decay, x)
    decay_to_end = jnp.exp(a_cs[:, :, -1:] - a_cs)
    chunk_states = jnp.einsum("bclgn,bclgrp->bcgrpn", bm, x * decay_to_end[..., None])
    chunk_decay = jnp.exp(a_cs[:, :, -1])

    def step(state, inp):
        dec, st = inp
        return state * dec[..., None, None] + st, state

    init = jnp.zeros((bsz, g, r, p, n), jnp.float32)
    _, prev = lax.scan(step, init, (jnp.moveaxis(chunk_decay, 1, 0), jnp.moveaxis(chunk_states, 1, 0)))
    prev = jnp.moveaxis(prev, 0, 1)
    y_off = jnp.einsum("bclgn,bcgrpn->bclgrp", cm, prev) * jnp.exp(a_cs)[..., None]
    return (y_diag + y_off).reshape(bsz, s, h, p)


def ssd_branch(z, xbc, dt_raw, conv_w, conv_b, dt_bias, a_log, d_skip, norm_g):
    bsz, s, _ = z.shape
    xbc = jax.nn.silu(causal_dwconv(xbc, conv_w, conv_b))
    xs, bm, cm = jnp.split(xbc, (SSD_D_INNER, SSD_D_INNER + SSD_GROUPS * SSD_STATE), axis=-1)
    xh = xs.reshape(bsz, s, SSD_HEADS, SSD_HEAD_DIM)
    bm = bm.reshape(bsz, s, SSD_GROUPS, SSD_STATE)
    cm = cm.reshape(bsz, s, SSD_GROUPS, SSD_STATE)
    dt = jax.nn.softplus(dt_raw.astype(jnp.float32) + dt_bias.astype(jnp.float32))
    a = -jnp.exp(a_log.astype(jnp.float32))
    y = ssd_chunked(xh, dt, a, bm, cm) + d_skip.astype(jnp.float32)[:, None] * xh.astype(jnp.float32)
    yg = (y.reshape(bsz, s, SSD_D_INNER) * jax.nn.silu(z.astype(jnp.float32))).reshape(bsz, s, SSD_GROUPS, -1)
    yg = yg * lax.rsqrt(jnp.mean(yg * yg, axis=-1, keepdims=True) + EPS)
    y = yg.reshape(bsz, s, SSD_D_INNER) * norm_g.astype(jnp.float32)
    return y.astype(z.dtype)


def gmlp_branch(uv, v_norm_g, w_s, b_s):
    bsz, s, _ = uv.shape
    u, v = jnp.split(jax.nn.gelu(uv, approximate=False), 2, axis=-1)
    v = rmsnorm(v, v_norm_g)
    vb = v.reshape(bsz, s // GMLP_CHUNK, GMLP_CHUNK, GMLP_GROUPS, GMLP_GROUP_DIM)
    mask = jnp.tril(jnp.ones((GMLP_CHUNK, GMLP_CHUNK), dtype=bool))
    ws = jnp.where(mask[None], w_s, 0).astype(v.dtype)
    mixed = jnp.einsum("gts,bcsgd->bctgd", ws, vb) + b_s.T.astype(v.dtype)[None, None, :, :, None]
    return u * mixed.reshape(bsz, s, GMLP_WIDTH)


def memory_attention(q, mem_n, w_mem_kv):
    bsz, s, _ = q.shape
    k, v = jnp.split(mem_n @ w_mem_kv, 2, axis=-1)
    q = q.reshape(bsz, s, MEM_HEADS, MEM_HEAD_DIM)
    k = k.reshape(bsz, -1, MEM_HEADS, MEM_HEAD_DIM)
    v = v.reshape(bsz, -1, MEM_HEADS, MEM_HEAD_DIM)
    scores = jnp.einsum("bshd,bmhd->bhsm", q, k).astype(jnp.float32) * (1.0 / math.sqrt(MEM_HEAD_DIM))
    probs = jax.nn.softmax(scores, axis=-1).astype(v.dtype)
    return jnp.einsum("bhsm,bmhd->bshd", probs, v).reshape(bsz, s, MEM_WIDTH)


def setup_inputs(seed: int = 0) -> dict:
    key = jax.random.key(seed)
    ks = iter(jax.random.split(key, 40))

    def nrm(shape, scale):
        return jax.random.normal(next(ks), shape, jnp.float32) * scale

    def gain(shape):
        return 1.0 + nrm(shape, 0.02)

    d = DEPTH
    dt0 = jnp.exp(jax.random.uniform(next(ks), (d, SSD_HEADS), jnp.float32, math.log(1e-3), math.log(1e-1)))
    dt_bias = dt0 + jnp.log(-jnp.expm1(-dt0))
    a_log = jnp.log(jax.random.uniform(next(ks), (d, SSD_HEADS), jnp.float32, 1.0, 16.0))
    return {
        "x": nrm((BATCH, SEQ, D_MODEL), 1.0),
        "mem": nrm((BATCH, MEM_LEN, D_MODEL), 1.0),
        "ffn1_norm": gain((d, D_MODEL)),
        "ffn1_w_gate": nrm((d, D_MODEL, D_FF), D_MODEL ** -0.5),
        "ffn1_w_up": nrm((d, D_MODEL, D_FF), D_MODEL ** -0.5),
        "ffn1_w_down": nrm((d, D_FF, D_MODEL), D_FF ** -0.5),
        "mix_norm": gain((d, D_MODEL)),
        "mem_norm": gain((d, D_MODEL)),
        "w_in": nrm((d, D_MODEL, IN_WIDTH), D_MODEL ** -0.5),
        "ssd_conv_w": nrm((d, SSD_CONV, SSD_CONV_DIM), SSD_CONV ** -0.5),
        "ssd_conv_b": nrm((d, SSD_CONV_DIM), 0.01),
        "ssd_dt_bias": dt_bias,
        "ssd_a_log": a_log,
        "ssd_d": gain((d, SSD_HEADS)),
        "ssd_norm": gain((d, SSD_D_INNER)),
        "gmlp_v_norm": gain((d, GMLP_WIDTH)),
        "gmlp_w_s": nrm((d, GMLP_GROUPS, GMLP_CHUNK, GMLP_CHUNK), GMLP_CHUNK ** -0.5),
        "gmlp_b_s": gain((d, GMLP_GROUPS, GMLP_CHUNK)),
        "w_mem_kv": nrm((d, D_MODEL, 2 * MEM_WIDTH), D_MODEL ** -0.5),
        "w_branch_ssd": nrm((d, SSD_D_INNER, D_MODEL), SSD_D_INNER ** -0.5),
        "w_branch_gmlp": nrm((d, GMLP_WIDTH, D_MODEL), GMLP_WIDTH ** -0.5),
        "w_branch_mem": nrm((d, MEM_WIDTH, D_MODEL), MEM_WIDTH ** -0.5),
        "w_out": nrm((d, D_MODEL, D_MODEL), D_MODEL ** -0.5),
        "ffn2_norm": gain((d, D_MODEL)),
        "ffn2_w_gate": nrm((d, D_MODEL, D_FF), D_MODEL ** -0.5),
        "ffn2_w_up": nrm((d, D_MODEL, D_FF), D_MODEL ** -0.5),
        "ffn2_w_down": nrm((d, D_FF, D_MODEL), D_FF ** -0.5),
        "final_norm": gain((D_MODEL,)),
    }


def reference(x, mem, ffn1_norm, ffn1_w_gate, ffn1_w_up, ffn1_w_down, mix_norm, mem_norm, w_in,
              ssd_conv_w, ssd_conv_b, ssd_dt_bias, ssd_a_log, ssd_d, ssd_norm,
              gmlp_v_norm, gmlp_w_s, gmlp_b_s, w_mem_kv,
              w_branch_ssd, w_branch_gmlp, w_branch_mem, w_out,
              ffn2_norm, ffn2_w_gate, ffn2_w_up, ffn2_w_down, final_norm):
    h = x
    for layer in range(DEPTH):
        h = h + 0.5 * swiglu(rmsnorm(h, ffn1_norm[layer]), ffn1_w_gate[layer], ffn1_w_up[layer], ffn1_w_down[layer])
        n = rmsnorm(h, mix_norm[layer])
        z, xbc, dt_raw, uv, q_mem, gate_logits = jnp.split(n @ w_in[layer], _IN_SPLITS, axis=-1)
        y_ssd = ssd_branch(z, xbc, dt_raw, ssd_conv_w[layer], ssd_conv_b[layer], ssd_dt_bias[layer],
                           ssd_a_log[layer], ssd_d[layer], ssd_norm[layer])
        y_gmlp = gmlp_branch(uv, gmlp_v_norm[layer], gmlp_w_s[layer], gmlp_b_s[layer])
        y_mem = memory_attention(q_mem, rmsnorm(mem, mem_norm[layer]), w_mem_kv[layer])
        g_ssd, g_gmlp, g_mem = jnp.split(jax.nn.sigmoid(gate_logits), N_BRANCH, axis=-1)
        merged = (g_ssd * (y_ssd @ w_branch_ssd[layer])
                  + g_gmlp * (y_gmlp @ w_branch_gmlp[layer])
                  + g_mem * (y_mem @ w_branch_mem[layer]))
        h = h + merged @ w_out[layer]
        h = h + 0.5 * swiglu(rmsnorm(h, ffn2_norm[layer]), ffn2_w_gate[layer], ffn2_w_up[layer], ffn2_w_down[layer])
    return rmsnorm(h, final_norm)
```

```cpp
#include <hip/hip_runtime.h>
#include <hip/hip_cooperative_groups.h>
#include <cstdio>
#include <cstdint>
namespace cg = cooperative_groups;
namespace pg8 {
#define PG8_LAS __attribute__((address_space(3)))
typedef unsigned short bf16_t;
typedef short bf16x8 __attribute__((ext_vector_type(8)));
typedef float f32x4 __attribute__((ext_vector_type(4)));
typedef unsigned u32x4 __attribute__((ext_vector_type(4)));
constexpr int BM = 256, BK = 64, HALF = 128, HTB = HALF * BK * 2  , STAGE_BYTES = 8 * HTB, NXCD = 8, WGM = 8;

__host__ __device__ __forceinline__ int lds_byte(int r, int c) { const int st = (r >> 4) * 2 + (c >> 5), rr = r & 15, cc = c & 31, ob = rr * 64 + cc * 2; return st * 1024 + (ob ^ (((ob >> 9) & 1) << 5)); }
__host__ __device__ __forceinline__ void stage_rc(int b, int& R, int& C) { const int st = b / 1024, sb = b % 1024, swz = sb ^ (((sb >> 9) & 1) << 5); R = (st >> 1) * 16 + swz / 64; C = (st & 1) * 32 + (swz % 64) / 2; }
__host__ __device__ __forceinline__ int perm32(int rho) { const int n = rho >> 4, i = rho & 15; return 8 * (i >> 2) + 4 * n + (i & 3); }

struct Unit { int pm, pn, seg; };
struct Gemm { const bf16_t* A; const bf16_t* Bt; int M, N, K; };

struct StaticOrder {
    int nM, nN, nwg, G, c;
    __host__ __device__ void init(int M, int N, int G_, int c_) { nM = M / BM; nN = N / BM; nwg = nM * nN; G = G_; c = c_; }
    __host__ __device__ bool next(int i, Unit& u) const {
        const long L = (long)i * G + c; if (L >= nwg) return false;
        int wgid = (int)L; { const int q = nwg / NXCD, r = nwg % NXCD, xcd = wgid % NXCD, off = wgid / NXCD; wgid = (xcd < r ? xcd * (q + 1) : r * (q + 1) + (xcd - r) * q) + off; }
        const int nig = WGM * nN, gid = wgid / nig, fm = gid * WGM, gsz = (nM - fm) < WGM ? (nM - fm) : WGM;
        u.pm = fm + ((wgid % nig) % gsz); u.pn = (wgid % nig) / gsz; u.seg = 0; return true;
    }
    __device__ __forceinline__ void a_ready(const Unit&) const {}
    __device__ __forceinline__ void done(const Unit&) const {}
};

template <int NSEG> struct SegOrder {
    StaticOrder base;
    __host__ __device__ void init(int M, int N, int G_, int c_) { base.init(M, N, G_, c_); }
    __host__ __device__ bool next(int i, Unit& u) const { if (!base.next(i / NSEG, u)) return false; u.seg = i % NSEG; return true; }
    __device__ __forceinline__ void a_ready(const Unit&) const {}
    __device__ __forceinline__ void done(const Unit&) const {}
};
__device__ __forceinline__ unsigned cvt_pk_bf16(float lo, float hi) { unsigned r; asm volatile("v_cvt_pk_bf16_f32 %0, %1, %2" : "=v"(r) : "v"(lo), "v"(hi)); return r; }
typedef float f32x2 __attribute__((ext_vector_type(2)));
__device__ __forceinline__ f32x2 gelu_pk(f32x2 v) {
    const f32x2 av = __builtin_elementwise_abs(v), d = av * 0.2316418882f + 1.0f;
    f32x2 t; t.x = __builtin_amdgcn_rcpf(d.x); t.y = __builtin_amdgcn_rcpf(d.y);
    f32x2 q = t * 0.5307027145f + (-0.7265760135f); q = q * t + 0.7107068705f; q = q * t + (-0.142248368f); q = q * t + 0.127414796f; q = q * t;
    const f32x2 s = (v * v) * (-0.72134752044f);
    f32x2 e; e.x = __builtin_amdgcn_exp2f(s.x); e.y = __builtin_amdgcn_exp2f(s.y);
    const f32x2 m = v * (q * e), r = v - m;
    f32x2 o; o.x = v.x < 0.f ? m.x : r.x; o.y = v.y < 0.f ? m.y : r.y; return o;
}
template <class Epi, class Sched, bool ALIGN_EPI = false, bool SP2 = false>
__device__ __forceinline__ void gemm_phase(PG8_LAS unsigned char* lds, const Gemm g, const Sched& S, const Epi& E) {
    int tid_ = threadIdx.x; asm volatile("" : "+v"(tid_)); const int tid = tid_, wid = __builtin_amdgcn_readfirstlane(tid >> 6), lane = tid & 63, wr = wid >> 2, wc = wid & 3, fr = lane & 15, fq = lane >> 4;
    const int K = g.K; int nt = K / BK;
    unsigned voffA[2], voffB[2];
#pragma unroll
    for (int i = 0; i < 2; ++i) { int R, C; stage_rc(tid * 16 + i * 8192, R, C); const int Rb = Epi::PERM ? ((R & ~31) + perm32(R & 31)) : R;
        voffA[i] = (unsigned)(R * K + C) * 2u; voffB[i] = (unsigned)(Rb * K + C) * 2u; }
    const size_t kstep = (size_t)(BK * 2);
    const size_t hstep = (size_t)HALF * K * 2;
    const size_t tstep = 2 * hstep;
    const unsigned ldsw = (unsigned)wid * 1024u;
    const int aoff = lds_byte(wr * 64 + fr, fq * 8), boff = lds_byte(wc * 32 + fr, fq * 8);
#define PG8_SA(b, h) (((b) * 2 + (h)) * HTB)
#define PG8_SB(b, h) ((4 + (b) * 2 + (h)) * HTB)
#define PG8_STAGE(bufoff, gbase, voff) do { _Pragma("unroll") for (int _i = 0; _i < 2; ++_i) \
        __builtin_amdgcn_global_load_lds((const unsigned*)((const char*)(gbase) + (voff)[_i]), (PG8_LAS unsigned*)(lds + (bufoff) + ldsw + _i * 8192), 16, 0, 0); } while (0)
#define PG8_LDA(dst, b, h) do { _Pragma("unroll") for (int m = 0; m < 4; ++m) _Pragma("unroll") for (int k = 0; k < 2; ++k) dst[m][k] = *(const PG8_LAS bf16x8*)(lds + PG8_SA(b, h) + aoff + m * 2048 + k * 1024); } while (0)
#define PG8_LDB(dst, b, h) do { _Pragma("unroll") for (int n = 0; n < 2; ++n) _Pragma("unroll") for (int k = 0; k < 2; ++k) dst[n][k] = *(const PG8_LAS bf16x8*)(lds + PG8_SB(b, h) + boff + n * 2048 + k * 1024); } while (0)
#define PG8_MMA(ai, bj, At, Bt) do { __builtin_amdgcn_s_setprio(1); _Pragma("unroll") for (int m = 0; m < 4; ++m) _Pragma("unroll") for (int n = 0; n < 2; ++n) _Pragma("unroll") for (int k = 0; k < 2; ++k) \
        acc[ai][bj][m][n] = __builtin_amdgcn_mfma_f32_16x16x32_bf16(Bt[n][k], At[m][k], acc[ai][bj][m][n], 0, 0, 0); __builtin_amdgcn_s_setprio(0); } while (0)
#define PG8_WAIT_V(n) asm volatile("s_waitcnt vmcnt(" #n ")" ::: "memory")
#define PG8_WAIT_L(n) asm volatile("s_waitcnt lgkmcnt(" #n ")" ::: "memory")
#define PG8_BAR __builtin_amdgcn_s_barrier()
#define PG8_SCHED __builtin_amdgcn_sched_barrier(0)
    Unit cur, nxt; int ui = 0;
    if (!S.next(0, cur)) return;
    f32x4 acc[2][2][4][2];
#pragma unroll
    for (int a = 0; a < 2; ++a)
#pragma unroll
        for (int b = 0; b < 2; ++b)
#pragma unroll
            for (int m = 0; m < 4; ++m)
#pragma unroll
                for (int n = 0; n < 2; ++n) acc[a][b][m][n] = (f32x4){0.f, 0.f, 0.f, 0.f};
    bf16x8 At[4][2], B0[2][2], B1[2][2];
    const char* cA = (const char*)g.A + (size_t)cur.pm * tstep; const char* cB = (const char*)g.Bt + (size_t)cur.pn * tstep;
    if constexpr (Epi::NSEG > 1) { cA += (size_t)Epi::seg_koff(cur.seg) * 2; cB += (size_t)Epi::seg_koff(cur.seg) * 2; nt = Epi::seg_nt(cur.seg); }
    S.a_ready(cur);
    if constexpr (SP2) {
        PG8_STAGE(PG8_SB(0, 0), cB, voffB); PG8_STAGE(PG8_SB(0, 1), cB + hstep, voffB); PG8_STAGE(PG8_SA(0, 0), cA, voffA); PG8_STAGE(PG8_SA(0, 1), cA + hstep, voffA);
        if (wr == 1) PG8_BAR;
        PG8_WAIT_V(2); PG8_BAR;
        PG8_STAGE(PG8_SB(1, 0), cB + kstep, voffB); PG8_STAGE(PG8_SA(1, 0), cA + kstep, voffA); PG8_STAGE(PG8_SB(1, 1), cB + hstep + kstep, voffB);
        PG8_WAIT_V(6); PG8_BAR;
    } else {
        PG8_STAGE(PG8_SB(0, 0), cB, voffB); PG8_STAGE(PG8_SA(0, 0), cA, voffA); PG8_STAGE(PG8_SB(0, 1), cB + hstep, voffB); PG8_STAGE(PG8_SA(0, 1), cA + hstep, voffA);
        if (wr == 1) PG8_BAR;
        PG8_WAIT_V(4); PG8_BAR;
        PG8_STAGE(PG8_SB(1, 0), cB + kstep, voffB); PG8_STAGE(PG8_SA(1, 0), cA + kstep, voffA); PG8_STAGE(PG8_SB(1, 1), cB + hstep + kstep, voffB);
        PG8_WAIT_V(6); PG8_BAR;
    }
    for (;;) {
        const bool has_next = S.next(ui + 1, nxt);
        const char* nA = has_next ? (const char*)g.A + (size_t)nxt.pm * tstep : cA; const char* nB = has_next ? (const char*)g.Bt + (size_t)nxt.pn * tstep : cB;
        if constexpr (Epi::NSEG > 1) { if (has_next) { nA += (size_t)Epi::seg_koff(nxt.seg) * 2; nB += (size_t)Epi::seg_koff(nxt.seg) * 2; } }
        for (int t = 0; t < nt; t += 2) {
            const bool last = (t == nt - 2);
            const char* a1 = cA + (size_t)(t + 1) * kstep;
            const char* a2 = last ? nA : cA + (size_t)(t + 2) * kstep; const char* b2 = last ? nB : cB + (size_t)(t + 2) * kstep;
            const char* a3 = a2 + kstep; const char* b3 = b2 + kstep;
            if (last && has_next) S.a_ready(nxt);
            if constexpr (SP2) {
            PG8_LDB(B0, 0, 0); PG8_LDB(B1, 0, 1); PG8_SCHED; PG8_LDA(At, 0, 0); PG8_STAGE(PG8_SA(1, 1), a1 + hstep, voffA);
            PG8_WAIT_V(8); PG8_WAIT_L(0); PG8_BAR; PG8_MMA(0, 0, At, B0); PG8_MMA(0, 1, At, B1); PG8_BAR; PG8_SCHED;
            PG8_LDA(At, 0, 1); PG8_STAGE(PG8_SB(0, 0), b2, voffB); PG8_STAGE(PG8_SB(0, 1), b2 + hstep, voffB); PG8_STAGE(PG8_SA(0, 0), a2, voffA);
            PG8_WAIT_V(8); PG8_WAIT_L(0); PG8_BAR; PG8_MMA(1, 0, At, B0); PG8_MMA(1, 1, At, B1); PG8_BAR; PG8_SCHED;
            PG8_LDB(B0, 1, 0); PG8_LDB(B1, 1, 1); PG8_SCHED; PG8_LDA(At, 1, 0); PG8_STAGE(PG8_SA(0, 1), a2 + hstep, voffA);
            PG8_WAIT_V(8); PG8_WAIT_L(0); PG8_BAR; PG8_MMA(0, 0, At, B0); PG8_MMA(0, 1, At, B1); PG8_BAR; PG8_SCHED;
            PG8_LDA(At, 1, 1); PG8_STAGE(PG8_SB(1, 0), b3, voffB); PG8_STAGE(PG8_SB(1, 1), b3 + hstep, voffB); PG8_STAGE(PG8_SA(1, 0), a3, voffA);
            PG8_WAIT_V(8); PG8_WAIT_L(0); PG8_BAR; PG8_MMA(1, 0, At, B0); PG8_MMA(1, 1, At, B1); PG8_BAR; PG8_SCHED;
            } else {
            PG8_LDB(B0, 0, 0); PG8_SCHED; PG8_LDA(At, 0, 0); PG8_STAGE(PG8_SA(1, 1), a1 + hstep, voffA);
            PG8_WAIT_L(8); PG8_BAR; PG8_WAIT_L(0); PG8_MMA(0, 0, At, B0); PG8_BAR; PG8_SCHED;
            PG8_LDB(B1, 0, 1); PG8_STAGE(PG8_SB(0, 0), b2, voffB);
            PG8_BAR; PG8_WAIT_L(0); PG8_MMA(0, 1, At, B1); PG8_BAR;
            PG8_LDA(At, 0, 1); PG8_STAGE(PG8_SA(0, 0), a2, voffA);
            PG8_BAR; PG8_WAIT_L(0); PG8_MMA(1, 0, At, B0); PG8_BAR; PG8_SCHED;
            PG8_STAGE(PG8_SB(0, 1), b2 + hstep, voffB);
            PG8_WAIT_V(6); PG8_BAR; PG8_MMA(1, 1, At, B1); PG8_BAR;
            PG8_LDB(B0, 1, 0); PG8_SCHED; PG8_LDA(At, 1, 0); PG8_STAGE(PG8_SA(0, 1), a2 + hstep, voffA);
            PG8_WAIT_L(8); PG8_BAR; PG8_WAIT_L(0); PG8_MMA(0, 0, At, B0); PG8_BAR; PG8_SCHED;
            PG8_LDB(B1, 1, 1); PG8_STAGE(PG8_SB(1, 0), b3, voffB);
            PG8_BAR; PG8_WAIT_L(0); PG8_MMA(0, 1, At, B1); PG8_BAR;
            PG8_LDA(At, 1, 1); PG8_STAGE(PG8_SA(1, 0), a3, voffA);
            PG8_BAR; PG8_WAIT_L(0); PG8_MMA(1, 0, At, B0); PG8_BAR; PG8_SCHED;
            PG8_STAGE(PG8_SB(1, 1), b3 + hstep, voffB);
            PG8_WAIT_V(6); PG8_BAR; PG8_MMA(1, 1, At, B1); PG8_BAR;
            }
        }
        if constexpr (ALIGN_EPI) { if (wr == 0) PG8_BAR; }
        bool lastseg = true; if constexpr (Epi::NSEG > 1) lastseg = (cur.seg == Epi::NSEG - 1);
        if constexpr (!Epi::AFTER_DRAIN) { if (lastseg) { E(acc, cur, wr, wc, fr, fq); S.done(cur); } else { if constexpr (Epi::NSEG > 1) E.seg(acc, cur, wr, wc, fr, fq); } }
        if (!has_next) break;
#pragma unroll
        for (int a = 0; a < 2; ++a)
#pragma unroll
            for (int b = 0; b < 2; ++b)
#pragma unroll
                for (int m = 0; m < 4; ++m)
#pragma unroll
                    for (int n = 0; n < 2; ++n) acc[a][b][m][n] = (f32x4){0.f, 0.f, 0.f, 0.f};
        cur = nxt; cA = nA; cB = nB; ++ui; if constexpr (Epi::NSEG > 1) nt = Epi::seg_nt(cur.seg);
        if constexpr (ALIGN_EPI) { if (wr == 1) PG8_BAR; }
    }
    PG8_WAIT_V(0);
    if constexpr (!ALIGN_EPI) { if (wr == 0) PG8_BAR; }
    PG8_BAR;
    if constexpr (Epi::AFTER_DRAIN) { E.fused(acc, cur, wr, wc, fr, fq, lds, wid, lane); S.done(cur); }
#undef PG8_SA
#undef PG8_SB
#undef PG8_STAGE
#undef PG8_LDA
#undef PG8_LDB
#undef PG8_MMA
#undef PG8_WAIT_V
#undef PG8_WAIT_L
#undef PG8_BAR
#undef PG8_SCHED
}
}

#define DI __device__ __forceinline__
#define LAS __attribute__((address_space(3)))
using pg8::bf16_t; using pg8::bf16x8; using pg8::f32x4; using pg8::u32x4; using pg8::Unit; using pg8::f32x2; using pg8::gelu_pk;
typedef __bf16 bf16x2_t __attribute__((ext_vector_type(2)));
__device__ __forceinline__ unsigned cvt_pk_bf16(float lo, float hi) { f32x2 v = {lo, hi}; bf16x2_t b = __builtin_convertvector(v, bf16x2_t); return __builtin_bit_cast(unsigned, b); }
typedef LAS unsigned char* lptr;
typedef unsigned u32x2 __attribute__((ext_vector_type(2)));
#define MFMA16(a, b, c) __builtin_amdgcn_mfma_f32_16x16x32_bf16((a), (b), (c), 0, 0, 0)

constexpr int T = 16384, TB = 8192, DM = 1024, FF = 2816;
constexpr float EPS = 1e-6f;
constexpr int ZUQ_LD = 3328, XBC_LD = 3072, NWIN = 7680, GATE_LD = 3072, KBR = 3328, WIN_LD = 10528;
constexpr float QSCALE = 0.125f * 1.4426950408889634f;
constexpr int PT = 272;
constexpr int LDS_BYTES = 155648;

constexpr size_t KiB = 1024, MiB = 1u << 20;
constexpr size_t WS_SS1 = 0, WS_SS2 = 64 * KiB, WS_SS3 = 128 * KiB, WS_SS4 = 192 * KiB, WS_SSV = 256 * KiB, WS_SSG = 320 * KiB  , WS_CDEC = 576 * KiB  ;
constexpr size_t WS_KMEM = 640 * KiB, WS_VMEMT = 896 * KiB, WS_DT = 2 * MiB;
constexpr size_t WS_W2GU = 6 * MiB, WS_W2D = 17 * MiB, WS_WIN = 22 * MiB + 512 * KiB, WS_WG = 37 * MiB + 512 * KiB, WS_WBR = 43 * MiB + 512 * KiB, WS_WOUT = 50 * MiB;
constexpr size_t WS_HB = 52 * MiB, WS_MG = 84 * MiB, WS_W1GU = 116 * MiB, WS_W1D = 127 * MiB, WS_ACT = 132 * MiB + 512 * KiB;
constexpr size_t WS_ZUQ = 116 * MiB, WS_XBC = 168 * MiB, WS_ST = 216 * MiB, WS_END = 256 * MiB;
static_assert(WS_ACT + (size_t)T * FF * 2 <= WS_END && WS_ST + (size_t)64 * 32 * 8192 * 2 <= WS_END && WS_ZUQ + (size_t)TB * ZUQ_LD * 2 <= WS_XBC && WS_XBC + (size_t)TB * XBC_LD * 2 <= WS_ST, "ws map");

DI float bflo(unsigned w) { return __uint_as_float(w << 16); }
DI float bfhi(unsigned w) { return __uint_as_float(w & 0xffff0000u); }
DI float sigm(float x) { return __builtin_amdgcn_rcpf(1.f + __expf(-x)); }
DI float silu(float x) { return x * sigm(x); }
DI u32x4 pack8(f32x4 a, f32x4 b) { u32x4 w; w.x = cvt_pk_bf16(a[0], a[1]); w.y = cvt_pk_bf16(a[2], a[3]); w.z = cvt_pk_bf16(b[0], b[1]); w.w = cvt_pk_bf16(b[2], b[3]); return w; }
DI u32x2 pack4(f32x4 a) { u32x2 w; w.x = cvt_pk_bf16(a[0], a[1]); w.y = cvt_pk_bf16(a[2], a[3]); return w; }
DI f32x4 gelu4(f32x4 v) { f32x2 a = gelu_pk((f32x2){v[0], v[1]}), b = gelu_pk((f32x2){v[2], v[3]}); return (f32x4){a.x, a.y, b.x, b.y}; }
DI float rstd_of(float ss, float inv_n) { return __builtin_amdgcn_rsqf(ss * inv_n + EPS); }
DI float softplus(float v) { return v > 20.f ? v : log1pf(__expf(v)); }

struct EpiGLU {
    static constexpr bool PERM = true, AFTER_DRAIN = false; static constexpr int NSEG = 1;
    const float* ss; bf16_t* O;
    DI void operator()(const f32x4 (&acc)[2][2][4][2], const Unit& u, int wr, int wc, int fr, int fq) const {
        const int col = u.pn * 128 + wc * 32 + 8 * fq;
#pragma unroll
        for (int ai = 0; ai < 2; ++ai)
#pragma unroll
            for (int m = 0; m < 4; ++m) {
                const int row = u.pm * 256 + ai * 128 + wr * 64 + m * 16 + fr;
                const float r = rstd_of(ss[row], 1.f / 1024.f);
                f32x4 o[2];
#pragma unroll
                for (int n = 0; n < 2; ++n)
#pragma unroll
                    for (int e = 0; e < 4; ++e) o[n][e] = silu(acc[ai][0][m][n][e] * r) * (acc[ai][1][m][n][e] * r);
                *(u32x4*)(O + (size_t)row * FF + col) = pack8(o[0], o[1]);
            }
    }
};
struct EpiRes {
    static constexpr bool PERM = true, AFTER_DRAIN = false; static constexpr int NSEG = 1;
    const float* resid; float* hout; bf16_t* hb; float* ssout; float alpha;
    DI void operator()(const f32x4 (&acc)[2][2][4][2], const Unit& u, int wr, int wc, int fr, int fq) const {
#pragma unroll
        for (int ai = 0; ai < 2; ++ai)
#pragma unroll
            for (int m = 0; m < 4; ++m) {
                const int row = u.pm * 256 + ai * 128 + wr * 64 + m * 16 + fr;
                float sq = 0.f;
#pragma unroll
                for (int bj = 0; bj < 2; ++bj) {
                    const size_t off = (size_t)row * DM + u.pn * 256 + bj * 128 + wc * 32 + 8 * fq;
                    f32x4 v0 = *(const f32x4*)(resid + off) + acc[ai][bj][m][0] * alpha, v1 = *(const f32x4*)(resid + off + 4) + acc[ai][bj][m][1] * alpha;
                    *(f32x4*)(hout + off) = v0; *(f32x4*)(hout + off + 4) = v1;
                    if (hb) *(u32x4*)(hb + off) = pack8(v0, v1);
                    sq += (v0[0] * v0[0] + v0[1] * v0[1]) + (v0[2] * v0[2] + v0[3] * v0[3]) + (v1[0] * v1[0] + v1[1] * v1[1]) + (v1[2] * v1[2] + v1[3] * v1[3]);
                }
                sq += __shfl_xor(sq, 16); sq += __shfl_xor(sq, 32);
                if (fq == 0) atomicAdd(ssout + row, sq);
            }
    }
};
struct EpiWin {
    static constexpr bool PERM = true, AFTER_DRAIN = false; static constexpr int NSEG = 1;
    int row_base; const float* ss; bf16_t* zuq; bf16_t* xbc; bf16_t* gv; float* dt; const float* dt_bias; float* ssv;
    DI void operator()(const f32x4 (&acc)[2][2][4][2], const Unit& u, int wr, int wc, int fr, int fq) const {
        const int pn = u.pn, cw = wc * 32 + 8 * fq;
#pragma unroll
        for (int ai = 0; ai < 2; ++ai)
#pragma unroll
            for (int m = 0; m < 4; ++m) {
                const int lr = u.pm * 256 + ai * 128 + wr * 64 + m * 16 + fr, gr = row_base + lr;
                const float r = rstd_of(ss[gr], 1.f / 1024.f);
                if (pn < 8) {
#pragma unroll
                    for (int bj = 0; bj < 2; ++bj) { f32x4 a, b;
#pragma unroll
                        for (int e = 0; e < 4; ++e) { a[e] = silu(acc[ai][bj][m][0][e] * r); b[e] = silu(acc[ai][bj][m][1][e] * r); }
                        *(u32x4*)(zuq + (size_t)lr * ZUQ_LD + pn * 256 + bj * 128 + cw) = pack8(a, b); }
                } else if (pn < 12) {
#pragma unroll
                    for (int bj = 0; bj < 2; ++bj) { f32x4 a = gelu4(acc[ai][bj][m][0] * r), b = gelu4(acc[ai][bj][m][1] * r);
                        *(u32x4*)(zuq + (size_t)lr * ZUQ_LD + pn * 256 + bj * 128 + cw) = pack8(a, b); }
                } else if (pn == 12) {
#pragma unroll
                    for (int bj = 0; bj < 2; ++bj) { f32x4 a = acc[ai][bj][m][0] * (r * QSCALE), b = acc[ai][bj][m][1] * (r * QSCALE);
                        *(u32x4*)(zuq + (size_t)lr * ZUQ_LD + pn * 256 + bj * 128 + cw) = pack8(a, b); }
                } else if (pn < 25) {
#pragma unroll
                    for (int bj = 0; bj < 2; ++bj) { f32x4 a = acc[ai][bj][m][0] * r, b = acc[ai][bj][m][1] * r;
                        *(u32x4*)(xbc + (size_t)lr * XBC_LD + (pn - 13) * 256 + bj * 128 + cw) = pack8(a, b); }
                } else if (pn < 29) {
                    float sq = 0.f;
#pragma unroll
                    for (int bj = 0; bj < 2; ++bj) { f32x4 a = gelu4(acc[ai][bj][m][0] * r), b = gelu4(acc[ai][bj][m][1] * r);
                        sq += (a[0] * a[0] + a[1] * a[1]) + (a[2] * a[2] + a[3] * a[3]) + (b[0] * b[0] + b[1] * b[1]) + (b[2] * b[2] + b[3] * b[3]);
                        *(u32x4*)(gv + (size_t)lr * DM + (pn - 25) * 256 + bj * 128 + cw) = pack8(a, b); }
                    sq += __shfl_xor(sq, 16); sq += __shfl_xor(sq, 32);
                    if (fq == 0) atomicAdd(ssv + gr, sq);
                } else {
                    if (wc == 0) {
#pragma unroll
                        for (int n = 0; n < 2; ++n) { f32x4 o;
#pragma unroll
                            for (int e = 0; e < 4; ++e) o[e] = softplus(acc[ai][0][m][n][e] * r + dt_bias[8 * fq + 4 * n + e]);
                            *(f32x4*)(dt + (size_t)gr * 32 + 8 * fq + 4 * n) = o; }
                    }
                }
            }
    }
};
struct EpiGates {
    static constexpr bool PERM = true, AFTER_DRAIN = false; static constexpr int NSEG = 1;
    int row_base; const float* ss; bf16_t* O;
    DI void operator()(const f32x4 (&acc)[2][2][4][2], const Unit& u, int wr, int wc, int fr, int fq) const {
#pragma unroll
        for (int ai = 0; ai < 2; ++ai)
#pragma unroll
            for (int m = 0; m < 4; ++m) {
                const int lr = u.pm * 256 + ai * 128 + wr * 64 + m * 16 + fr;
                const float r = rstd_of(ss[row_base + lr], 1.f / 1024.f);
#pragma unroll
                for (int bj = 0; bj < 2; ++bj) { f32x4 a, b;
#pragma unroll
                    for (int e = 0; e < 4; ++e) { a[e] = sigm(acc[ai][bj][m][0][e] * r); b[e] = sigm(acc[ai][bj][m][1][e] * r); }
                    *(u32x4*)(O + (size_t)lr * GATE_LD + u.pn * 256 + bj * 128 + wc * 32 + 8 * fq) = pack8(a, b); }
            }
    }
};
struct EpiMerge {
    static constexpr bool PERM = true, AFTER_DRAIN = false; static constexpr int NSEG = 3;
    const bf16_t* gates; float* run; bf16_t* O;
    static DI int seg_koff(int s) { return s == 0 ? 0 : (s == 1 ? 2048 : 3072); }
    static DI int seg_nt(int s) { return s == 0 ? 32 : (s == 1 ? 16 : 4); }
    DI void seg(const f32x4 (&acc)[2][2][4][2], const Unit& u, int wr, int wc, int fr, int fq) const {
        const int row0 = u.pm * 256 + wr * 64 + fr, cw = u.pn * 256 + wc * 32 + 8 * fq, s = u.seg;
#pragma unroll
        for (int ai = 0; ai < 2; ++ai)
#pragma unroll
            for (int m = 0; m < 4; ++m) {
                const int row = row0 + ai * 128 + m * 16;
#pragma unroll
                for (int bj = 0; bj < 2; ++bj) {
                    const u32x4 G = *(const u32x4*)(gates + (size_t)row * GATE_LD + s * 1024 + cw + bj * 128);
                    float* rp = run + (size_t)row * DM + cw + bj * 128;
                    f32x4 a = (f32x4){0.f, 0.f, 0.f, 0.f}, b = a;
                    if (s > 0) { a = *(const f32x4*)rp; b = *(const f32x4*)(rp + 4); }
                    a[0] += acc[ai][bj][m][0][0] * bflo(G[0]); a[1] += acc[ai][bj][m][0][1] * bfhi(G[0]); a[2] += acc[ai][bj][m][0][2] * bflo(G[1]); a[3] += acc[ai][bj][m][0][3] * bfhi(G[1]);
                    b[0] += acc[ai][bj][m][1][0] * bflo(G[2]); b[1] += acc[ai][bj][m][1][1] * bfhi(G[2]); b[2] += acc[ai][bj][m][1][2] * bflo(G[3]); b[3] += acc[ai][bj][m][1][3] * bfhi(G[3]);
                    *(f32x4*)rp = a; *(f32x4*)(rp + 4) = b;
                }
            }
    }
    DI void operator()(const f32x4 (&acc)[2][2][4][2], const Unit& u, int wr, int wc, int fr, int fq) const {
        const int row0 = u.pm * 256 + wr * 64 + fr, cw = u.pn * 256 + wc * 32 + 8 * fq;
#pragma unroll
        for (int ai = 0; ai < 2; ++ai)
#pragma unroll
            for (int m = 0; m < 4; ++m) {
                const int row = row0 + ai * 128 + m * 16;
#pragma unroll
                for (int bj = 0; bj < 2; ++bj) {
                    const u32x4 G = *(const u32x4*)(gates + (size_t)row * GATE_LD + 2048 + cw + bj * 128);
                    const float* rp = run + (size_t)row * DM + cw + bj * 128;
                    f32x4 a = *(const f32x4*)rp, b = *(const f32x4*)(rp + 4);
                    a[0] += acc[ai][bj][m][0][0] * bflo(G[0]); a[1] += acc[ai][bj][m][0][1] * bfhi(G[0]); a[2] += acc[ai][bj][m][0][2] * bflo(G[1]); a[3] += acc[ai][bj][m][0][3] * bfhi(G[1]);
                    b[0] += acc[ai][bj][m][1][0] * bflo(G[2]); b[1] += acc[ai][bj][m][1][1] * bfhi(G[2]); b[2] += acc[ai][bj][m][1][2] * bflo(G[3]); b[3] += acc[ai][bj][m][1][3] * bfhi(G[3]);
                    *(u32x4*)(O + (size_t)row * DM + cw + bj * 128) = pack8(a, b);
                }
            }
    }
};

struct Frame {
    lptr lds; unsigned char* ws; const float* const* in; float* out;
    int tid, lane, wave, G, bid;
};
struct Args { const float* in[28]; float* out; unsigned char* ws; int ph_lo, ph_hi; };
enum { I_X = 0, I_MEM, I_F1N, I_F1G, I_F1U, I_F1D, I_MIXN, I_MEMN, I_WIN, I_CONVW, I_CONVB, I_DTB, I_ALOG, I_SSDD, I_SSDN, I_GVN, I_GWS, I_GBS, I_WKV, I_WBS, I_WBG, I_WBM, I_WOUT, I_F2N, I_F2G, I_F2U, I_F2D, I_FINN };

#define LDS_WAIT() asm volatile("s_waitcnt lgkmcnt(0)" ::: "memory")

DI void tr_item(const float* W, int ldw, int col0, bf16_t* WT, int ldt, int dcol0, int drow0, const float* gain, LAS float* scr, int kb, int lane) {
    const int k0 = 64 * kb;
#pragma unroll 8
    for (int i = 0; i < 32; ++i) { const int kk = 2 * i + (lane >> 5); float v = W[(size_t)(k0 + kk) * ldw + col0 + (lane & 31)]; if (gain) v *= gain[k0 + kk]; scr[kk * 33 + (lane & 31)] = v; }
    LDS_WAIT();
    const int c = lane & 7;
#pragma unroll
    for (int j = 0; j < 4; ++j) { const int n = (lane >> 3) + 8 * j; const LAS float* s = scr + (8 * c) * 33 + n;
        u32x4 o; o.x = cvt_pk_bf16(s[0 * 33], s[1 * 33]); o.y = cvt_pk_bf16(s[2 * 33], s[3 * 33]); o.z = cvt_pk_bf16(s[4 * 33], s[5 * 33]); o.w = cvt_pk_bf16(s[6 * 33], s[7 * 33]);
        *(u32x4*)(WT + (size_t)(drow0 + n) * ldt + dcol0 + k0 + 8 * c) = o; }
    LDS_WAIT();
}
DI void kv_item(const Frame& F, int item) {
    const int rt = item >> 3, ct = item & 7, r0 = rt * 64, c0 = ct * 64, tid = F.tid, lane = F.lane, w = F.wave, fr = lane & 15, fq = lane >> 4;
    lptr As = F.lds, Bs = F.lds + 9216; LAS float* rs = (LAS float*)(F.lds + 18432);
    const float* mem = F.in[I_MEM]; const float* W = F.in[I_WKV]; const float* gain = F.in[I_MEMN];
    bf16_t* Kmem = (bf16_t*)(F.ws + WS_KMEM); bf16_t* VmemT = (bf16_t*)(F.ws + WS_VMEMT);
    const int ar = tid >> 3, ks8 = (tid & 7) * 8;
    float sq = 0.f;
    f32x4 acc[2]; acc[0] = (f32x4){0.f, 0.f, 0.f, 0.f}; acc[1] = acc[0];
    const bool ktype = ct < 4;
    for (int kc = 0; kc < 16; ++kc) {
        { const float* p = mem + (size_t)(r0 + ar) * 1024 + kc * 64 + ks8; const f32x4 v0 = *(const f32x4*)p, v1 = *(const f32x4*)(p + 4);
          sq += (v0[0] * v0[0] + v0[1] * v0[1]) + (v0[2] * v0[2] + v0[3] * v0[3]) + (v1[0] * v1[0] + v1[1] * v1[1]) + (v1[2] * v1[2] + v1[3] * v1[3]);
          *(LAS u32x4*)(As + ar * 144 + ks8 * 2) = pack8(v0, v1); }
        { const int k = ar; const float g = gain[kc * 64 + k]; const float* p = W + (size_t)(kc * 64 + k) * 512 + c0 + ks8; const f32x4 v0 = *(const f32x4*)p * g, v1 = *(const f32x4*)(p + 4) * g;
          const u32x4 pk = pack8(v0, v1);
#pragma unroll
          for (int i = 0; i < 8; ++i) { const unsigned short hv = (unsigned short)((i & 1) ? (pk[i >> 1] >> 16) : (pk[i >> 1] & 0xffffu)); *(LAS unsigned short*)(Bs + (ks8 + i) * 144 + k * 2) = hv; } }
        __syncthreads();
#pragma unroll
        for (int ks = 0; ks < 2; ++ks) {
            if (ktype) { const bf16x8 yf = *(const LAS bf16x8*)(As + (16 * (w >> 1) + fr) * 144 + ks * 64 + fq * 16);
#pragma unroll
                for (int i = 0; i < 2; ++i) { const bf16x8 xf = *(const LAS bf16x8*)(Bs + (16 * ((w & 1) * 2 + i) + fr) * 144 + ks * 64 + fq * 16); acc[i] = MFMA16(xf, yf, acc[i]); } }
            else { const bf16x8 yf = *(const LAS bf16x8*)(Bs + (16 * (w >> 1) + fr) * 144 + ks * 64 + fq * 16);
#pragma unroll
                for (int i = 0; i < 2; ++i) { const bf16x8 xf = *(const LAS bf16x8*)(As + (16 * ((w & 1) * 2 + i) + fr) * 144 + ks * 64 + fq * 16); acc[i] = MFMA16(xf, yf, acc[i]); } }
        }
        __syncthreads();
    }
    sq += __shfl_xor(sq, 1); sq += __shfl_xor(sq, 2); sq += __shfl_xor(sq, 4);
    if ((tid & 7) == 0) rs[ar] = rstd_of(sq, 1.f / 1024.f);
    __syncthreads();
    if (ktype) { const int tok = 16 * (w >> 1) + fr; const float r = rs[tok];
#pragma unroll
        for (int i = 0; i < 2; ++i) { const int ch = c0 + 16 * ((w & 1) * 2 + i) + 4 * fq; *(u32x2*)(Kmem + (size_t)(r0 + tok) * 256 + ch) = pack4(acc[i] * r); } }
    else { const int ch = c0 - 256 + 16 * (w >> 1) + fr;
#pragma unroll
        for (int i = 0; i < 2; ++i) { const int tok = 16 * ((w & 1) * 2 + i) + 4 * fq; f32x4 o;
#pragma unroll
            for (int e = 0; e < 4; ++e) o[e] = acc[i][e] * rs[tok + e];
            const int row = r0 + tok; *(u32x2*)(VmemT + (size_t)((row >> 8) * 256 + ch) * 256 + (row & 255)) = pack4(o); } }
    __syncthreads();
}
DI float wave_sum(float v) {
#pragma unroll
    for (int o = 1; o < 64; o <<= 1) v += __shfl_xor(v, o);
    return v;
}
DI void prologue(const Frame& F) {
    unsigned char* ws = F.ws;
    { u32x4* z = (u32x4*)(ws + WS_SS2); const int n = (int)((WS_CDEC - WS_SS2) / 16); for (int i = F.bid * 512 + F.tid; i < n; i += F.G * 512) z[i] = (u32x4){0u, 0u, 0u, 0u}; }
    if (F.bid < 64) kv_item(F, F.bid);
    LAS float* scr = (LAS float*)(F.lds + F.wave * 16384);
    const int gw = F.bid * 8 + F.wave, NGW = F.G * 8, lane = F.lane;
    bf16_t* W1GU = (bf16_t*)(ws + WS_W1GU); bf16_t* W1D = (bf16_t*)(ws + WS_W1D); bf16_t* W2GU = (bf16_t*)(ws + WS_W2GU); bf16_t* W2D = (bf16_t*)(ws + WS_W2D);
    bf16_t* WIN = (bf16_t*)(ws + WS_WIN); bf16_t* WG = (bf16_t*)(ws + WS_WG); bf16_t* WBR = (bf16_t*)(ws + WS_WBR); bf16_t* WOUT = (bf16_t*)(ws + WS_WOUT);
#define SEG(Wp, ldw, c0, nc, Kk, WTp, ldt, dc0, gn, MAP) { const int nblk = (nc) / 32, cnt = ((Kk) / 64) * nblk; if (r < cnt) { const int kb = r / nblk, n0 = (r % nblk) * 32; \
        tr_item(Wp, ldw, (c0) + n0, WTp, ldt, dc0, (MAP), gn, scr, kb, lane); continue; } r -= cnt; }
    constexpr int NITEMS = 2 * (3 * 1408) + 16 * (7456 / 32) + 16 * 96 + (32 + 16 + 4) * 32 + 512;
    for (int it = gw; it < NITEMS; it += NGW) {
        int r = it;
        SEG(F.in[I_F1G], FF, 0, FF, 1024, W1GU, 1024, 0, F.in[I_F1N], (n0 / 128) * 256 + (n0 % 128))
        SEG(F.in[I_F1U], FF, 0, FF, 1024, W1GU, 1024, 0, F.in[I_F1N], (n0 / 128) * 256 + 128 + (n0 % 128))
        SEG(F.in[I_F1D], 1024, 0, 1024, FF, W1D, FF, 0, (const float*)nullptr, n0)
        SEG(F.in[I_F2G], FF, 0, FF, 1024, W2GU, 1024, 0, F.in[I_F2N], (n0 / 128) * 256 + (n0 % 128))
        SEG(F.in[I_F2U], FF, 0, FF, 1024, W2GU, 1024, 0, F.in[I_F2N], (n0 / 128) * 256 + 128 + (n0 % 128))
        SEG(F.in[I_F2D], 1024, 0, 1024, FF, W2D, FF, 0, (const float*)nullptr, n0)
        SEG(F.in[I_WIN], WIN_LD, 0, 2048, 1024, WIN, 1024, 0, F.in[I_MIXN], n0)
        SEG(F.in[I_WIN], WIN_LD, 5152, 1024, 1024, WIN, 1024, 0, F.in[I_MIXN], 2048 + n0)
        SEG(F.in[I_WIN], WIN_LD, 7200, 256, 1024, WIN, 1024, 0, F.in[I_MIXN], 3072 + n0)
        SEG(F.in[I_WIN], WIN_LD, 2048, 3072, 1024, WIN, 1024, 0, F.in[I_MIXN], 3328 + n0)
        SEG(F.in[I_WIN], WIN_LD, 6176, 1024, 1024, WIN, 1024, 0, F.in[I_MIXN], 6400 + n0)
        SEG(F.in[I_WIN], WIN_LD, 5120, 32, 1024, WIN, 1024, 0, F.in[I_MIXN], 7424 + n0)
        SEG(F.in[I_WIN], WIN_LD, 7456, 3072, 1024, WG, 1024, 0, F.in[I_MIXN], n0)
        SEG(F.in[I_WBS], 1024, 0, 1024, 2048, WBR, KBR, 0, F.in[I_SSDN], n0)
        SEG(F.in[I_WBG], 1024, 0, 1024, 1024, WBR, KBR, 2048, (const float*)nullptr, n0)
        SEG(F.in[I_WBM], 1024, 0, 1024, 256, WBR, KBR, 3072, (const float*)nullptr, n0)
        SEG(F.in[I_WOUT], 1024, 0, 1024, 1024, WOUT, 1024, 0, (const float*)nullptr, n0)
    }
#undef SEG
    const float* x = F.in[I_X]; bf16_t* hb = (bf16_t*)(ws + WS_HB); float* ss1 = (float*)(ws + WS_SS1);
    for (int m = gw; m < T; m += NGW) {
        const f32x4* xr = (const f32x4*)(x + (size_t)m * DM) + lane; float s = 0.f; f32x4 v[4];
#pragma unroll
        for (int j = 0; j < 4; ++j) { v[j] = xr[64 * j]; s += (v[j][0] * v[j][0] + v[j][1] * v[j][1]) + (v[j][2] * v[j][2] + v[j][3] * v[j][3]); }
        s = wave_sum(s); if (lane == 0) ss1[m] = s;
        u32x2* o = (u32x2*)(hb + (size_t)m * DM) + lane;
#pragma unroll
        for (int j = 0; j < 4; ++j) o[64 * j] = pack4(v[j]);
    }
}
DI void final_norm(const Frame& F) {
    const float* ss4 = (const float*)(F.ws + WS_SS4); const float* g = F.in[I_FINN];
    const int gw = F.bid * 8 + F.wave, NGW = F.G * 8, lane = F.lane;
    f32x4 gv[4];
#pragma unroll
    for (int j = 0; j < 4; ++j) gv[j] = ((const f32x4*)g)[lane + 64 * j];
    for (int m = gw; m < T; m += NGW) {
        f32x4* xr = (f32x4*)(F.out + (size_t)m * DM) + lane; const float r = rstd_of(ss4[m], 1.f / 1024.f);
#pragma unroll
        for (int j = 0; j < 4; ++j) xr[64 * j] = xr[64 * j] * r * gv[j];
    }
}

DI void ssd_scan_prep(const Frame& F, const float* dt, int gr0, int h0, LAS float* acs, LAS float* dts, LAS float* wtot) {
    const int hl = F.tid >> 7, l = F.tid & 127, h = h0 + hl;
    const float a = -__expf(F.in[I_ALOG][h]);
    const float d = dt[(size_t)(gr0 + l) * 32 + h];
    float v = d * a;
#pragma unroll
    for (int o = 1; o < 64; o <<= 1) { const float t = __shfl_up(v, o); if (F.lane >= o) v += t; }
    if (F.lane == 63) wtot[F.wave] = v;
    __syncthreads();
    if (F.wave & 1) v += wtot[F.wave - 1];
    acs[hl * 128 + l] = v; dts[hl * 128 + l] = d;
    __syncthreads();
}
template <bool SCALED> DI void stage_conv_T(lptr dst, const bf16_t* xbc, int t0, int chan0, int nch, const float* cw, const float* cb, const LAS float* scale, int tid) {
    const int ncp = nch >> 1, ntask = ncp * 16;
    for (int task = tid; task < ntask; task += 512) {
        const int cp = task % ncp, tb = task / ncp, ch = chan0 + 2 * cp, l0 = tb * 8;
        float w[4][2];
#pragma unroll
        for (int k = 0; k < 4; ++k) { w[k][0] = cw[k * XBC_LD + ch]; w[k][1] = cw[k * XBC_LD + ch + 1]; }
        const float b0 = cb[ch], b1 = cb[ch + 1];
        float r0[11], r1[11];
#pragma unroll
        for (int i = 0; i < 11; ++i) { const int l = l0 - 3 + i; unsigned v = 0u; if (t0 + l >= 0) v = *(const unsigned*)(xbc + (long)(t0 + l) * XBC_LD + ch); r0[i] = bflo(v); r1[i] = bfhi(v); }
        f32x4 o0[2], o1[2];
#pragma unroll
        for (int j = 0; j < 8; ++j) {
            float y0 = b0 + w[0][0] * r0[j] + w[1][0] * r0[j + 1] + w[2][0] * r0[j + 2] + w[3][0] * r0[j + 3];
            float y1 = b1 + w[0][1] * r1[j] + w[1][1] * r1[j + 1] + w[2][1] * r1[j + 2] + w[3][1] * r1[j + 3];
            y0 = silu(y0); y1 = silu(y1);
            if (SCALED) { const float s = scale[((2 * cp) >> 6) * 128 + l0 + j]; y0 *= s; y1 *= s; }
            o0[j >> 2][j & 3] = y0; o1[j >> 2][j & 3] = y1;
        }
        *(LAS u32x4*)(dst + (2 * cp) * PT + l0 * 2) = pack8(o0[0], o0[1]);
        *(LAS u32x4*)(dst + (2 * cp + 1) * PT + l0 * 2) = pack8(o1[0], o1[1]);
    }
}
DI void stage_conv_N(lptr dst, const bf16_t* xbc, int t0, int chan0, const float* cw, const float* cb, int tid) {
    const int cg8 = (tid & 15) * 8, ch = chan0 + cg8;
    float w[4][8], b[8];
#pragma unroll
    for (int k = 0; k < 4; ++k) { const f32x4 a = *(const f32x4*)(cw + k * XBC_LD + ch), c = *(const f32x4*)(cw + k * XBC_LD + ch + 4);
#pragma unroll
        for (int e = 0; e < 4; ++e) { w[k][e] = a[e]; w[k][4 + e] = c[e]; } }
    { const f32x4 a = *(const f32x4*)(cb + ch), c = *(const f32x4*)(cb + ch + 4);
#pragma unroll
        for (int e = 0; e < 4; ++e) { b[e] = a[e]; b[4 + e] = c[e]; } }
#pragma unroll
    for (int i = 0; i < 4; ++i) {
        const int l = (tid >> 4) + 32 * i;
        float y[8];
#pragma unroll
        for (int e = 0; e < 8; ++e) y[e] = b[e];
#pragma unroll
        for (int k = 0; k < 4; ++k) { const int t = t0 + l - 3 + k; u32x4 v = (u32x4){0u, 0u, 0u, 0u}; if (t >= 0) v = *(const u32x4*)(xbc + (long)t * XBC_LD + ch);
#pragma unroll
            for (int q = 0; q < 4; ++q) { y[2 * q] += w[k][2 * q] * bflo(v[q]); y[2 * q + 1] += w[k][2 * q + 1] * bfhi(v[q]); } }
        f32x4 o0, o1;
#pragma unroll
        for (int e = 0; e < 4; ++e) { o0[e] = silu(y[e]); o1[e] = silu(y[4 + e]); }
        *(LAS u32x4*)(dst + l * PT + cg8 * 2) = pack8(o0, o1);
    }
}
struct Half { int b; bf16_t* zuq; bf16_t* xbc; bf16_t* gv; bf16_t* st; float* cdec; const float* dt; int row_base; };

DI void ssd_a_item(const Frame& F, const Half& H, int item) {
    const int c = item >> 3, g = (item >> 1) & 3, hh = item & 1, h0 = g * 8 + hh * 4, t0 = c * 128;
    lptr XT = F.lds, BT = F.lds + 69632; LAS float* acs = (LAS float*)(F.lds + 139264); LAS float* dts = acs + 512; LAS float* sc = dts + 512; LAS float* wtot = sc + 512;
    ssd_scan_prep(F, H.dt, H.row_base + t0, h0, acs, dts, wtot);
    { const int hl = F.tid >> 7, l = F.tid & 127; const float last = acs[hl * 128 + 127]; sc[hl * 128 + l] = dts[hl * 128 + l] * __expf(last - acs[hl * 128 + l]);
      if (l == 127) H.cdec[c * 32 + h0 + hl] = __expf(last); }
    __syncthreads();
    stage_conv_T<true>(XT, H.xbc, t0, g * 512 + hh * 256, 256, F.in[I_CONVW], F.in[I_CONVB], sc, F.tid);
    stage_conv_T<false>(BT, H.xbc, t0, 2048 + g * 128, 128, F.in[I_CONVW], F.in[I_CONVB], nullptr, F.tid);
    __syncthreads();
    const int w = F.wave, hl = w >> 1, nh = w & 1, fr = F.lane & 15, fq = F.lane >> 4;
    f32x4 acc[4][4];
#pragma unroll
    for (int i = 0; i < 4; ++i)
#pragma unroll
        for (int j = 0; j < 4; ++j) acc[i][j] = (f32x4){0.f, 0.f, 0.f, 0.f};
#pragma unroll
    for (int ks = 0; ks < 4; ++ks) {
        bf16x8 xf[4], yf[4];
#pragma unroll
        for (int i = 0; i < 4; ++i) { xf[i] = *(const LAS bf16x8*)(BT + (nh * 64 + 16 * i + fr) * PT + ks * 64 + fq * 16); yf[i] = *(const LAS bf16x8*)(XT + (hl * 64 + 16 * i + fr) * PT + ks * 64 + fq * 16); }
#pragma unroll
        for (int i = 0; i < 4; ++i)
#pragma unroll
            for (int j = 0; j < 4; ++j) acc[i][j] = MFMA16(xf[i], yf[j], acc[i][j]);
    }
    bf16_t* dst = H.st + (size_t)(c * 32 + h0 + hl) * 8192;
#pragma unroll
    for (int i = 0; i < 4; ++i)
#pragma unroll
        for (int j = 0; j < 4; ++j) *(u32x2*)(dst + (16 * j + fr) * 128 + nh * 64 + 16 * i + 4 * fq) = pack4(acc[i][j]);
    __syncthreads();
}
DI void ssd_scan(const Frame& F, const Half& H) {
    for (int e = F.bid * 512 + F.tid; e < 131072; e += F.G * 512) {
        const int h = e >> 12; unsigned* p = (unsigned*)H.st + e; float r0 = 0.f, r1 = 0.f;
#pragma unroll 8
        for (int c = 0; c < 64; ++c) { const unsigned wv = p[(size_t)c * 131072]; const float dec = H.cdec[c * 32 + h]; p[(size_t)c * 131072] = cvt_pk_bf16(r0, r1); r0 = r0 * dec + bflo(wv); r1 = r1 * dec + bfhi(wv); }
    }
}
DI void ssd_c_item(const Frame& F, const Half& H, int item) {
    const int c = item >> 2, g = item & 3, t0 = c * 128;
    lptr XT = F.lds, Cn = F.lds + 69632, Bn = F.lds + 104448; LAS float* acs = (LAS float*)(F.lds + 139264); LAS float* dts = acs + 512; LAS float* wtot = dts + 512; LAS float* tss = wtot + 16;
    stage_conv_N(Bn, H.xbc, t0, 2048 + g * 128, F.in[I_CONVW], F.in[I_CONVB], F.tid);
    stage_conv_N(Cn, H.xbc, t0, 2560 + g * 128, F.in[I_CONVW], F.in[I_CONVB], F.tid);
    __syncthreads();
    const int w = F.wave, fr = F.lane & 15, fq = F.lane >> 4;
    {
        const int lt0 = (w >> 1) * 2, st0 = (w & 1) * 4;
        f32x4 cb[4][2];
#pragma unroll
        for (int i = 0; i < 4; ++i) { cb[i][0] = (f32x4){0.f, 0.f, 0.f, 0.f}; cb[i][1] = cb[i][0]; }
#pragma unroll
        for (int ks = 0; ks < 4; ++ks) {
            bf16x8 xf[4], yf[2];
#pragma unroll
            for (int i = 0; i < 4; ++i) xf[i] = *(const LAS bf16x8*)(Bn + (16 * (st0 + i) + fr) * PT + ks * 64 + fq * 16);
#pragma unroll
            for (int j = 0; j < 2; ++j) yf[j] = *(const LAS bf16x8*)(Cn + (16 * (lt0 + j) + fr) * PT + ks * 64 + fq * 16);
#pragma unroll
            for (int i = 0; i < 4; ++i)
#pragma unroll
                for (int j = 0; j < 2; ++j) cb[i][j] = MFMA16(xf[i], yf[j], cb[i][j]);
        }
        __syncthreads();
#pragma unroll
        for (int i = 0; i < 4; ++i)
#pragma unroll
            for (int j = 0; j < 2; ++j) *(LAS u32x2*)(Bn + (16 * (lt0 + j) + fr) * PT + (16 * (st0 + i) + 4 * fq) * 2) = pack4(cb[i][j]);
    }
    const int hl = w >> 1, lh = w & 1;
#pragma unroll 1
    for (int hh = 0; hh < 2; ++hh) {
        const int h0 = g * 8 + hh * 4, h = h0 + hl;
        __syncthreads();
        ssd_scan_prep(F, H.dt, H.row_base + t0, h0, acs, dts, wtot);
        stage_conv_T<false>(XT, H.xbc, t0, g * 512 + hh * 256, 256, F.in[I_CONVW], F.in[I_CONVB], nullptr, F.tid);
        __syncthreads();
        f32x4 accd[4][4];
#pragma unroll
        for (int i = 0; i < 4; ++i)
#pragma unroll
            for (int j = 0; j < 4; ++j) accd[i][j] = (f32x4){0.f, 0.f, 0.f, 0.f};
        const LAS float* ah = acs + hl * 128; const LAS float* dh = dts + hl * 128;
        const bf16_t* Sp = H.st + (size_t)(c * 32 + h) * 8192;
#pragma unroll
        for (int ks = 0; ks < 4; ++ks) {
            bf16x8 xf[4], yf[4];
#pragma unroll
            for (int i = 0; i < 4; ++i) { xf[i] = *(const bf16x8*)(Sp + (16 * i + fr) * 128 + ks * 32 + fq * 8); yf[i] = *(const LAS bf16x8*)(Cn + (lh * 64 + 16 * i + fr) * PT + ks * 64 + fq * 16); }
#pragma unroll
            for (int i = 0; i < 4; ++i)
#pragma unroll
                for (int j = 0; j < 4; ++j) accd[i][j] = MFMA16(xf[i], yf[j], accd[i][j]);
        }
#pragma unroll
        for (int j = 0; j < 4; ++j) { const float el = __expf(ah[lh * 64 + 16 * j + fr]);
#pragma unroll
            for (int i = 0; i < 4; ++i) accd[i][j] = accd[i][j] * el; }
        const int nks = lh ? 4 : 2;
        for (int ks = 0; ks < nks; ++ks) {
            bf16x8 xf[4], yf[4];
            const int s0 = ks * 32 + fq * 8;
            const f32x4 as0 = *(const LAS f32x4*)(ah + s0), as1 = *(const LAS f32x4*)(ah + s0 + 4), ds0 = *(const LAS f32x4*)(dh + s0), ds1 = *(const LAS f32x4*)(dh + s0 + 4);
#pragma unroll
            for (int j = 0; j < 4; ++j) {
                const int l = lh * 64 + 16 * j + fr; const float al = ah[l];
                const u32x4 cbv = *(const LAS u32x4*)(Bn + l * PT + s0 * 2);
                f32x4 o0, o1;
#pragma unroll
                for (int q = 0; q < 4; ++q) {
                    const int sa = s0 + 2 * q, sb = sa + 1;
                    const float asa = (q < 2) ? as0[2 * q] : as1[2 * q - 4], asb = (q < 2) ? as0[2 * q + 1] : as1[2 * q - 3];
                    const float dsa = (q < 2) ? ds0[2 * q] : ds1[2 * q - 4], dsb = (q < 2) ? ds0[2 * q + 1] : ds1[2 * q - 3];
                    const float va = (sa <= l) ? bflo(cbv[q]) * __expf(al - asa) * dsa : 0.f;
                    const float vb = (sb <= l) ? bfhi(cbv[q]) * __expf(al - asb) * dsb : 0.f;
                    if (q < 2) { o0[2 * q] = va; o0[2 * q + 1] = vb; } else { o1[2 * q - 4] = va; o1[2 * q - 3] = vb; }
                }
                yf[j] = __builtin_bit_cast(bf16x8, pack8(o0, o1));
            }
#pragma unroll
            for (int i = 0; i < 4; ++i) xf[i] = *(const LAS bf16x8*)(XT + (hl * 64 + 16 * i + fr) * PT + ks * 64 + fq * 16);
#pragma unroll
            for (int i = 0; i < 4; ++i)
#pragma unroll
                for (int j = 0; j < 4; ++j) accd[i][j] = MFMA16(xf[i], yf[j], accd[i][j]);
        }
        const float Dh = F.in[I_SSDD][h];
#pragma unroll
        for (int j = 0; j < 4; ++j) {
            const int l = lh * 64 + 16 * j + fr; float sq = 0.f;
            bf16_t* zr = H.zuq + (size_t)(t0 + l) * ZUQ_LD + h * 64;
#pragma unroll
            for (int i = 0; i < 4; ++i) {
                const int p = 16 * i + 4 * fq;
                const u32x2 zv = *(const u32x2*)(zr + p);
                f32x4 y;
#pragma unroll
                for (int e = 0; e < 4; ++e) { const float xv = __uint_as_float(((unsigned)*(const LAS unsigned short*)(XT + (hl * 64 + p + e) * PT + l * 2)) << 16); y[e] = accd[i][j][e] + Dh * xv; }
                y[0] *= bflo(zv[0]); y[1] *= bfhi(zv[0]); y[2] *= bflo(zv[1]); y[3] *= bfhi(zv[1]);
                sq += (y[0] * y[0] + y[1] * y[1]) + (y[2] * y[2] + y[3] * y[3]);
                *(u32x2*)(zr + p) = pack4(y);
            }
            sq += __shfl_xor(sq, 16); sq += __shfl_xor(sq, 32);
            if (fq == 0) tss[(hh * 4 + hl) * 128 + l] = sq;
        }
    }
    __threadfence();
    __syncthreads();
    {
        const int l = F.tid >> 2, qd = F.tid & 3; float tsum = 0.f;
#pragma unroll
        for (int k = 0; k < 8; ++k) tsum += tss[k * 128 + l];
        const float r = rstd_of(tsum, 1.f / 512.f);
        u32x4* p = (u32x4*)(H.zuq + (size_t)(t0 + l) * ZUQ_LD + g * 512 + qd * 128);
#pragma unroll
        for (int i = 0; i < 16; ++i) { const u32x4 v = p[i]; f32x4 a, b; a[0] = bflo(v[0]) * r; a[1] = bfhi(v[0]) * r; a[2] = bflo(v[1]) * r; a[3] = bfhi(v[1]) * r; b[0] = bflo(v[2]) * r; b[1] = bfhi(v[2]) * r; b[2] = bflo(v[3]) * r; b[3] = bfhi(v[3]) * r; p[i] = pack8(a, b); }
    }
    __syncthreads();
}

DI void gmlp_item(const Frame& F, const Half& H, int item) {
    const int c = item >> 3, g = item & 7, t0 = c * 128, d0 = g * 128, tid = F.tid;
    lptr VT = F.lds, WS = F.lds + 34816; LAS float* rv = (LAS float*)(F.lds + 69632);
    const float* ssv = (const float*)(F.ws + WS_SSV);
    if (tid < 128) rv[tid] = rstd_of(ssv[H.row_base + t0 + tid], 1.f / 1024.f);
    __syncthreads();
#pragma unroll
    for (int i = 0; i < 4; ++i) {
        const int v = tid + 512 * i, s = v >> 4, seg = v & 15;
        const u32x4 pk = *(const u32x4*)(H.gv + (size_t)(t0 + s) * DM + d0 + seg * 8);
#pragma unroll
        for (int e = 0; e < 8; ++e) { const unsigned short hv = (unsigned short)((e & 1) ? (pk[e >> 1] >> 16) : (pk[e >> 1] & 0xffffu)); *(LAS unsigned short*)(VT + (seg * 8 + e) * PT + s * 2) = hv; }
        const int t = s, s0 = seg * 8;
        const float* wp = F.in[I_GWS] + (size_t)(g * 128 + t) * 128 + s0; const f32x4 w0 = *(const f32x4*)wp, w1 = *(const f32x4*)(wp + 4);
        f32x4 o0, o1;
#pragma unroll
        for (int e = 0; e < 4; ++e) { o0[e] = (s0 + e <= t) ? w0[e] * rv[s0 + e] : 0.f; o1[e] = (s0 + 4 + e <= t) ? w1[e] * rv[s0 + 4 + e] : 0.f; }
        *(LAS u32x4*)(WS + t * PT + s0 * 2) = pack8(o0, o1);
    }
    __syncthreads();
    const int w = F.wave, fr = F.lane & 15, fq = F.lane >> 4, mtb = (w & 3) * 2, ntb = (w >> 2) * 4;
    f32x4 acc[2][4];
#pragma unroll
    for (int i = 0; i < 2; ++i)
#pragma unroll
        for (int j = 0; j < 4; ++j) acc[i][j] = (f32x4){0.f, 0.f, 0.f, 0.f};
    const int nks = ntb ? 4 : 2;
    for (int ks = 0; ks < nks; ++ks) {
        bf16x8 xf[2], yf[4];
#pragma unroll
        for (int i = 0; i < 2; ++i) xf[i] = *(const LAS bf16x8*)(VT + (16 * (mtb + i) + fr) * PT + ks * 64 + fq * 16);
#pragma unroll
        for (int j = 0; j < 4; ++j) yf[j] = *(const LAS bf16x8*)(WS + (16 * (ntb + j) + fr) * PT + ks * 64 + fq * 16);
#pragma unroll
        for (int i = 0; i < 2; ++i)
#pragma unroll
            for (int j = 0; j < 4; ++j) acc[i][j] = MFMA16(xf[i], yf[j], acc[i][j]);
    }
#pragma unroll
    for (int j = 0; j < 4; ++j) {
        const int t = 16 * (ntb + j) + fr; const float bias = F.in[I_GBS][g * 128 + t];
#pragma unroll
        for (int i = 0; i < 2; ++i) {
            const int d = d0 + 16 * (mtb + i) + 4 * fq;
            const f32x4 gn = *(const f32x4*)(F.in[I_GVN] + d);
            bf16_t* up = H.zuq + (size_t)(t0 + t) * ZUQ_LD + 2048 + d;
            const u32x2 uv = *(const u32x2*)up;
            f32x4 y;
            y[0] = bflo(uv[0]) * (gn[0] * acc[i][j][0] + bias); y[1] = bfhi(uv[0]) * (gn[1] * acc[i][j][1] + bias);
            y[2] = bflo(uv[1]) * (gn[2] * acc[i][j][2] + bias); y[3] = bfhi(uv[1]) * (gn[3] * acc[i][j][3] + bias);
            *(u32x2*)up = pack4(y);
        }
    }
    __syncthreads();
}
DI void memattn_item(const Frame& F, const Half& H, int item) {
    const int h = item & 3, t0 = (item >> 2) * 256, tid = F.tid, w = F.wave, fr = F.lane & 15, fq = F.lane >> 4;
    lptr Ks = F.lds, VT = F.lds + 36864, Pw = F.lds + 70656 + w * 8448;
    const bf16_t* Kmem = (const bf16_t*)(F.ws + WS_KMEM) + (size_t)H.b * 256 * 256; const bf16_t* VmemT = (const bf16_t*)(F.ws + WS_VMEMT) + (size_t)H.b * 256 * 256;
#pragma unroll
    for (int i = 0; i < 4; ++i) {
        const int v = tid + 512 * i;
        { const int m = v >> 3, seg = v & 7; *(LAS u32x4*)(Ks + m * 144 + seg * 16) = *(const u32x4*)(Kmem + (size_t)m * 256 + h * 64 + seg * 8); }
        { const int d = v >> 5, seg = v & 31; *(LAS u32x4*)(VT + d * 528 + seg * 16) = *(const u32x4*)(VmemT + (size_t)(h * 64 + d) * 256 + seg * 8); }
    }
    __syncthreads();
    for (int sub = 0; sub < 2; ++sub) {
        const int tw = t0 + sub * 128 + w * 16;
        bf16_t* qrow = H.zuq + (size_t)(tw + fr) * ZUQ_LD + 3072 + h * 64;
        bf16x8 qf[2];
        qf[0] = *(const bf16x8*)(qrow + fq * 8); qf[1] = *(const bf16x8*)(qrow + 32 + fq * 8);
        f32x4 s[16];
#pragma unroll
        for (int i = 0; i < 16; ++i) { s[i] = (f32x4){0.f, 0.f, 0.f, 0.f};
#pragma unroll
            for (int ks = 0; ks < 2; ++ks) { const bf16x8 kf = *(const LAS bf16x8*)(Ks + (16 * i + fr) * 144 + ks * 64 + fq * 16); s[i] = MFMA16(kf, qf[ks], s[i]); } }
        float mx = -3.0e38f;
#pragma unroll
        for (int i = 0; i < 16; ++i) mx = fmaxf(mx, fmaxf(fmaxf(s[i][0], s[i][1]), fmaxf(s[i][2], s[i][3])));
        mx = fmaxf(mx, __shfl_xor(mx, 16)); mx = fmaxf(mx, __shfl_xor(mx, 32));
        float sum = 0.f;
#pragma unroll
        for (int i = 0; i < 16; ++i) { f32x4 p;
#pragma unroll
            for (int e = 0; e < 4; ++e) { p[e] = __builtin_amdgcn_exp2f(s[i][e] - mx); sum += p[e]; }
            *(LAS u32x2*)(Pw + fr * 528 + (16 * i + 4 * fq) * 2) = pack4(p); }
        sum += __shfl_xor(sum, 16); sum += __shfl_xor(sum, 32);
        LDS_WAIT(); __builtin_amdgcn_wave_barrier();
        f32x4 o[4];
#pragma unroll
        for (int i = 0; i < 4; ++i) o[i] = (f32x4){0.f, 0.f, 0.f, 0.f};
#pragma unroll
        for (int ks = 0; ks < 8; ++ks) { const bf16x8 pf = *(const LAS bf16x8*)(Pw + fr * 528 + ks * 64 + fq * 16);
#pragma unroll
            for (int i = 0; i < 4; ++i) { const bf16x8 vf = *(const LAS bf16x8*)(VT + (16 * i + fr) * 528 + ks * 64 + fq * 16); o[i] = MFMA16(vf, pf, o[i]); } }
        const float inv = __builtin_amdgcn_rcpf(sum);
#pragma unroll
        for (int i = 0; i < 4; ++i) *(u32x2*)(qrow + 16 * i + 4 * fq) = pack4(o[i] * inv);
        LDS_WAIT(); __builtin_amdgcn_wave_barrier();
    }
    __syncthreads();
}

#define PH_GEMM(EpiT, Aptr, Bptr, Mm, Nn, Kk, Eobj) do { pg8::Gemm g_{(const bf16_t*)(Aptr), (const bf16_t*)(Bptr), Mm, Nn, Kk}; pg8::StaticOrder S_; S_.init(Mm, Nn, F.G, F.bid); \
        pg8::gemm_phase<EpiT, pg8::StaticOrder, true, true>(F.lds, g_, S_, Eobj); } while (0)

__global__ void __launch_bounds__(512) mega_fwd(Args args) {
    extern __shared__ __attribute__((aligned(16))) unsigned char lds_raw[];
    cg::grid_group grid = cg::this_grid();
    Frame F; F.lds = (lptr)lds_raw; F.ws = args.ws; F.in = args.in; F.out = args.out;
    F.tid = threadIdx.x; F.lane = F.tid & 63; F.wave = __builtin_amdgcn_readfirstlane(F.tid >> 6); F.G = gridDim.x; F.bid = blockIdx.x;
    unsigned char* ws = args.ws;
    const int lo = args.ph_lo, hi = args.ph_hi;
    bf16_t* HB = (bf16_t*)(ws + WS_HB); bf16_t* ACT = (bf16_t*)(ws + WS_ACT); bf16_t* MG = (bf16_t*)(ws + WS_MG);
    float* SS1 = (float*)(ws + WS_SS1); float* SS2 = (float*)(ws + WS_SS2); float* SS3 = (float*)(ws + WS_SS3); float* SS4 = (float*)(ws + WS_SS4);
#ifndef PHMASK
#define PHMASK 0xFFFFFFFFu
#endif
#define RELAUNDER() do { int t_ = threadIdx.x; asm volatile("" : "+v"(t_)); F.tid = t_; F.lane = t_ & 63; F.wave = __builtin_amdgcn_readfirstlane(t_ >> 6); } while (0)
#define IN(k) (((PHMASK >> ((k) > 8 ? (k) - 6 : (k))) & 1u) && lo <= (k) && (k) < hi)
#define SEAM(k) do { if ((k) + 1 < hi) grid.sync(); } while (0)
    if (IN(0)) { RELAUNDER(); prologue(F); SEAM(0); }
    if (IN(1)) { RELAUNDER(); EpiGLU E{SS1, ACT}; PH_GEMM(EpiGLU, HB, ws + WS_W1GU, T, 2 * FF, DM, E); SEAM(1); }
    if (IN(2)) { RELAUNDER(); EpiRes E{F.in[I_X], F.out, HB, SS2, 0.5f}; PH_GEMM(EpiRes, ACT, ws + WS_W1D, T, DM, FF, E); SEAM(2); }
#pragma unroll 1
    for (int b = 0; b < 2; ++b) {
        const int k0 = 3 + 6 * b;
        Half H; H.b = b; H.zuq = (bf16_t*)(ws + WS_ZUQ); H.xbc = (bf16_t*)(ws + WS_XBC); H.gv = MG + (size_t)TB * DM; H.st = (bf16_t*)(ws + WS_ST);
        H.cdec = (float*)(ws + WS_CDEC) + b * 2048; H.dt = (const float*)(ws + WS_DT); H.row_base = b * TB;
        if (IN(k0)) { RELAUNDER(); EpiWin E{H.row_base, SS2, H.zuq, H.xbc, H.gv, (float*)(ws + WS_DT), F.in[I_DTB], (float*)(ws + WS_SSV)};
            PH_GEMM(EpiWin, HB + (size_t)H.row_base * DM, ws + WS_WIN, TB, NWIN, DM, E); SEAM(k0); }
        if (IN(k0 + 1)) { RELAUNDER();
            for (int it = F.bid; it < 512 + 512 + 128; it += F.G) {
                if (it < 512) ssd_a_item(F, H, it); else if (it < 1024) gmlp_item(F, H, it - 512); else memattn_item(F, H, it - 1024);
            }
            SEAM(k0 + 1); }
        if (IN(k0 + 2)) { RELAUNDER(); ssd_scan(F, H); SEAM(k0 + 2); }
        if (IN(k0 + 3)) { RELAUNDER(); for (int it = F.bid; it < 256; it += F.G) ssd_c_item(F, H, it); SEAM(k0 + 3); }
        if (IN(k0 + 4)) { RELAUNDER(); EpiGates E{H.row_base, SS2, H.xbc}; PH_GEMM(EpiGates, HB + (size_t)H.row_base * DM, ws + WS_WG, TB, GATE_LD, DM, E); SEAM(k0 + 4); }
        if (IN(k0 + 5)) { RELAUNDER(); EpiMerge E{H.xbc, (float*)(ws + WS_ST), MG + (size_t)b * TB * DM};
            { pg8::Gemm g_{(const bf16_t*)H.zuq, (const bf16_t*)(ws + WS_WBR), TB, DM, KBR}; pg8::SegOrder<3> S_; S_.init(TB, DM, F.G, F.bid); pg8::gemm_phase<EpiMerge, pg8::SegOrder<3>, true, true>(F.lds, g_, S_, E); } SEAM(k0 + 5); }
    }
    if (IN(15)) { RELAUNDER(); EpiRes E{F.out, F.out, HB, SS3, 1.0f}; PH_GEMM(EpiRes, MG, ws + WS_WOUT, T, DM, DM, E); SEAM(15); }
    if (IN(16)) { RELAUNDER(); EpiGLU E{SS3, ACT}; PH_GEMM(EpiGLU, HB, ws + WS_W2GU, T, 2 * FF, DM, E); SEAM(16); }
    if (IN(17)) { RELAUNDER(); EpiRes E{F.out, F.out, (bf16_t*)nullptr, SS4, 0.5f}; PH_GEMM(EpiRes, ACT, ws + WS_W2D, T, DM, FF, E); SEAM(17); }
    if (IN(18)) { RELAUNDER(); final_norm(F); }
#ifdef DUMP_MASK
    if (lo <= 19 && 19 < hi) {
        const bf16_t* zq = (const bf16_t*)(ws + WS_ZUQ); const bf16_t* xb = (const bf16_t*)(ws + WS_XBC); const bf16_t* st = (const bf16_t*)(ws + WS_ST);
        for (size_t i = (size_t)F.bid * 512 + F.tid; i < (size_t)T * DM; i += (size_t)F.G * 512) {
            float v = 0.f;
            if (DUMP_MASK & 1) v += __uint_as_float((unsigned)zq[i] << 16) + __uint_as_float((unsigned)zq[i + 10485760] << 16);
            if (DUMP_MASK & 2) v += __uint_as_float((unsigned)xb[i] << 16) + __uint_as_float((unsigned)xb[i + 8388608] << 16);
            if (DUMP_MASK & 4) v += __uint_as_float((unsigned)st[i] << 16);
            if (DUMP_MASK & 8) v += __uint_as_float((unsigned)MG[i] << 16);
            F.out[i] = v;
        }
    }
#endif
}

#ifndef N_PHASES
#define N_PHASES 19
#endif
#ifndef ONE_LAUNCH
#define ONE_LAUNCH 1
#endif
extern "C" void kernel_launch(void* const* d_in, const int* in_sizes, int n_in, void* d_out, int out_size, void* d_ws, size_t ws_size, hipStream_t stream) {
    static int grid = 0;
    if (grid == 0) {
        int dev = 0, cus = 0, per_cu = 0;
        hipGetDevice(&dev); hipDeviceGetAttribute(&cus, hipDeviceAttributeMultiprocessorCount, dev);
        if (hipFuncSetAttribute((const void*)mega_fwd, hipFuncAttributeMaxDynamicSharedMemorySize, LDS_BYTES) != hipSuccess) { fprintf(stderr, "kernel_launch: hipFuncSetAttribute failed\n"); grid = -1; return; }
        if (hipOccupancyMaxActiveBlocksPerMultiprocessor(&per_cu, (const void*)mega_fwd, 512, LDS_BYTES) != hipSuccess || per_cu < 1) { fprintf(stderr, "kernel_launch: occupancy query says %d\n", per_cu); per_cu = 1; }
        (void)hipGetLastError();
        grid = cus;
        if (n_in != 28 || ws_size < WS_END) { fprintf(stderr, "kernel_launch: unexpected n_in %d / ws %zu\n", n_in, ws_size); grid = -1; return; }
    }
    if (grid < 0) return;
    Args a{};
    for (int i = 0; i < 28; ++i) a.in[i] = (const float*)d_in[i];
    a.out = (float*)d_out; a.ws = (unsigned char*)d_ws;
#if ONE_LAUNCH
    a.ph_lo = 0; a.ph_hi = N_PHASES;
    void* kargs[] = {&a};
    hipError_t e = hipLaunchCooperativeKernel((const void*)mega_fwd, dim3(grid), dim3(512), kargs, LDS_BYTES, stream);
    if (e != hipSuccess) fprintf(stderr, "cooperative launch failed: %s (grid %d)\n", hipGetErrorString(e), grid);
#else
    for (int k = 0; k < N_PHASES; ++k) { a.ph_lo = k; a.ph_hi = k + 1; hipLaunchKernelGGL(mega_fwd, dim3(grid), dim3(512), LDS_BYTES, stream, a); }
#ifdef DUMP_MASK
    a.ph_lo = 19; a.ph_hi = 20; hipLaunchKernelGGL(mega_fwd, dim3(grid), dim3(512), LDS_BYTES, stream, a);
#endif
#endif
}
```

```cpp
#include <hip/hip_runtime.h>
#include <hip/hip_cooperative_groups.h>
#include <cstdio>
#include <cstdint>
namespace cg = cooperative_groups;
namespace pg8 {
#define PG8_LAS __attribute__((address_space(3)))
typedef unsigned short bf16_t;
typedef short bf16x8 __attribute__((ext_vector_type(8)));
typedef float f32x4 __attribute__((ext_vector_type(4)));
typedef unsigned u32x4 __attribute__((ext_vector_type(4)));
constexpr int BM = 256, BK = 64, HALF = 128, HTB = HALF * BK * 2  , STAGE_BYTES = 8 * HTB, NXCD = 8, WGM = 8;

__host__ __device__ __forceinline__ int lds_byte(int r, int c) { const int st = (r >> 4) * 2 + (c >> 5), rr = r & 15, cc = c & 31, ob = rr * 64 + cc * 2; return st * 1024 + (ob ^ (((ob >> 9) & 1) << 5)); }
__host__ __device__ __forceinline__ void stage_rc(int b, int& R, int& C) { const int st = b / 1024, sb = b % 1024, swz = sb ^ (((sb >> 9) & 1) << 5); R = (st >> 1) * 16 + swz / 64; C = (st & 1) * 32 + (swz % 64) / 2; }
__host__ __device__ __forceinline__ int perm32(int rho) { const int n = rho >> 4, i = rho & 15; return 8 * (i >> 2) + 4 * n + (i & 3); }

struct Unit { int pm, pn, seg; };
struct Gemm { const bf16_t* A; const bf16_t* Bt; int M, N, K; };

struct StaticOrder {
    int nM, nN, nwg, G, c;
    __host__ __device__ void init(int M, int N, int G_, int c_) { nM = M / BM; nN = N / BM; nwg = nM * nN; G = G_; c = c_; }
    __host__ __device__ bool next(int i, Unit& u) const {
        const long L = (long)i * G + c; if (L >= nwg) return false;
        int wgid = (int)L; { const int q = nwg / NXCD, r = nwg % NXCD, xcd = wgid % NXCD, off = wgid / NXCD; wgid = (xcd < r ? xcd * (q + 1) : r * (q + 1) + (xcd - r) * q) + off; }
        const int nig = WGM * nN, gid = wgid / nig, fm = gid * WGM, gsz = (nM - fm) < WGM ? (nM - fm) : WGM;
        u.pm = fm + ((wgid % nig) % gsz); u.pn = (wgid % nig) / gsz; u.seg = 0; return true;
    }
    __device__ __forceinline__ void a_ready(const Unit&) const {}
    __device__ __forceinline__ void done(const Unit&) const {}
};

template <int NSEG> struct SegOrder {
    StaticOrder base;
    __host__ __device__ void init(int M, int N, int G_, int c_) { base.init(M, N, G_, c_); }
    __host__ __device__ bool next(int i, Unit& u) const { if (!base.next(i / NSEG, u)) return false; u.seg = i % NSEG; return true; }
    __device__ __forceinline__ void a_ready(const Unit&) const {}
    __device__ __forceinline__ void done(const Unit&) const {}
};
__device__ __forceinline__ unsigned cvt_pk_bf16(float lo, float hi) { unsigned r; asm volatile("v_cvt_pk_bf16_f32 %0, %1, %2" : "=v"(r) : "v"(lo), "v"(hi)); return r; }
typedef float f32x2 __attribute__((ext_vector_type(2)));
__device__ __forceinline__ f32x2 gelu_pk(f32x2 v) {
    const f32x2 av = __builtin_elementwise_abs(v), d = av * 0.2316418882f + 1.0f;
    f32x2 t; t.x = __builtin_amdgcn_rcpf(d.x); t.y = __builtin_amdgcn_rcpf(d.y);
    f32x2 q = t * 0.5307027145f + (-0.7265760135f); q = q * t + 0.7107068705f; q = q * t + (-0.142248368f); q = q * t + 0.127414796f; q = q * t;
    const f32x2 s = (v * v) * (-0.72134752044f);
    f32x2 e; e.x = __builtin_amdgcn_exp2f(s.x); e.y = __builtin_amdgcn_exp2f(s.y);
    const f32x2 m = v * (q * e), r = v - m;
    f32x2 o; o.x = v.x < 0.f ? m.x : r.x; o.y = v.y < 0.f ? m.y : r.y; return o;
}
template <class Epi, class Sched, bool ALIGN_EPI = false, bool SP2 = false>
__device__ __forceinline__ void gemm_phase(PG8_LAS unsigned char* lds, const Gemm g, const Sched& S, const Epi& E) {
    int tid_ = threadIdx.x; asm volatile("" : "+v"(tid_)); const int tid = tid_, wid = __builtin_amdgcn_readfirstlane(tid >> 6), lane = tid & 63, wr = wid >> 2, wc = wid & 3, fr = lane & 15, fq = lane >> 4;
    const int K = g.K; int nt = K / BK;
    unsigned voffA[2], voffB[2];
#pragma unroll
    for (int i = 0; i < 2; ++i) { int R, C; stage_rc(tid * 16 + i * 8192, R, C); const int Rb = Epi::PERM ? ((R & ~31) + perm32(R & 31)) : R;
        voffA[i] = (unsigned)(R * K + C) * 2u; voffB[i] = (unsigned)(Rb * K + C) * 2u; }
    const size_t kstep = (size_t)(BK * 2);
    const size_t hstep = (size_t)HALF * K * 2;
    const size_t tstep = 2 * hstep;
    const unsigned ldsw = (unsigned)wid * 1024u;
    const int aoff = lds_byte(wr * 64 + fr, fq * 8), boff = lds_byte(wc * 32 + fr, fq * 8);
#define PG8_SA(b, h) (((b) * 2 + (h)) * HTB)
#define PG8_SB(b, h) ((4 + (b) * 2 + (h)) * HTB)
#define PG8_STAGE(bufoff, gbase, voff) do { _Pragma("unroll") for (int _i = 0; _i < 2; ++_i) \
        __builtin_amdgcn_global_load_lds((const unsigned*)((const char*)(gbase) + (voff)[_i]), (PG8_LAS unsigned*)(lds + (bufoff) + ldsw + _i * 8192), 16, 0, 0); } while (0)
#define PG8_LDA(dst, b, h) do { _Pragma("unroll") for (int m = 0; m < 4; ++m) _Pragma("unroll") for (int k = 0; k < 2; ++k) dst[m][k] = *(const PG8_LAS bf16x8*)(lds + PG8_SA(b, h) + aoff + m * 2048 + k * 1024); } while (0)
#define PG8_LDB(dst, b, h) do { _Pragma("unroll") for (int n = 0; n < 2; ++n) _Pragma("unroll") for (int k = 0; k < 2; ++k) dst[n][k] = *(const PG8_LAS bf16x8*)(lds + PG8_SB(b, h) + boff + n * 2048 + k * 1024); } while (0)
#define PG8_MMA(ai, bj, At, Bt) do { __builtin_amdgcn_s_setprio(1); _Pragma("unroll") for (int m = 0; m < 4; ++m) _Pragma("unroll") for (int n = 0; n < 2; ++n) _Pragma("unroll") for (int k = 0; k < 2; ++k) \
        acc[ai][bj][m][n] = __builtin_amdgcn_mfma_f32_16x16x32_bf16(Bt[n][k], At[m][k], acc[ai][bj][m][n], 0, 0, 0); __builtin_amdgcn_s_setprio(0); } while (0)
#define PG8_WAIT_V(n) asm volatile("s_waitcnt vmcnt(" #n ")" ::: "memory")
#define PG8_WAIT_L(n) asm volatile("s_waitcnt lgkmcnt(" #n ")" ::: "memory")
#define PG8_BAR __builtin_amdgcn_s_barrier()
#define PG8_SCHED __builtin_amdgcn_sched_barrier(0)
    Unit cur, nxt; int ui = 0;
    if (!S.next(0, cur)) return;
    f32x4 acc[2][2][4][2];
#pragma unroll
    for (int a = 0; a < 2; ++a)
#pragma unroll
        for (int b = 0; b < 2; ++b)
#pragma unroll
            for (int m = 0; m < 4; ++m)
#pragma unroll
                for (int n = 0; n < 2; ++n) acc[a][b][m][n] = (f32x4){0.f, 0.f, 0.f, 0.f};
    bf16x8 At[4][2], B0[2][2], B1[2][2];
    const char* cA = (const char*)g.A + (size_t)cur.pm * tstep; const char* cB = (const char*)g.Bt + (size_t)cur.pn * (Epi::HALFB ? hstep : tstep);
    if constexpr (Epi::NSEG > 1) { cA += (size_t)Epi::seg_koff(cur.seg) * 2; cB += (size_t)Epi::seg_koff(cur.seg) * 2; nt = Epi::seg_nt(cur.seg); }
    S.a_ready(cur);
    if constexpr (SP2) {
        PG8_STAGE(PG8_SB(0, 0), cB, voffB); PG8_STAGE(PG8_SB(0, 1), cB + hstep, voffB); PG8_STAGE(PG8_SA(0, 0), cA, voffA); PG8_STAGE(PG8_SA(0, 1), cA + hstep, voffA);
        if (wr == 1) PG8_BAR;
        PG8_WAIT_V(2); PG8_BAR;
        PG8_STAGE(PG8_SB(1, 0), cB + kstep, voffB); PG8_STAGE(PG8_SA(1, 0), cA + kstep, voffA); PG8_STAGE(PG8_SB(1, 1), cB + hstep + kstep, voffB);
        PG8_WAIT_V(6); PG8_BAR;
    } else {
        PG8_STAGE(PG8_SB(0, 0), cB, voffB); PG8_STAGE(PG8_SA(0, 0), cA, voffA); PG8_STAGE(PG8_SB(0, 1), cB + hstep, voffB); PG8_STAGE(PG8_SA(0, 1), cA + hstep, voffA);
        if (wr == 1) PG8_BAR;
        PG8_WAIT_V(4); PG8_BAR;
        PG8_STAGE(PG8_SB(1, 0), cB + kstep, voffB); PG8_STAGE(PG8_SA(1, 0), cA + kstep, voffA); PG8_STAGE(PG8_SB(1, 1), cB + hstep + kstep, voffB);
        PG8_WAIT_V(6); PG8_BAR;
    }
    for (;;) {
        const bool has_next = S.next(ui + 1, nxt);
        const char* nA = has_next ? (const char*)g.A + (size_t)nxt.pm * tstep : cA; const char* nB = has_next ? (const char*)g.Bt + (size_t)nxt.pn * (Epi::HALFB ? hstep : tstep) : cB;
        if constexpr (Epi::NSEG > 1) { if (has_next) { nA += (size_t)Epi::seg_koff(nxt.seg) * 2; nB += (size_t)Epi::seg_koff(nxt.seg) * 2; } }
        for (int t = 0; t < nt; t += 2) {
            const bool last = (t == nt - 2);
            const char* a1 = cA + (size_t)(t + 1) * kstep;
            const char* a2 = last ? nA : cA + (size_t)(t + 2) * kstep; const char* b2 = last ? nB : cB + (size_t)(t + 2) * kstep;
            const char* a3 = a2 + kstep; const char* b3 = b2 + kstep;
            if (last && has_next) S.a_ready(nxt);
            if constexpr (SP2) {
            PG8_LDB(B0, 0, 0); if constexpr (!Epi::HALFB) PG8_LDB(B1, 0, 1); PG8_SCHED; PG8_LDA(At, 0, 0); PG8_STAGE(PG8_SA(1, 1), a1 + hstep, voffA);
            PG8_WAIT_V(8); PG8_WAIT_L(0); PG8_BAR; PG8_MMA(0, 0, At, B0); if constexpr (!Epi::HALFB) PG8_MMA(0, 1, At, B1); PG8_BAR; PG8_SCHED;
            PG8_LDA(At, 0, 1); PG8_STAGE(PG8_SB(0, 0), b2, voffB); PG8_STAGE(PG8_SB(0, 1), b2 + hstep, voffB); PG8_STAGE(PG8_SA(0, 0), a2, voffA);
            PG8_WAIT_V(8); PG8_WAIT_L(0); PG8_BAR; PG8_MMA(1, 0, At, B0); if constexpr (!Epi::HALFB) PG8_MMA(1, 1, At, B1); PG8_BAR; PG8_SCHED;
            PG8_LDB(B0, 1, 0); if constexpr (!Epi::HALFB) PG8_LDB(B1, 1, 1); PG8_SCHED; PG8_LDA(At, 1, 0); PG8_STAGE(PG8_SA(0, 1), a2 + hstep, voffA);
            PG8_WAIT_V(8); PG8_WAIT_L(0); PG8_BAR; PG8_MMA(0, 0, At, B0); if constexpr (!Epi::HALFB) PG8_MMA(0, 1, At, B1); PG8_BAR; PG8_SCHED;
            PG8_LDA(At, 1, 1); PG8_STAGE(PG8_SB(1, 0), b3, voffB); PG8_STAGE(PG8_SB(1, 1), b3 + hstep, voffB); PG8_STAGE(PG8_SA(1, 0), a3, voffA);
            PG8_WAIT_V(8); PG8_WAIT_L(0); PG8_BAR; PG8_MMA(1, 0, At, B0); if constexpr (!Epi::HALFB) PG8_MMA(1, 1, At, B1); PG8_BAR; PG8_SCHED;
            } else {
            PG8_LDB(B0, 0, 0); PG8_SCHED; PG8_LDA(At, 0, 0); PG8_STAGE(PG8_SA(1, 1), a1 + hstep, voffA);
            PG8_WAIT_L(8); PG8_BAR; PG8_WAIT_L(0); PG8_MMA(0, 0, At, B0); PG8_BAR; PG8_SCHED;
            PG8_LDB(B1, 0, 1); PG8_STAGE(PG8_SB(0, 0), b2, voffB);
            PG8_BAR; PG8_WAIT_L(0); PG8_MMA(0, 1, At, B1); PG8_BAR;
            PG8_LDA(At, 0, 1); PG8_STAGE(PG8_SA(0, 0), a2, voffA);
            PG8_BAR; PG8_WAIT_L(0); PG8_MMA(1, 0, At, B0); PG8_BAR; PG8_SCHED;
            PG8_STAGE(PG8_SB(0, 1), b2 + hstep, voffB);
            PG8_WAIT_V(6); PG8_BAR; PG8_MMA(1, 1, At, B1); PG8_BAR;
            PG8_LDB(B0, 1, 0); PG8_SCHED; PG8_LDA(At, 1, 0); PG8_STAGE(PG8_SA(0, 1), a2 + hstep, voffA);
            PG8_WAIT_L(8); PG8_BAR; PG8_WAIT_L(0); PG8_MMA(0, 0, At, B0); PG8_BAR; PG8_SCHED;
            PG8_LDB(B1, 1, 1); PG8_STAGE(PG8_SB(1, 0), b3, voffB);
            PG8_BAR; PG8_WAIT_L(0); PG8_MMA(0, 1, At, B1); PG8_BAR;
            PG8_LDA(At, 1, 1); PG8_STAGE(PG8_SA(1, 0), a3, voffA);
            PG8_BAR; PG8_WAIT_L(0); PG8_MMA(1, 0, At, B0); PG8_BAR; PG8_SCHED;
            PG8_STAGE(PG8_SB(1, 1), b3 + hstep, voffB);
            PG8_WAIT_V(6); PG8_BAR; PG8_MMA(1, 1, At, B1); PG8_BAR;
            }
        }
        if constexpr (ALIGN_EPI) { if (wr == 0) PG8_BAR; }
        bool lastseg = true; if constexpr (Epi::NSEG > 1) lastseg = (cur.seg == Epi::NSEG - 1);
        if constexpr (!Epi::AFTER_DRAIN) { if (lastseg) { E(acc, cur, wr, wc, fr, fq); S.done(cur); } else { if constexpr (Epi::NSEG > 1) E.seg(acc, cur, wr, wc, fr, fq); } }
        if (!has_next) break;
#pragma unroll
        for (int a = 0; a < 2; ++a)
#pragma unroll
            for (int b = 0; b < 2; ++b)
#pragma unroll
                for (int m = 0; m < 4; ++m)
#pragma unroll
                    for (int n = 0; n < 2; ++n) acc[a][b][m][n] = (f32x4){0.f, 0.f, 0.f, 0.f};
        cur = nxt; cA = nA; cB = nB; ++ui; if constexpr (Epi::NSEG > 1) nt = Epi::seg_nt(cur.seg);
        if constexpr (ALIGN_EPI) { if (wr == 1) PG8_BAR; }
    }
    PG8_WAIT_V(0);
    if constexpr (!ALIGN_EPI) { if (wr == 0) PG8_BAR; }
    PG8_BAR;
    if constexpr (Epi::AFTER_DRAIN) { E.fused(acc, cur, wr, wc, fr, fq, lds, wid, lane); S.done(cur); }
#undef PG8_SA
#undef PG8_SB
#undef PG8_STAGE
#undef PG8_LDA
#undef PG8_LDB
#undef PG8_MMA
#undef PG8_WAIT_V
#undef PG8_WAIT_L
#undef PG8_BAR
#undef PG8_SCHED
}
}

#define DI __device__ __forceinline__
#define LAS __attribute__((address_space(3)))
using pg8::bf16_t; using pg8::bf16x8; using pg8::f32x4; using pg8::u32x4; using pg8::Unit; using pg8::f32x2; using pg8::gelu_pk;
typedef __bf16 bf16x2_t __attribute__((ext_vector_type(2)));
__device__ __forceinline__ unsigned cvt_pk_bf16(float lo, float hi) { f32x2 v = {lo, hi}; bf16x2_t b = __builtin_convertvector(v, bf16x2_t); return __builtin_bit_cast(unsigned, b); }
typedef LAS unsigned char* lptr;
typedef unsigned u32x2 __attribute__((ext_vector_type(2)));
#define MFMA16(a, b, c) __builtin_amdgcn_mfma_f32_16x16x32_bf16((a), (b), (c), 0, 0, 0)

constexpr int T = 16384, TB = 8192, DM = 1024, FF = 2816;
constexpr float EPS = 1e-6f;
constexpr int ZUQ_LD = 3328, XBC_LD = 3072, NWIN = 7680, GATE_LD = 3072, KBR = 3328, WIN_LD = 10528;
constexpr float QSCALE = 0.125f * 1.4426950408889634f;
constexpr int PT = 272;
constexpr int LDS_BYTES = 155648;

constexpr size_t KiB = 1024, MiB = 1u << 20;
constexpr size_t WS_SS1 = 0, WS_SS2 = 64 * KiB, WS_SS3 = 128 * KiB, WS_SS4 = 192 * KiB, WS_SSV = 256 * KiB, WS_SSG = 320 * KiB  , WS_CDEC = 576 * KiB  ;
constexpr size_t WS_KMEM = 640 * KiB, WS_VMEMT = 896 * KiB, WS_DT = 2 * MiB;
constexpr size_t WS_BAR = 4 * MiB, BAR_BYTES = 16384;
constexpr int LDS_BARST = LDS_BYTES - 64;
constexpr size_t WS_W2GU = 6 * MiB, WS_W2D = 17 * MiB, WS_WIN = 22 * MiB + 512 * KiB, WS_WG = 37 * MiB + 512 * KiB, WS_WBR = 43 * MiB + 512 * KiB, WS_WOUT = 50 * MiB;
constexpr size_t WS_HB = 52 * MiB, WS_MG = 84 * MiB, WS_W1GU = 116 * MiB, WS_W1D = 127 * MiB, WS_ACT = 132 * MiB + 512 * KiB;
constexpr size_t WS_ZUQ = 116 * MiB, WS_XBC = 168 * MiB, WS_ST = 216 * MiB, WS_END = 256 * MiB;
static_assert(WS_ACT + (size_t)T * FF * 2 <= WS_END && WS_ST + (size_t)64 * 32 * 8192 * 2 <= WS_END && WS_ZUQ + (size_t)TB * ZUQ_LD * 2 <= WS_XBC && WS_XBC + (size_t)TB * XBC_LD * 2 <= WS_ST, "ws map");

DI float bflo(unsigned w) { return __uint_as_float(w << 16); }
DI float bfhi(unsigned w) { return __uint_as_float(w & 0xffff0000u); }
DI float sigm(float x) { return __builtin_amdgcn_rcpf(1.f + __expf(-x)); }
DI float silu(float x) { return x * sigm(x); }
DI u32x4 pack8(f32x4 a, f32x4 b) { u32x4 w; w.x = cvt_pk_bf16(a[0], a[1]); w.y = cvt_pk_bf16(a[2], a[3]); w.z = cvt_pk_bf16(b[0], b[1]); w.w = cvt_pk_bf16(b[2], b[3]); return w; }
DI u32x2 pack4(f32x4 a) { u32x2 w; w.x = cvt_pk_bf16(a[0], a[1]); w.y = cvt_pk_bf16(a[2], a[3]); return w; }
DI f32x4 gelu4(f32x4 v) { f32x2 a = gelu_pk((f32x2){v[0], v[1]}), b = gelu_pk((f32x2){v[2], v[3]}); return (f32x4){a.x, a.y, b.x, b.y}; }
DI float rstd_of(float ss, float inv_n) { return __builtin_amdgcn_rsqf(ss * inv_n + EPS); }
DI float softplus(float v) { return v > 20.f ? v : log1pf(__expf(v)); }

struct EpiGLU {
    static constexpr bool PERM = true, AFTER_DRAIN = false; static constexpr int NSEG = 1; static constexpr bool HALFB = false;
    const float* ss; bf16_t* O;
    DI void operator()(const f32x4 (&acc)[2][2][4][2], const Unit& u, int wr, int wc, int fr, int fq) const {
        const int col = u.pn * 128 + wc * 32 + 8 * fq;
#pragma unroll
        for (int ai = 0; ai < 2; ++ai)
#pragma unroll
            for (int m = 0; m < 4; ++m) {
                const int row = u.pm * 256 + ai * 128 + wr * 64 + m * 16 + fr;
                const float r = rstd_of(ss[row], 1.f / 1024.f);
                f32x4 o[2];
#pragma unroll
                for (int n = 0; n < 2; ++n)
#pragma unroll
                    for (int e = 0; e < 4; ++e) o[n][e] = silu(acc[ai][0][m][n][e] * r) * (acc[ai][1][m][n][e] * r);
                *(u32x4*)(O + (size_t)row * FF + col) = pack8(o[0], o[1]);
            }
    }
};
struct EpiRes {
    static constexpr bool PERM = true, AFTER_DRAIN = false; static constexpr int NSEG = 1; static constexpr bool HALFB = false;
    const float* resid; float* hout; bf16_t* hb; float* ssout; float alpha;
    DI void operator()(const f32x4 (&acc)[2][2][4][2], const Unit& u, int wr, int wc, int fr, int fq) const {
#pragma unroll
        for (int ai = 0; ai < 2; ++ai)
#pragma unroll
            for (int m = 0; m < 4; ++m) {
                const int row = u.pm * 256 + ai * 128 + wr * 64 + m * 16 + fr;
                float sq = 0.f;
#pragma unroll
                for (int bj = 0; bj < 2; ++bj) {
                    const size_t off = (size_t)row * DM + u.pn * 256 + bj * 128 + wc * 32 + 8 * fq;
                    f32x4 v0 = *(const f32x4*)(resid + off) + acc[ai][bj][m][0] * alpha, v1 = *(const f32x4*)(resid + off + 4) + acc[ai][bj][m][1] * alpha;
                    *(f32x4*)(hout + off) = v0; *(f32x4*)(hout + off + 4) = v1;
                    if (hb) *(u32x4*)(hb + off) = pack8(v0, v1);
                    sq += (v0[0] * v0[0] + v0[1] * v0[1]) + (v0[2] * v0[2] + v0[3] * v0[3]) + (v1[0] * v1[0] + v1[1] * v1[1]) + (v1[2] * v1[2] + v1[3] * v1[3]);
                }
                sq += __shfl_xor(sq, 16); sq += __shfl_xor(sq, 32);
                if (fq == 0) atomicAdd(ssout + row, sq);
            }
    }
};
struct EpiWin {
    static constexpr bool PERM = true, AFTER_DRAIN = false; static constexpr int NSEG = 1; static constexpr bool HALFB = false;
    int row_base; const float* ss; bf16_t* zuq; bf16_t* xbc; bf16_t* gv; float* dt; const float* dt_bias; float* ssv;
    template <int KIND> DI void body(const f32x4 (&acc)[2][2][4][2], const Unit& u, int wr, int wc, int fr, int fq) const {
        const int pn = u.pn, cw = wc * 32 + 8 * fq;
#pragma unroll
        for (int ai = 0; ai < 2; ++ai)
#pragma unroll
            for (int m = 0; m < 4; ++m) {
                const int lr = u.pm * 256 + ai * 128 + wr * 64 + m * 16 + fr, gr = row_base + lr;
                const float r = rstd_of(ss[gr], 1.f / 1024.f);
                if (KIND == 0) {
#pragma unroll
                    for (int bj = 0; bj < 2; ++bj) { f32x4 a, b;
#pragma unroll
                        for (int e = 0; e < 4; ++e) { a[e] = silu(acc[ai][bj][m][0][e] * r); b[e] = silu(acc[ai][bj][m][1][e] * r); }
                        *(u32x4*)(zuq + (size_t)lr * ZUQ_LD + pn * 256 + bj * 128 + cw) = pack8(a, b); }
                } else if (KIND == 1) {
#pragma unroll
                    for (int bj = 0; bj < 2; ++bj) { f32x4 a = gelu4(acc[ai][bj][m][0] * r), b = gelu4(acc[ai][bj][m][1] * r);
                        *(u32x4*)(zuq + (size_t)lr * ZUQ_LD + pn * 256 + bj * 128 + cw) = pack8(a, b); }
                } else if (KIND == 2) {
#pragma unroll
                    for (int bj = 0; bj < 2; ++bj) { f32x4 a = acc[ai][bj][m][0] * (r * QSCALE), b = acc[ai][bj][m][1] * (r * QSCALE);
                        *(u32x4*)(zuq + (size_t)lr * ZUQ_LD + pn * 256 + bj * 128 + cw) = pack8(a, b); }
                } else if (KIND == 3) {
#pragma unroll
                    for (int bj = 0; bj < 2; ++bj) { f32x4 a = acc[ai][bj][m][0] * r, b = acc[ai][bj][m][1] * r;
                        *(u32x4*)(xbc + (size_t)lr * XBC_LD + (pn - 13) * 256 + bj * 128 + cw) = pack8(a, b); }
                } else if (KIND == 4) {
                    float sq = 0.f;
#pragma unroll
                    for (int bj = 0; bj < 2; ++bj) { f32x4 a = gelu4(acc[ai][bj][m][0] * r), b = gelu4(acc[ai][bj][m][1] * r);
                        sq += (a[0] * a[0] + a[1] * a[1]) + (a[2] * a[2] + a[3] * a[3]) + (b[0] * b[0] + b[1] * b[1]) + (b[2] * b[2] + b[3] * b[3]);
                        *(u32x4*)(gv + (size_t)lr * DM + (pn - 25) * 256 + bj * 128 + cw) = pack8(a, b); }
                    sq += __shfl_xor(sq, 16); sq += __shfl_xor(sq, 32);
                    if (fq == 0) atomicAdd(ssv + gr, sq);
                } else {
                    if (wc == 0) {
#pragma unroll
                        for (int n = 0; n < 2; ++n) { f32x4 o;
#pragma unroll
                            for (int e = 0; e < 4; ++e) o[e] = softplus(acc[ai][0][m][n][e] * r + dt_bias[8 * fq + 4 * n + e]);
                            *(f32x4*)(dt + (size_t)gr * 32 + 8 * fq + 4 * n) = o; }
                    }
                }
            }
    }
    DI void operator()(const f32x4 (&acc)[2][2][4][2], const Unit& u, int wr, int wc, int fr, int fq) const {
        const int pn = u.pn;
        if (pn < 8) body<0>(acc, u, wr, wc, fr, fq); else if (pn < 12) body<1>(acc, u, wr, wc, fr, fq); else if (pn == 12) body<2>(acc, u, wr, wc, fr, fq);
        else if (pn < 25) body<3>(acc, u, wr, wc, fr, fq); else if (pn < 29) body<4>(acc, u, wr, wc, fr, fq); else body<5>(acc, u, wr, wc, fr, fq);
    }
};
struct EpiGates {
    static constexpr bool PERM = true, AFTER_DRAIN = false; static constexpr int NSEG = 1; static constexpr bool HALFB = false;
    int row_base; const float* ss; bf16_t* O;
    DI void operator()(const f32x4 (&acc)[2][2][4][2], const Unit& u, int wr, int wc, int fr, int fq) const {
#pragma unroll
        for (int ai = 0; ai < 2; ++ai)
#pragma unroll
            for (int m = 0; m < 4; ++m) {
                const int lr = u.pm * 256 + ai * 128 + wr * 64 + m * 16 + fr;
                const float r = rstd_of(ss[row_base + lr], 1.f / 1024.f);
#pragma unroll
                for (int bj = 0; bj < 2; ++bj) { f32x4 a, b;
#pragma unroll
                    for (int e = 0; e < 4; ++e) { a[e] = sigm(acc[ai][bj][m][0][e] * r); b[e] = sigm(acc[ai][bj][m][1][e] * r); }
                    *(u32x4*)(O + (size_t)lr * GATE_LD + u.pn * 256 + bj * 128 + wc * 32 + 8 * fq) = pack8(a, b); }
            }
    }
};
struct EpiMerge {
    static constexpr bool PERM = true, AFTER_DRAIN = false, HALFB = true; static constexpr int NSEG = 3;
    const bf16_t* gates; float* run; bf16_t* O;
    static DI int seg_koff(int s) { return s == 0 ? 0 : (s == 1 ? 2048 : 3072); }
    static DI int seg_nt(int s) { return s == 0 ? 32 : (s == 1 ? 16 : 4); }
    DI void seg(const f32x4 (&acc)[2][2][4][2], const Unit& u, int wr, int wc, int fr, int fq) const {
        const int row0 = u.pm * 256 + wr * 64 + fr, cw = u.pn * 128 + wc * 32 + 8 * fq, s = u.seg;
#pragma unroll
        for (int ai = 0; ai < 2; ++ai)
#pragma unroll
            for (int m = 0; m < 4; ++m) {
                const int row = row0 + ai * 128 + m * 16;
                const u32x4 G = *(const u32x4*)(gates + (size_t)row * GATE_LD + s * 1024 + cw);
                float* rp = run + (size_t)row * DM + cw;
                f32x4 a = (f32x4){0.f, 0.f, 0.f, 0.f}, b = a;
                if (s > 0) { a = *(const f32x4*)rp; b = *(const f32x4*)(rp + 4); }
                a[0] += acc[ai][0][m][0][0] * bflo(G[0]); a[1] += acc[ai][0][m][0][1] * bfhi(G[0]); a[2] += acc[ai][0][m][0][2] * bflo(G[1]); a[3] += acc[ai][0][m][0][3] * bfhi(G[1]);
                b[0] += acc[ai][0][m][1][0] * bflo(G[2]); b[1] += acc[ai][0][m][1][1] * bfhi(G[2]); b[2] += acc[ai][0][m][1][2] * bflo(G[3]); b[3] += acc[ai][0][m][1][3] * bfhi(G[3]);
                *(f32x4*)rp = a; *(f32x4*)(rp + 4) = b;
            }
    }
    DI void operator()(const f32x4 (&acc)[2][2][4][2], const Unit& u, int wr, int wc, int fr, int fq) const {
        const int row0 = u.pm * 256 + wr * 64 + fr, cw = u.pn * 128 + wc * 32 + 8 * fq;
#pragma unroll
        for (int ai = 0; ai < 2; ++ai)
#pragma unroll
            for (int m = 0; m < 4; ++m) {
                const int row = row0 + ai * 128 + m * 16;
                const u32x4 G = *(const u32x4*)(gates + (size_t)row * GATE_LD + 2048 + cw);
                const float* rp = run + (size_t)row * DM + cw;
                f32x4 a = *(const f32x4*)rp, b = *(const f32x4*)(rp + 4);
                a[0] += acc[ai][0][m][0][0] * bflo(G[0]); a[1] += acc[ai][0][m][0][1] * bfhi(G[0]); a[2] += acc[ai][0][m][0][2] * bflo(G[1]); a[3] += acc[ai][0][m][0][3] * bfhi(G[1]);
                b[0] += acc[ai][0][m][1][0] * bflo(G[2]); b[1] += acc[ai][0][m][1][1] * bfhi(G[2]); b[2] += acc[ai][0][m][1][2] * bflo(G[3]); b[3] += acc[ai][0][m][1][3] * bfhi(G[3]);
                *(u32x4*)(O + (size_t)row * DM + cw) = pack8(a, b);
            }
    }
};

struct Frame {
    lptr lds; unsigned char* ws; const float* const* in; float* out;
    int tid, lane, wave, G, bid;
};
struct Args { const float* in[28]; float* out; unsigned char* ws; int ph_lo, ph_hi; };
enum { I_X = 0, I_MEM, I_F1N, I_F1G, I_F1U, I_F1D, I_MIXN, I_MEMN, I_WIN, I_CONVW, I_CONVB, I_DTB, I_ALOG, I_SSDD, I_SSDN, I_GVN, I_GWS, I_GBS, I_WKV, I_WBS, I_WBG, I_WBM, I_WOUT, I_F2N, I_F2G, I_F2U, I_F2D, I_FINN };

#define LDS_WAIT() asm volatile("s_waitcnt lgkmcnt(0)" ::: "memory")

#define XB_TMO      128
#define XB_XCNT(j)  (256  + 64 * (j))
#define XB_XSUB(j)  (1280 + 64 * (j))
#define XB_XGEN(j)  (2304 + 64 * (j))
#define XB_TOP      3328
#define XB_TOPGEN   3392
#define XCD_BAR_WORDS 3456
#define XB_SPIN_CAP (1u << 18)

__device__ __forceinline__ unsigned xb_ld(unsigned* p)              { return __hip_atomic_load(p, __ATOMIC_RELAXED, __HIP_MEMORY_SCOPE_AGENT); }
__device__ __forceinline__ unsigned xb_add(unsigned* p, unsigned v) { return __hip_atomic_fetch_add(p, v, __ATOMIC_RELAXED, __HIP_MEMORY_SCOPE_AGENT); }
__device__ __forceinline__ unsigned xb_xcc_id() { return (unsigned)__builtin_amdgcn_s_getreg((3 << 11) | 20) & 0xFu; }
#define XB_SPIN(cond, bar) do { unsigned _sp = 0; while (cond) { __builtin_amdgcn_s_sleep(1); \
    if ((++_sp & 255u) == 0u) { if (xb_ld(&(bar)[XB_TMO])) break; if (_sp > XB_SPIN_CAP) { atomicAdd(&(bar)[XB_TMO], 1u); break; } } } } while (0)

struct XcdBarrier {
    unsigned* bar; unsigned x;
    volatile LAS unsigned* st;
};

__device__ __forceinline__ XcdBarrier xcd_barrier_post(unsigned* bar, volatile LAS unsigned* st) {
    XcdBarrier b; b.bar = bar; b.x = xb_xcc_id(); b.st = st;
    if (threadIdx.x == 0) (void)xb_add(&bar[XB_XCNT(b.x)], 1u);
    return b;
}
__device__ __forceinline__ void xcd_barrier_complete(unsigned* bar, unsigned x, unsigned& nloc, unsigned& nx) {
    const unsigned G = gridDim.x * gridDim.y * gridDim.z;
    unsigned sum, cnt, mine, sp = 0u;
    for (;;) {
        sum = 0u; cnt = 0u; mine = 0u;
#pragma unroll
        for (unsigned j = 0; j < 16; ++j) { const unsigned c = xb_ld(&bar[XB_XCNT(j)]); sum += c; cnt += (c > 0u) ? 1u : 0u; mine = (j == x) ? c : mine; }
        if (sum == G) break;
        __builtin_amdgcn_s_sleep(1);
        if ((++sp & 255u) == 0u) { if (xb_ld(&bar[XB_TMO])) break; if (sp > XB_SPIN_CAP) { atomicAdd(&bar[XB_TMO], 1u); break; } }
    }
    nloc = mine > 0u ? mine : 1u; nx = cnt > 0u ? cnt : 1u;
}

__device__ __forceinline__ void xcd_barrier(const XcdBarrier& b) {
    asm volatile("s_waitcnt vmcnt(0)" ::: "memory");
    __syncthreads();
    if (threadIdx.x == 0) {
        unsigned* bar = b.bar;
        __builtin_amdgcn_s_waitcnt(0);
        unsigned nloc = b.st[0], nx = b.st[1];
        if (nloc == 0u) { xcd_barrier_complete(bar, b.x, nloc, nx); b.st[0] = nloc; b.st[1] = nx; }
        const unsigned old = xb_add(&bar[XB_XSUB(b.x)], 1u);
        const unsigned gen = old / nloc;
        if (old + 1u == (gen + 1u) * nloc) {
            __builtin_amdgcn_fence(__ATOMIC_RELEASE, "agent");
            asm volatile("s_waitcnt vmcnt(0)" ::: "memory");
            const unsigned og = xb_add(&bar[XB_TOP], 1u);
            const unsigned tg = og / nx;
            if (og + 1u == (tg + 1u) * nx) xb_add(&bar[XB_TOPGEN], 1u);
            else XB_SPIN(xb_ld(&bar[XB_TOPGEN]) == tg, bar);
            __builtin_amdgcn_fence(__ATOMIC_ACQUIRE, "agent");
            xb_add(&bar[XB_XGEN(b.x)], 1u);
            asm volatile("s_waitcnt vmcnt(0)" ::: "memory");
        } else {
            XB_SPIN(xb_ld(&bar[XB_XGEN(b.x)]) == gen, bar);
            __builtin_amdgcn_fence(__ATOMIC_ACQUIRE, "agent");
            asm volatile("s_waitcnt vmcnt(0)" ::: "memory");
        }
    }
    __syncthreads();
}


DI void tr_item(const float* W, int ldw, int col0, bf16_t* WT, int ldt, int dcol0, int drow0, const float* gain, LAS float* scr, int kb, int lane) {
    const int k0 = 64 * kb;
    float tv[32];
    const float* wp = W + (size_t)(k0 + (lane >> 5)) * ldw + col0 + (lane & 31);
#pragma unroll
    for (int i = 0; i < 32; ++i) tv[i] = wp[(size_t)(2 * i) * ldw];
    if (gain) {
#pragma unroll
        for (int i = 0; i < 32; ++i) tv[i] *= gain[k0 + 2 * i + (lane >> 5)];
    }
#pragma unroll
    for (int i = 0; i < 32; ++i) scr[(2 * i + (lane >> 5)) * 33 + (lane & 31)] = tv[i];
    LDS_WAIT();
    const int c = lane & 7;
#pragma unroll
    for (int j = 0; j < 4; ++j) { const int n = (lane >> 3) + 8 * j; const LAS float* s = scr + (8 * c) * 33 + n;
        u32x4 o; o.x = cvt_pk_bf16(s[0 * 33], s[1 * 33]); o.y = cvt_pk_bf16(s[2 * 33], s[3 * 33]); o.z = cvt_pk_bf16(s[4 * 33], s[5 * 33]); o.w = cvt_pk_bf16(s[6 * 33], s[7 * 33]);
        *(u32x4*)(WT + (size_t)(drow0 + n) * ldt + dcol0 + k0 + 8 * c) = o; }
    LDS_WAIT();
}
DI void kv_item(const Frame& F, int item) {
    const int rt = item >> 3, ct = item & 7, r0 = rt * 64, c0 = ct * 64, tid = F.tid, lane = F.lane, w = F.wave, fr = lane & 15, fq = lane >> 4;
    lptr As = F.lds, Bs = F.lds + 64 * PT; LAS float* rs = (LAS float*)(F.lds + 128 * PT);
    const float* mem = F.in[I_MEM]; const float* W = F.in[I_WKV]; const float* gain = F.in[I_MEMN];
    bf16_t* Kmem = (bf16_t*)(F.ws + WS_KMEM); bf16_t* VmemT = (bf16_t*)(F.ws + WS_VMEMT);
    const int ar = tid >> 3, ka = (tid & 7) * 16;
    const int kb = tid >> 2, nb = (tid & 3) * 16;
    const float* pa = mem + (size_t)(r0 + ar) * 1024 + ka; const float* pb = W + (size_t)kb * 512 + c0 + nb;
    float sq = 0.f;
    f32x4 acc[2]; acc[0] = (f32x4){0.f, 0.f, 0.f, 0.f}; acc[1] = acc[0];
    const bool ktype = ct < 4;
    f32x4 va[4], vb[4]; float gk;
#pragma unroll
    for (int i = 0; i < 4; ++i) { va[i] = *(const f32x4*)(pa + 4 * i); vb[i] = *(const f32x4*)(pb + 4 * i); }
    gk = gain[kb];
    for (int kc = 0; kc < 8; ++kc) {
#pragma unroll
        for (int i = 0; i < 4; ++i) sq += (va[i][0] * va[i][0] + va[i][1] * va[i][1]) + (va[i][2] * va[i][2] + va[i][3] * va[i][3]);
        *(LAS u32x4*)(As + ar * PT + ka * 2) = pack8(va[0], va[1]); *(LAS u32x4*)(As + ar * PT + ka * 2 + 16) = pack8(va[2], va[3]);
#pragma unroll
        for (int i = 0; i < 4; ++i) { const u32x2 pk = pack4(vb[i] * gk);
            *(LAS unsigned short*)(Bs + (nb + 4 * i + 0) * PT + kb * 2) = (unsigned short)(pk[0] & 0xffffu); *(LAS unsigned short*)(Bs + (nb + 4 * i + 1) * PT + kb * 2) = (unsigned short)(pk[0] >> 16);
            *(LAS unsigned short*)(Bs + (nb + 4 * i + 2) * PT + kb * 2) = (unsigned short)(pk[1] & 0xffffu); *(LAS unsigned short*)(Bs + (nb + 4 * i + 3) * PT + kb * 2) = (unsigned short)(pk[1] >> 16); }
        if (kc < 7) {
#pragma unroll
            for (int i = 0; i < 4; ++i) { va[i] = *(const f32x4*)(pa + (kc + 1) * 128 + 4 * i); vb[i] = *(const f32x4*)(pb + (size_t)(kc + 1) * 128 * 512 + 4 * i); }
            gk = gain[(kc + 1) * 128 + kb];
        }
        __syncthreads();
#pragma unroll
        for (int ks = 0; ks < 4; ++ks) {
            if (ktype) { const bf16x8 yf = *(const LAS bf16x8*)(As + (16 * (w >> 1) + fr) * PT + ks * 64 + fq * 16);
#pragma unroll
                for (int i = 0; i < 2; ++i) { const bf16x8 xf = *(const LAS bf16x8*)(Bs + (16 * ((w & 1) * 2 + i) + fr) * PT + ks * 64 + fq * 16); acc[i] = MFMA16(xf, yf, acc[i]); } }
            else { const bf16x8 yf = *(const LAS bf16x8*)(Bs + (16 * (w >> 1) + fr) * PT + ks * 64 + fq * 16);
#pragma unroll
                for (int i = 0; i < 2; ++i) { const bf16x8 xf = *(const LAS bf16x8*)(As + (16 * ((w & 1) * 2 + i) + fr) * PT + ks * 64 + fq * 16); acc[i] = MFMA16(xf, yf, acc[i]); } }
        }
        __syncthreads();
    }
    sq += __shfl_xor(sq, 1); sq += __shfl_xor(sq, 2); sq += __shfl_xor(sq, 4);
    if ((tid & 7) == 0) rs[ar] = rstd_of(sq, 1.f / 1024.f);
    __syncthreads();
    if (ktype) { const int tok = 16 * (w >> 1) + fr; const float r = rs[tok];
#pragma unroll
        for (int i = 0; i < 2; ++i) { const int ch = c0 + 16 * ((w & 1) * 2 + i) + 4 * fq; *(u32x2*)(Kmem + (size_t)(r0 + tok) * 256 + ch) = pack4(acc[i] * r); } }
    else { const int ch = c0 - 256 + 16 * (w >> 1) + fr;
#pragma unroll
        for (int i = 0; i < 2; ++i) { const int tok = 16 * ((w & 1) * 2 + i) + 4 * fq; f32x4 o;
#pragma unroll
            for (int e = 0; e < 4; ++e) o[e] = acc[i][e] * rs[tok + e];
            const int row = r0 + tok; *(u32x2*)(VmemT + (size_t)((row >> 8) * 256 + ch) * 256 + (row & 255)) = pack4(o); } }
    __syncthreads();
}
DI float wave_sum(float v) {
#pragma unroll
    for (int o = 1; o < 64; o <<= 1) v += __shfl_xor(v, o);
    return v;
}
#define SEG(Wp, ldw, c0, nc, Kk, WTp, ldt, dc0, gn, MAP) { const int nblk = (nc) / 32, cnt = ((Kk) / 64) * nblk; if (r < cnt) { const int kb = r / nblk, n0 = (r % nblk) * 32; \
        tr_item(Wp, ldw, (c0) + n0, WTp, ldt, dc0, (MAP), gn, scr, kb, lane); continue; } r -= cnt; }
DI void prologue(const Frame& F) {
    unsigned char* ws = F.ws;
    { u32x4* z = (u32x4*)(ws + WS_SS2); const int n = (int)((WS_CDEC - WS_SS2) / 16); for (int i = F.bid * 512 + F.tid; i < n; i += F.G * 512) z[i] = (u32x4){0u, 0u, 0u, 0u}; }
    LAS float* scr = (LAS float*)(F.lds + F.wave * 16384);
    const int gw = F.bid * 8 + F.wave, NGW = F.G * 8, lane = F.lane;
    bf16_t* W1GU = (bf16_t*)(ws + WS_W1GU);
    bf16_t* W1D = (bf16_t*)(ws + WS_W1D); bf16_t* WIN = (bf16_t*)(ws + WS_WIN);
    constexpr int NITEMS = 3 * 1408 + 16 * ((2048 + 1024 + 256 + 3072) / 32);
    for (int it = gw; it < NITEMS; it += NGW) {
        int r = it;
        SEG(F.in[I_F1G], FF, 0, FF, 1024, W1GU, 1024, 0, F.in[I_F1N], (n0 / 128) * 256 + (n0 % 128))
        SEG(F.in[I_F1U], FF, 0, FF, 1024, W1GU, 1024, 0, F.in[I_F1N], (n0 / 128) * 256 + 128 + (n0 % 128))
        SEG(F.in[I_F1D], 1024, 0, 1024, FF, W1D, FF, 0, (const float*)nullptr, n0)
        SEG(F.in[I_WIN], WIN_LD, 0, 2048, 1024, WIN, 1024, 0, F.in[I_MIXN], n0)
        SEG(F.in[I_WIN], WIN_LD, 5152, 1024, 1024, WIN, 1024, 0, F.in[I_MIXN], 2048 + n0)
        SEG(F.in[I_WIN], WIN_LD, 7200, 256, 1024, WIN, 1024, 0, F.in[I_MIXN], 3072 + n0)
        SEG(F.in[I_WIN], WIN_LD, 2048, 3072, 1024, WIN, 1024, 0, F.in[I_MIXN], 3328 + n0)
    }
    const float* x = F.in[I_X]; bf16_t* hb = (bf16_t*)(ws + WS_HB); float* ss1 = (float*)(ws + WS_SS1);
    for (int m = 2 * gw; m < T; m += 2 * NGW) {
        const f32x4* xr = (const f32x4*)(x + (size_t)m * DM) + lane; float s0 = 0.f, s1 = 0.f; f32x4 v[8];
#pragma unroll
        for (int j = 0; j < 8; ++j) v[j] = xr[64 * j];
#pragma unroll
        for (int j = 0; j < 4; ++j) { s0 += (v[j][0] * v[j][0] + v[j][1] * v[j][1]) + (v[j][2] * v[j][2] + v[j][3] * v[j][3]); s1 += (v[4 + j][0] * v[4 + j][0] + v[4 + j][1] * v[4 + j][1]) + (v[4 + j][2] * v[4 + j][2] + v[4 + j][3] * v[4 + j][3]); }
        s0 = wave_sum(s0); s1 = wave_sum(s1); if (lane == 0) { ss1[m] = s0; ss1[m + 1] = s1; }
        u32x2* o = (u32x2*)(hb + (size_t)m * DM) + lane;
#pragma unroll
        for (int j = 0; j < 8; ++j) o[64 * j] = pack4(v[j]);
    }
}
DI void mid_convert(const Frame& F, int first_blk) {
    unsigned char* ws = F.ws;
    if (F.bid - first_blk < 64) kv_item(F, F.bid - first_blk);
    LAS float* scr = (LAS float*)(F.lds + F.wave * 16384); const int lane = F.lane;
    const int gw = (F.bid - first_blk) * 8 + F.wave, NGW = (F.G - first_blk) * 8;
    bf16_t* W1D = (bf16_t*)(ws + WS_W1D); bf16_t* WIN = (bf16_t*)(ws + WS_WIN); bf16_t* WG = (bf16_t*)(ws + WS_WG); bf16_t* WBR = (bf16_t*)(ws + WS_WBR);
    constexpr int NITEMS = 16 * ((1024 + 32) / 32) + 16 * 96 + (32 + 16 + 4) * 32;
    for (int it = gw; it < NITEMS; it += NGW) {
        int r = it;
        SEG(F.in[I_WIN], WIN_LD, 6176, 1024, 1024, WIN, 1024, 0, F.in[I_MIXN], 6400 + n0)
        SEG(F.in[I_WIN], WIN_LD, 5120, 32, 1024, WIN, 1024, 0, F.in[I_MIXN], 7424 + n0)
        SEG(F.in[I_WIN], WIN_LD, 7456, 3072, 1024, WG, 1024, 0, F.in[I_MIXN], n0)
        SEG(F.in[I_WBS], 1024, 0, 1024, 2048, WBR, KBR, 0, F.in[I_SSDN], n0)
        SEG(F.in[I_WBG], 1024, 0, 1024, 1024, WBR, KBR, 2048, (const float*)nullptr, n0)
        SEG(F.in[I_WBM], 1024, 0, 1024, 256, WBR, KBR, 3072, (const float*)nullptr, n0)
    }
}
DI void late_convert(const Frame& F, int first_blk) {
    unsigned char* ws = F.ws; LAS float* scr = (LAS float*)(F.lds + F.wave * 16384); const int lane = F.lane;
    const int gw = (F.bid - first_blk) * 8 + F.wave, NGW = (F.G - first_blk) * 8;
    bf16_t* W2GU = (bf16_t*)(ws + WS_W2GU); bf16_t* W2D = (bf16_t*)(ws + WS_W2D); bf16_t* WOUT = (bf16_t*)(ws + WS_WOUT);
    constexpr int NITEMS = (3 * 1408) + 512;
    for (int it = gw; it < NITEMS; it += NGW) {
        int r = it;
        SEG(F.in[I_F2G], FF, 0, FF, 1024, W2GU, 1024, 0, F.in[I_F2N], (n0 / 128) * 256 + (n0 % 128))
        SEG(F.in[I_F2U], FF, 0, FF, 1024, W2GU, 1024, 0, F.in[I_F2N], (n0 / 128) * 256 + 128 + (n0 % 128))
        SEG(F.in[I_F2D], 1024, 0, 1024, FF, W2D, FF, 0, (const float*)nullptr, n0)
        SEG(F.in[I_WOUT], 1024, 0, 1024, 1024, WOUT, 1024, 0, (const float*)nullptr, n0)
    }
}
DI void final_norm(const Frame& F) {
    const float* ss4 = (const float*)(F.ws + WS_SS4); const float* g = F.in[I_FINN];
    const int gw = F.bid * 8 + F.wave, NGW = F.G * 8, lane = F.lane;
    f32x4 gv[4];
#pragma unroll
    for (int j = 0; j < 4; ++j) gv[j] = ((const f32x4*)g)[lane + 64 * j];
    for (int m = gw; m < T; m += NGW) {
        f32x4* xr = (f32x4*)(F.out + (size_t)m * DM) + lane; const float r = rstd_of(ss4[m], 1.f / 1024.f);
#pragma unroll
        for (int j = 0; j < 4; ++j) xr[64 * j] = xr[64 * j] * r * gv[j];
    }
}

DI void ssd_scan_prep(const Frame& F, const float* dt, int gr0, int h0, LAS float* acs, LAS float* dts, LAS float* wtot) {
    const int hl = F.tid >> 7, l = F.tid & 127, h = h0 + hl;
    const float a = -__expf(F.in[I_ALOG][h]);
    const float d = dt[(size_t)(gr0 + l) * 32 + h];
    float v = d * a;
#pragma unroll
    for (int o = 1; o < 64; o <<= 1) { const float t = __shfl_up(v, o); if (F.lane >= o) v += t; }
    if (F.lane == 63) wtot[F.wave] = v;
    __syncthreads();
    if (F.wave & 1) v += wtot[F.wave - 1];
    acs[hl * 128 + l] = v; dts[hl * 128 + l] = d;
    __syncthreads();
}
template <bool SCALED, int NCH> DI void stage_conv_T(lptr dst, const bf16_t* xbc, int t0, int chan0, const float* cw, const float* cb, const LAS float* scale, int tid) {
    constexpr int ncp = NCH >> 1, ntask = ncp * 16;
#pragma unroll 2
    for (int it_ = 0; it_ < ntask / 512; ++it_) { const int task = tid + 512 * it_;
        const int cp = task % ncp, tb = task / ncp, ch = chan0 + 2 * cp, l0 = tb * 8;
        float w[4][2];
#pragma unroll
        for (int k = 0; k < 4; ++k) { w[k][0] = cw[k * XBC_LD + ch]; w[k][1] = cw[k * XBC_LD + ch + 1]; }
        const float b0 = cb[ch], b1 = cb[ch + 1];
        float r0[11], r1[11];
#pragma unroll
        for (int i = 0; i < 11; ++i) { const int l = l0 - 3 + i; unsigned v = 0u; if (t0 + l >= 0) v = *(const unsigned*)(xbc + (long)(t0 + l) * XBC_LD + ch); r0[i] = bflo(v); r1[i] = bfhi(v); }
        f32x4 o0[2], o1[2];
#pragma unroll
        for (int j = 0; j < 8; ++j) {
            float y0 = b0 + w[0][0] * r0[j] + w[1][0] * r0[j + 1] + w[2][0] * r0[j + 2] + w[3][0] * r0[j + 3];
            float y1 = b1 + w[0][1] * r1[j] + w[1][1] * r1[j + 1] + w[2][1] * r1[j + 2] + w[3][1] * r1[j + 3];
            y0 = silu(y0); y1 = silu(y1);
            if (SCALED) { const float s = scale[((2 * cp) >> 6) * 128 + l0 + j]; y0 *= s; y1 *= s; }
            o0[j >> 2][j & 3] = y0; o1[j >> 2][j & 3] = y1;
        }
        *(LAS u32x4*)(dst + (2 * cp) * PT + l0 * 2) = pack8(o0[0], o0[1]);
        *(LAS u32x4*)(dst + (2 * cp + 1) * PT + l0 * 2) = pack8(o1[0], o1[1]);
    }
}
DI void stage_conv_N(lptr dst, const bf16_t* xbc, int t0, int chan0, const float* cw, const float* cb, int tid) {
    const int cg8 = (tid & 15) * 8, ch = chan0 + cg8;
    float w[4][8], b[8];
#pragma unroll
    for (int k = 0; k < 4; ++k) { const f32x4 a = *(const f32x4*)(cw + k * XBC_LD + ch), c = *(const f32x4*)(cw + k * XBC_LD + ch + 4);
#pragma unroll
        for (int e = 0; e < 4; ++e) { w[k][e] = a[e]; w[k][4 + e] = c[e]; } }
    { const f32x4 a = *(const f32x4*)(cb + ch), c = *(const f32x4*)(cb + ch + 4);
#pragma unroll
        for (int e = 0; e < 4; ++e) { b[e] = a[e]; b[4 + e] = c[e]; } }
#pragma unroll
    for (int i = 0; i < 4; ++i) {
        const int l = (tid >> 4) + 32 * i;
        float y[8];
#pragma unroll
        for (int e = 0; e < 8; ++e) y[e] = b[e];
#pragma unroll
        for (int k = 0; k < 4; ++k) { const int t = t0 + l - 3 + k; u32x4 v = (u32x4){0u, 0u, 0u, 0u}; if (t >= 0) v = *(const u32x4*)(xbc + (long)t * XBC_LD + ch);
#pragma unroll
            for (int q = 0; q < 4; ++q) { y[2 * q] += w[k][2 * q] * bflo(v[q]); y[2 * q + 1] += w[k][2 * q + 1] * bfhi(v[q]); } }
        f32x4 o0, o1;
#pragma unroll
        for (int e = 0; e < 4; ++e) { o0[e] = silu(y[e]); o1[e] = silu(y[4 + e]); }
        *(LAS u32x4*)(dst + l * PT + cg8 * 2) = pack8(o0, o1);
    }
}
struct Half { int b; bf16_t* zuq; bf16_t* xbc; bf16_t* gv; bf16_t* st; float* cdec; const float* dt; int row_base; };

DI void ssd_a_item(const Frame& F, const Half& H, int item) {
    const int c = item >> 3, g = (item >> 1) & 3, hh = item & 1, h0 = g * 8 + hh * 4, t0 = c * 128;
    lptr XT = F.lds, BT = F.lds + 69632; LAS float* acs = (LAS float*)(F.lds + 139264); LAS float* dts = acs + 512; LAS float* sc = dts + 512; LAS float* wtot = sc + 512;
    ssd_scan_prep(F, H.dt, H.row_base + t0, h0, acs, dts, wtot);
    { const int hl = F.tid >> 7, l = F.tid & 127; const float last = acs[hl * 128 + 127]; sc[hl * 128 + l] = dts[hl * 128 + l] * __expf(last - acs[hl * 128 + l]);
      if (l == 127) H.cdec[c * 32 + h0 + hl] = __expf(last); }
    __syncthreads();
    stage_conv_T<true, 256>(XT, H.xbc, t0, g * 512 + hh * 256, F.in[I_CONVW], F.in[I_CONVB], sc, F.tid);
    stage_conv_T<false, 128>(BT, H.xbc, t0, 2048 + g * 128, F.in[I_CONVW], F.in[I_CONVB], nullptr, F.tid);
    __syncthreads();
    const int w = F.wave, hl = w >> 1, nh = w & 1, fr = F.lane & 15, fq = F.lane >> 4;
    f32x4 acc[4][4];
#pragma unroll
    for (int i = 0; i < 4; ++i)
#pragma unroll
        for (int j = 0; j < 4; ++j) acc[i][j] = (f32x4){0.f, 0.f, 0.f, 0.f};
#pragma unroll
    for (int ks = 0; ks < 4; ++ks) {
        bf16x8 xf[4], yf[4];
#pragma unroll
        for (int i = 0; i < 4; ++i) { xf[i] = *(const LAS bf16x8*)(BT + (nh * 64 + 16 * i + fr) * PT + ks * 64 + fq * 16); yf[i] = *(const LAS bf16x8*)(XT + (hl * 64 + 16 * i + fr) * PT + ks * 64 + fq * 16); }
#pragma unroll
        for (int i = 0; i < 4; ++i)
#pragma unroll
            for (int j = 0; j < 4; ++j) acc[i][j] = MFMA16(xf[i], yf[j], acc[i][j]);
    }
    bf16_t* dst = H.st + (size_t)(c * 32 + h0 + hl) * 8192;
#pragma unroll
    for (int i = 0; i < 4; ++i)
#pragma unroll
        for (int j = 0; j < 4; ++j) *(u32x2*)(dst + (16 * j + fr) * 128 + nh * 64 + 16 * i + 4 * fq) = pack4(acc[i][j]);
    __syncthreads();
}
DI void ssd_scan(const Frame& F, const Half& H) {
    for (int e = F.bid * 512 + F.tid; e < 131072; e += F.G * 512) {
        const int h = e >> 12; unsigned* p = (unsigned*)H.st + e; float r0 = 0.f, r1 = 0.f;
#pragma unroll 8
        for (int c = 0; c < 64; ++c) { const unsigned wv = p[(size_t)c * 131072]; const float dec = H.cdec[c * 32 + h]; p[(size_t)c * 131072] = cvt_pk_bf16(r0, r1); r0 = r0 * dec + bflo(wv); r1 = r1 * dec + bfhi(wv); }
    }
}
DI void ssd_c_item(const Frame& F, const Half& H, int item) {
    const int c = item >> 2, g = item & 3, t0 = c * 128;
    lptr XT = F.lds, Cn = F.lds + 69632, Bn = F.lds + 104448; LAS float* acs = (LAS float*)(F.lds + 139264); LAS float* dts = acs + 512; LAS float* wtot = dts + 512; LAS float* tss = wtot + 16;
    stage_conv_N(Bn, H.xbc, t0, 2048 + g * 128, F.in[I_CONVW], F.in[I_CONVB], F.tid);
    stage_conv_N(Cn, H.xbc, t0, 2560 + g * 128, F.in[I_CONVW], F.in[I_CONVB], F.tid);
    __syncthreads();
    const int w = F.wave, fr = F.lane & 15, fq = F.lane >> 4;
    {
        const int lt0 = (w >> 1) * 2, st0 = (w & 1) * 4;
        f32x4 cb[4][2];
#pragma unroll
        for (int i = 0; i < 4; ++i) { cb[i][0] = (f32x4){0.f, 0.f, 0.f, 0.f}; cb[i][1] = cb[i][0]; }
#pragma unroll
        for (int ks = 0; ks < 4; ++ks) {
            bf16x8 xf[4], yf[2];
#pragma unroll
            for (int i = 0; i < 4; ++i) xf[i] = *(const LAS bf16x8*)(Bn + (16 * (st0 + i) + fr) * PT + ks * 64 + fq * 16);
#pragma unroll
            for (int j = 0; j < 2; ++j) yf[j] = *(const LAS bf16x8*)(Cn + (16 * (lt0 + j) + fr) * PT + ks * 64 + fq * 16);
#pragma unroll
            for (int i = 0; i < 4; ++i)
#pragma unroll
                for (int j = 0; j < 2; ++j) cb[i][j] = MFMA16(xf[i], yf[j], cb[i][j]);
        }
        __syncthreads();
#pragma unroll
        for (int i = 0; i < 4; ++i)
#pragma unroll
            for (int j = 0; j < 2; ++j) *(LAS u32x2*)(Bn + (16 * (lt0 + j) + fr) * PT + (16 * (st0 + i) + 4 * fq) * 2) = pack4(cb[i][j]);
    }
    const int hl = w >> 1, lh = w & 1;
#pragma unroll 1
    for (int hh = 0; hh < 2; ++hh) {
        const int h0 = g * 8 + hh * 4, h = h0 + hl;
        __syncthreads();
        ssd_scan_prep(F, H.dt, H.row_base + t0, h0, acs, dts, wtot);
        stage_conv_T<false, 256>(XT, H.xbc, t0, g * 512 + hh * 256, F.in[I_CONVW], F.in[I_CONVB], nullptr, F.tid);
        __syncthreads();
        f32x4 accd[4][4];
#pragma unroll
        for (int i = 0; i < 4; ++i)
#pragma unroll
            for (int j = 0; j < 4; ++j) accd[i][j] = (f32x4){0.f, 0.f, 0.f, 0.f};
        const LAS float* ah = acs + hl * 128; const LAS float* dh = dts + hl * 128;
        const bf16_t* Sp = H.st + (size_t)(c * 32 + h) * 8192;
#pragma unroll
        for (int ks = 0; ks < 4; ++ks) {
            bf16x8 xf[4], yf[4];
#pragma unroll
            for (int i = 0; i < 4; ++i) { xf[i] = *(const bf16x8*)(Sp + (16 * i + fr) * 128 + ks * 32 + fq * 8); yf[i] = *(const LAS bf16x8*)(Cn + (lh * 64 + 16 * i + fr) * PT + ks * 64 + fq * 16); }
#pragma unroll
            for (int i = 0; i < 4; ++i)
#pragma unroll
                for (int j = 0; j < 4; ++j) accd[i][j] = MFMA16(xf[i], yf[j], accd[i][j]);
        }
#pragma unroll
        for (int j = 0; j < 4; ++j) { const float el = __expf(ah[lh * 64 + 16 * j + fr]);
#pragma unroll
            for (int i = 0; i < 4; ++i) accd[i][j] = accd[i][j] * el; }
        const int nks = lh ? 4 : 2;
        for (int ks = 0; ks < nks; ++ks) {
            bf16x8 xf[4], yf[4];
            const int s0 = ks * 32 + fq * 8;
            const f32x4 as0 = *(const LAS f32x4*)(ah + s0), as1 = *(const LAS f32x4*)(ah + s0 + 4), ds0 = *(const LAS f32x4*)(dh + s0), ds1 = *(const LAS f32x4*)(dh + s0 + 4);
#pragma unroll
            for (int j = 0; j < 4; ++j) {
                const int l = lh * 64 + 16 * j + fr; const float al = ah[l];
                const u32x4 cbv = *(const LAS u32x4*)(Bn + l * PT + s0 * 2);
                f32x4 o0, o1;
#pragma unroll
                for (int q = 0; q < 4; ++q) {
                    const int sa = s0 + 2 * q, sb = sa + 1;
                    const float asa = (q < 2) ? as0[2 * q] : as1[2 * q - 4], asb = (q < 2) ? as0[2 * q + 1] : as1[2 * q - 3];
                    const float dsa = (q < 2) ? ds0[2 * q] : ds1[2 * q - 4], dsb = (q < 2) ? ds0[2 * q + 1] : ds1[2 * q - 3];
                    const float va = (sa <= l) ? bflo(cbv[q]) * __expf(al - asa) * dsa : 0.f;
                    const float vb = (sb <= l) ? bfhi(cbv[q]) * __expf(al - asb) * dsb : 0.f;
                    if (q < 2) { o0[2 * q] = va; o0[2 * q + 1] = vb; } else { o1[2 * q - 4] = va; o1[2 * q - 3] = vb; }
                }
                yf[j] = __builtin_bit_cast(bf16x8, pack8(o0, o1));
            }
#pragma unroll
            for (int i = 0; i < 4; ++i) xf[i] = *(const LAS bf16x8*)(XT + (hl * 64 + 16 * i + fr) * PT + ks * 64 + fq * 16);
#pragma unroll
            for (int i = 0; i < 4; ++i)
#pragma unroll
                for (int j = 0; j < 4; ++j) accd[i][j] = MFMA16(xf[i], yf[j], accd[i][j]);
        }
        const float Dh = F.in[I_SSDD][h];
#pragma unroll
        for (int j = 0; j < 4; ++j) {
            const int l = lh * 64 + 16 * j + fr; float sq = 0.f;
            bf16_t* zr = H.zuq + (size_t)(t0 + l) * ZUQ_LD + h * 64;
#pragma unroll
            for (int i = 0; i < 4; ++i) {
                const int p = 16 * i + 4 * fq;
                const u32x2 zv = *(const u32x2*)(zr + p);
                f32x4 y;
#pragma unroll
                for (int e = 0; e < 4; ++e) { const float xv = __uint_as_float(((unsigned)*(const LAS unsigned short*)(XT + (hl * 64 + p + e) * PT + l * 2)) << 16); y[e] = accd[i][j][e] + Dh * xv; }
                y[0] *= bflo(zv[0]); y[1] *= bfhi(zv[0]); y[2] *= bflo(zv[1]); y[3] *= bfhi(zv[1]);
                sq += (y[0] * y[0] + y[1] * y[1]) + (y[2] * y[2] + y[3] * y[3]);
                *(u32x2*)(zr + p) = pack4(y);
            }
            sq += __shfl_xor(sq, 16); sq += __shfl_xor(sq, 32);
            if (fq == 0) tss[(hh * 4 + hl) * 128 + l] = sq;
        }
    }
    __syncthreads();
    {
        const int l = F.tid >> 2, qd = F.tid & 3; float tsum = 0.f;
#pragma unroll
        for (int k = 0; k < 8; ++k) tsum += tss[k * 128 + l];
        const float r = rstd_of(tsum, 1.f / 512.f);
        u32x4* p = (u32x4*)(H.zuq + (size_t)(t0 + l) * ZUQ_LD + g * 512 + qd * 128);
#pragma unroll
        for (int i = 0; i < 16; ++i) { const u32x4 v = p[i]; f32x4 a, b; a[0] = bflo(v[0]) * r; a[1] = bfhi(v[0]) * r; a[2] = bflo(v[1]) * r; a[3] = bfhi(v[1]) * r; b[0] = bflo(v[2]) * r; b[1] = bfhi(v[2]) * r; b[2] = bflo(v[3]) * r; b[3] = bfhi(v[3]) * r; p[i] = pack8(a, b); }
    }
    __syncthreads();
}


DI void gmlp_item(const Frame& F, const Half& H, int item) {
    const int c = item >> 3, g = item & 7, t0 = c * 128, d0 = g * 128, tid = F.tid;
    lptr VT = F.lds, WS = F.lds + 34816; LAS float* rv = (LAS float*)(F.lds + 69632);
    const float* ssv = (const float*)(F.ws + WS_SSV);
    if (tid < 128) rv[tid] = rstd_of(ssv[H.row_base + t0 + tid], 1.f / 1024.f);
    __syncthreads();
#pragma unroll
    for (int i = 0; i < 4; ++i) {
        const int v = tid + 512 * i, s = v >> 4, seg = v & 15;
        const u32x4 pk = *(const u32x4*)(H.gv + (size_t)(t0 + s) * DM + d0 + seg * 8);
#pragma unroll
        for (int e = 0; e < 8; ++e) { const unsigned short hv = (unsigned short)((e & 1) ? (pk[e >> 1] >> 16) : (pk[e >> 1] & 0xffffu)); *(LAS unsigned short*)(VT + (seg * 8 + e) * PT + s * 2) = hv; }
        const int t = s, s0 = seg * 8;
        const float* wp = F.in[I_GWS] + (size_t)(g * 128 + t) * 128 + s0; const f32x4 w0 = *(const f32x4*)wp, w1 = *(const f32x4*)(wp + 4);
        f32x4 o0, o1;
#pragma unroll
        for (int e = 0; e < 4; ++e) { o0[e] = (s0 + e <= t) ? w0[e] * rv[s0 + e] : 0.f; o1[e] = (s0 + 4 + e <= t) ? w1[e] * rv[s0 + 4 + e] : 0.f; }
        *(LAS u32x4*)(WS + t * PT + s0 * 2) = pack8(o0, o1);
    }
    __syncthreads();
    const int w = F.wave, fr = F.lane & 15, fq = F.lane >> 4, mtb = (w & 3) * 2, ntb = (w >> 2) * 4;
    f32x4 acc[2][4];
#pragma unroll
    for (int i = 0; i < 2; ++i)
#pragma unroll
        for (int j = 0; j < 4; ++j) acc[i][j] = (f32x4){0.f, 0.f, 0.f, 0.f};
    const int nks = ntb ? 4 : 2;
    for (int ks = 0; ks < nks; ++ks) {
        bf16x8 xf[2], yf[4];
#pragma unroll
        for (int i = 0; i < 2; ++i) xf[i] = *(const LAS bf16x8*)(VT + (16 * (mtb + i) + fr) * PT + ks * 64 + fq * 16);
#pragma unroll
        for (int j = 0; j < 4; ++j) yf[j] = *(const LAS bf16x8*)(WS + (16 * (ntb + j) + fr) * PT + ks * 64 + fq * 16);
#pragma unroll
        for (int i = 0; i < 2; ++i)
#pragma unroll
            for (int j = 0; j < 4; ++j) acc[i][j] = MFMA16(xf[i], yf[j], acc[i][j]);
    }
#pragma unroll
    for (int j = 0; j < 4; ++j) {
        const int t = 16 * (ntb + j) + fr; const float bias = F.in[I_GBS][g * 128 + t];
#pragma unroll
        for (int i = 0; i < 2; ++i) {
            const int d = d0 + 16 * (mtb + i) + 4 * fq;
            const f32x4 gn = *(const f32x4*)(F.in[I_GVN] + d);
            bf16_t* up = H.zuq + (size_t)(t0 + t) * ZUQ_LD + 2048 + d;
            const u32x2 uv = *(const u32x2*)up;
            f32x4 y;
            y[0] = bflo(uv[0]) * (gn[0] * acc[i][j][0] + bias); y[1] = bfhi(uv[0]) * (gn[1] * acc[i][j][1] + bias);
            y[2] = bflo(uv[1]) * (gn[2] * acc[i][j][2] + bias); y[3] = bfhi(uv[1]) * (gn[3] * acc[i][j][3] + bias);
            *(u32x2*)up = pack4(y);
        }
    }
    __syncthreads();
}
DI void memattn_item(const Frame& F, const Half& H, int item) {
    const int h = item & 3, t0 = (item >> 2) * 128, tid = F.tid, w = F.wave, fr = F.lane & 15, fq = F.lane >> 4;
    lptr Ks = F.lds, VT = F.lds + 36864, Pw = F.lds + 70656 + w * 8448;
    const bf16_t* Kmem = (const bf16_t*)(F.ws + WS_KMEM) + (size_t)H.b * 256 * 256; const bf16_t* VmemT = (const bf16_t*)(F.ws + WS_VMEMT) + (size_t)H.b * 256 * 256;
#pragma unroll
    for (int i = 0; i < 4; ++i) {
        const int v = tid + 512 * i;
        { const int m = v >> 3, seg = v & 7; *(LAS u32x4*)(Ks + m * 144 + seg * 16) = *(const u32x4*)(Kmem + (size_t)m * 256 + h * 64 + seg * 8); }
        { const int d = v >> 5, seg = v & 31; *(LAS u32x4*)(VT + d * 528 + seg * 16) = *(const u32x4*)(VmemT + (size_t)(h * 64 + d) * 256 + seg * 8); }
    }
    __syncthreads();
    for (int sub = 0; sub < 1; ++sub) {
        const int tw = t0 + sub * 128 + w * 16;
        bf16_t* qrow = H.zuq + (size_t)(tw + fr) * ZUQ_LD + 3072 + h * 64;
        bf16x8 qf[2];
        qf[0] = *(const bf16x8*)(qrow + fq * 8); qf[1] = *(const bf16x8*)(qrow + 32 + fq * 8);
        f32x4 s[16];
#pragma unroll
        for (int i = 0; i < 16; ++i) { s[i] = (f32x4){0.f, 0.f, 0.f, 0.f};
#pragma unroll
            for (int ks = 0; ks < 2; ++ks) { const bf16x8 kf = *(const LAS bf16x8*)(Ks + (16 * i + fr) * 144 + ks * 64 + fq * 16); s[i] = MFMA16(kf, qf[ks], s[i]); } }
        float mx = -3.0e38f;
#pragma unroll
        for (int i = 0; i < 16; ++i) mx = fmaxf(mx, fmaxf(fmaxf(s[i][0], s[i][1]), fmaxf(s[i][2], s[i][3])));
        mx = fmaxf(mx, __shfl_xor(mx, 16)); mx = fmaxf(mx, __shfl_xor(mx, 32));
        float sum = 0.f;
#pragma unroll
        for (int i = 0; i < 16; ++i) { f32x4 p;
#pragma unroll
            for (int e = 0; e < 4; ++e) { p[e] = __builtin_amdgcn_exp2f(s[i][e] - mx); sum += p[e]; }
            *(LAS u32x2*)(Pw + fr * 528 + (16 * i + 4 * fq) * 2) = pack4(p); }
        sum += __shfl_xor(sum, 16); sum += __shfl_xor(sum, 32);
        LDS_WAIT(); __builtin_amdgcn_wave_barrier();
        f32x4 o[4];
#pragma unroll
        for (int i = 0; i < 4; ++i) o[i] = (f32x4){0.f, 0.f, 0.f, 0.f};
#pragma unroll
        for (int ks = 0; ks < 8; ++ks) { const bf16x8 pf = *(const LAS bf16x8*)(Pw + fr * 528 + ks * 64 + fq * 16);
#pragma unroll
            for (int i = 0; i < 4; ++i) { const bf16x8 vf = *(const LAS bf16x8*)(VT + (16 * i + fr) * 528 + ks * 64 + fq * 16); o[i] = MFMA16(vf, pf, o[i]); } }
        const float inv = __builtin_amdgcn_rcpf(sum);
#pragma unroll
        for (int i = 0; i < 4; ++i) *(u32x2*)(qrow + 16 * i + 4 * fq) = pack4(o[i] * inv);
        LDS_WAIT(); __builtin_amdgcn_wave_barrier();
    }
    __syncthreads();
}

#define PH_GEMM(EpiT, Aptr, Bptr, Mm, Nn, Kk, Eobj) do { pg8::Gemm g_{(const bf16_t*)(Aptr), (const bf16_t*)(Bptr), Mm, Nn, Kk}; pg8::StaticOrder S_; S_.init(Mm, Nn, F.G, F.bid); \
        pg8::gemm_phase<EpiT, pg8::StaticOrder, true, true>(F.lds, g_, S_, Eobj); } while (0)

__global__ void __launch_bounds__(512) mega_fwd(Args args) {
    extern __shared__ __attribute__((aligned(16))) unsigned char lds_raw[];
    cg::grid_group grid = cg::this_grid();
    Frame F; F.lds = (lptr)lds_raw; F.ws = args.ws; F.in = args.in; F.out = args.out;
    F.tid = threadIdx.x; F.lane = F.tid & 63; F.wave = __builtin_amdgcn_readfirstlane(F.tid >> 6); F.G = gridDim.x; F.bid = blockIdx.x;
    unsigned char* ws = args.ws;
    const int lo = args.ph_lo, hi = args.ph_hi;
    { volatile LAS unsigned* st_ = (volatile LAS unsigned*)(F.lds + LDS_BARST); if (F.tid < 2) st_[F.tid] = 0u; }
    __syncthreads();
    XcdBarrier xbar; xbar.bar = (unsigned*)(ws + WS_BAR); xbar.x = 0; xbar.st = nullptr;
    if (hi - lo > 1) grid.sync();
    if (hi - lo > 1) xbar = xcd_barrier_post((unsigned*)(ws + WS_BAR), (volatile LAS unsigned*)(F.lds + LDS_BARST));
#define HB ((bf16_t*)(ws + WS_HB))
#define ACT ((bf16_t*)(ws + WS_ACT))
#define MG ((bf16_t*)(ws + WS_MG))
#define SS1 ((float*)(ws + WS_SS1))
#define SS2 ((float*)(ws + WS_SS2))
#define SS3 ((float*)(ws + WS_SS3))
#define SS4 ((float*)(ws + WS_SS4))
#ifndef PHMASK
#define PHMASK 0xFFFFFFFFu
#endif
#define RELAUNDER() do { int t_ = threadIdx.x; asm volatile("" : "+v"(t_)); F.tid = t_; F.lane = t_ & 63; F.wave = __builtin_amdgcn_readfirstlane(t_ >> 6); \
        unsigned long long w_ = (unsigned long long)args.ws; asm volatile("" : "+s"(w_)); ws = (unsigned char*)w_; F.ws = ws; } while (0)
#define IN(k) (((PHMASK >> ((k) > 8 ? (k) - 6 : (k))) & 1u) && lo <= (k) && (k) < hi)
#define SEAM(k) do { if ((k) + 1 < hi) { xcd_barrier(xbar); } } while (0)

    if (IN(0)) { RELAUNDER(); prologue(F); SEAM(0); }
    if (IN(1)) { RELAUNDER(); EpiGLU E{SS1, ACT}; PH_GEMM(EpiGLU, HB, ws + WS_W1GU, T, 2 * FF, DM, E);
        if (F.G >= 256) { if (F.bid >= 128) mid_convert(F, 128); } else mid_convert(F, 0);
        SEAM(1); }
    if (IN(2)) { RELAUNDER(); EpiRes E{F.in[I_X], F.out, HB, SS2, 0.5f}; PH_GEMM(EpiRes, ACT, ws + WS_W1D, T, DM, FF, E); SEAM(2); }
#pragma unroll 1
    for (int b = 0; b < 2; ++b) {
        const int k0 = 3 + 6 * b;
#define MKHALF() Half H; H.b = b; H.zuq = (bf16_t*)(ws + WS_ZUQ); H.xbc = (bf16_t*)(ws + WS_XBC); H.gv = MG + (size_t)TB * DM; H.st = (bf16_t*)(ws + WS_ST); H.cdec = (float*)(ws + WS_CDEC) + b * 2048; H.dt = (const float*)(ws + WS_DT); H.row_base = b * TB;
        if (IN(k0)) { RELAUNDER(); MKHALF(); EpiWin E{H.row_base, SS2, H.zuq, H.xbc, H.gv, (float*)(ws + WS_DT), F.in[I_DTB], (float*)(ws + WS_SSV)};
            PH_GEMM(EpiWin, HB + (size_t)H.row_base * DM, ws + WS_WIN, TB, NWIN, DM, E); SEAM(k0); }
        if (IN(k0 + 1)) { RELAUNDER(); MKHALF();
            for (int it = F.bid; it < 512 + 512 + 256; it += F.G) {
                if (it < 512) ssd_a_item(F, H, it); else if (it < 1024) gmlp_item(F, H, it - 512); else memattn_item(F, H, it - 1024);
            }
            SEAM(k0 + 1); }
        if (IN(k0 + 2)) { RELAUNDER(); MKHALF(); ssd_scan(F, H); SEAM(k0 + 2); }
        if (IN(k0 + 3)) { RELAUNDER(); MKHALF(); for (int it = F.bid; it < 256; it += F.G) ssd_c_item(F, H, it); SEAM(k0 + 3); }
        if (IN(k0 + 4)) { RELAUNDER(); MKHALF(); if (b == 0) { if (F.G >= 256) { if (F.bid >= 128) late_convert(F, 128); } else late_convert(F, 0); __syncthreads(); }
            EpiGates E{H.row_base, SS2, H.xbc}; PH_GEMM(EpiGates, HB + (size_t)H.row_base * DM, ws + WS_WG, TB, GATE_LD, DM, E); SEAM(k0 + 4); }
        if (IN(k0 + 5)) { RELAUNDER(); MKHALF(); EpiMerge E{H.xbc, (float*)(ws + WS_ST), MG + (size_t)b * TB * DM};
            { pg8::Gemm g_{(const bf16_t*)H.zuq, (const bf16_t*)(ws + WS_WBR), TB, DM, KBR}; pg8::SegOrder<3> S_; S_.init(TB, 2 * DM, F.G, F.bid);     pg8::gemm_phase<EpiMerge, pg8::SegOrder<3>, true, true>(F.lds, g_, S_, E); } SEAM(k0 + 5); }
    }
    if (IN(15)) { RELAUNDER(); EpiRes E{F.out, F.out, HB, SS3, 1.0f}; PH_GEMM(EpiRes, MG, ws + WS_WOUT, T, DM, DM, E); SEAM(15); }
    if (IN(16)) { RELAUNDER(); EpiGLU E{SS3, ACT}; PH_GEMM(EpiGLU, HB, ws + WS_W2GU, T, 2 * FF, DM, E); SEAM(16); }
    if (IN(17)) { RELAUNDER(); EpiRes E{F.out, F.out, (bf16_t*)nullptr, SS4, 0.5f}; PH_GEMM(EpiRes, ACT, ws + WS_W2D, T, DM, FF, E); SEAM(17); }
    if (IN(18)) { RELAUNDER(); final_norm(F); }
}

#ifndef N_PHASES
#define N_PHASES 19
#endif
#ifndef ONE_LAUNCH
#define ONE_LAUNCH 1
#endif
extern "C" void kernel_launch(void* const* d_in, const int* in_sizes, int n_in, void* d_out, int out_size, void* d_ws, size_t ws_size, hipStream_t stream) {
    static int grid = 0;
    if (grid == 0) {
        int dev = 0, cus = 0, per_cu = 0;
        hipGetDevice(&dev); hipDeviceGetAttribute(&cus, hipDeviceAttributeMultiprocessorCount, dev);
        if (hipFuncSetAttribute((const void*)mega_fwd, hipFuncAttributeMaxDynamicSharedMemorySize, LDS_BYTES) != hipSuccess) { fprintf(stderr, "kernel_launch: hipFuncSetAttribute failed\n"); grid = -1; return; }
        if (hipOccupancyMaxActiveBlocksPerMultiprocessor(&per_cu, (const void*)mega_fwd, 512, LDS_BYTES) != hipSuccess || per_cu < 1) { fprintf(stderr, "kernel_launch: occupancy query says %d\n", per_cu); per_cu = 1; }
        (void)hipGetLastError();
        grid = cus;
        if (n_in != 28 || ws_size < WS_END) { fprintf(stderr, "kernel_launch: unexpected n_in %d / ws %zu\n", n_in, ws_size); grid = -1; return; }
    }
    if (grid < 0) return;
    if (hipMemsetAsync((char*)d_ws + WS_BAR, 0, BAR_BYTES, stream) != hipSuccess) { fprintf(stderr, "kernel_launch: memset failed\n"); return; }
    Args a{};
    for (int i = 0; i < 28; ++i) a.in[i] = (const float*)d_in[i];
    a.out = (float*)d_out; a.ws = (unsigned char*)d_ws;
#if ONE_LAUNCH
    a.ph_lo = 0; a.ph_hi = N_PHASES;
    void* kargs[] = {&a};
    hipError_t e = hipLaunchCooperativeKernel((const void*)mega_fwd, dim3(grid), dim3(512), kargs, LDS_BYTES, stream);
    if (e != hipSuccess) fprintf(stderr, "cooperative launch failed: %s (grid %d)\n", hipGetErrorString(e), grid);
#else
    for (int k = 0; k < N_PHASES; ++k) { a.ph_lo = k; a.ph_hi = k + 1; hipLaunchKernelGGL(mega_fwd, dim3(grid), dim3(512), LDS_BYTES, stream, a); }
#endif
}
```

```cpp
#include <hip/hip_runtime.h>
#include <hip/hip_cooperative_groups.h>
#include <cstdio>
#include <cstdint>
namespace cg = cooperative_groups;
namespace pg8 {
#define PG8_LAS __attribute__((address_space(3)))
typedef unsigned short bf16_t;
typedef short bf16x8 __attribute__((ext_vector_type(8)));
typedef float f32x4 __attribute__((ext_vector_type(4)));
typedef unsigned u32x4 __attribute__((ext_vector_type(4)));
constexpr int BM = 256, BK = 64, HALF = 128, HTB = HALF * BK * 2  , STAGE_BYTES = 8 * HTB, NXCD = 8, WGM = 8;

__host__ __device__ __forceinline__ int lds_byte(int r, int c) { const int st = (r >> 4) * 2 + (c >> 5), rr = r & 15, cc = c & 31, ob = rr * 64 + cc * 2; return st * 1024 + (ob ^ (((ob >> 9) & 1) << 5)); }
__host__ __device__ __forceinline__ void stage_rc(int b, int& R, int& C) { const int st = b / 1024, sb = b % 1024, swz = sb ^ (((sb >> 9) & 1) << 5); R = (st >> 1) * 16 + swz / 64; C = (st & 1) * 32 + (swz % 64) / 2; }
__host__ __device__ __forceinline__ int perm32(int rho) { const int n = rho >> 4, i = rho & 15; return 8 * (i >> 2) + 4 * n + (i & 3); }

struct Unit { int pm, pn, seg; };
struct Gemm { const bf16_t* A; const bf16_t* Bt; int M, N, K; };

struct StaticOrder {
    int nM, nN, nwg, G, c;
    __host__ __device__ void init(int M, int N, int G_, int c_) { nM = M / BM; nN = N / BM; nwg = nM * nN; G = G_; c = c_; }
    __host__ __device__ bool next(int i, Unit& u) const {
        const long L = (long)i * G + c; if (L >= nwg) return false;
        int wgid = (int)L; { const int q = nwg / NXCD, r = nwg % NXCD, xcd = wgid % NXCD, off = wgid / NXCD; wgid = (xcd < r ? xcd * (q + 1) : r * (q + 1) + (xcd - r) * q) + off; }
        const int nig = WGM * nN, gid = wgid / nig, fm = gid * WGM, gsz = (nM - fm) < WGM ? (nM - fm) : WGM;
        u.pm = fm + ((wgid % nig) % gsz); u.pn = (wgid % nig) / gsz; u.seg = 0; return true;
    }
    __device__ __forceinline__ void a_ready(const Unit&) const {}
    __device__ __forceinline__ void done(const Unit&) const {}
};

template <int NSEG> struct SegOrder {
    StaticOrder base;
    __host__ __device__ void init(int M, int N, int G_, int c_) { base.init(M, N, G_, c_); }
    __host__ __device__ bool next(int i, Unit& u) const { if (!base.next(i / NSEG, u)) return false; u.seg = i % NSEG; return true; }
    __device__ __forceinline__ void a_ready(const Unit&) const {}
    __device__ __forceinline__ void done(const Unit&) const {}
};
__device__ __forceinline__ unsigned cvt_pk_bf16(float lo, float hi) { unsigned r; asm volatile("v_cvt_pk_bf16_f32 %0, %1, %2" : "=v"(r) : "v"(lo), "v"(hi)); return r; }
typedef float f32x2 __attribute__((ext_vector_type(2)));
__device__ __forceinline__ f32x2 gelu_pk(f32x2 v) {
    const f32x2 av = __builtin_elementwise_abs(v), d = av * 0.2316418882f + 1.0f;
    f32x2 t; t.x = __builtin_amdgcn_rcpf(d.x); t.y = __builtin_amdgcn_rcpf(d.y);
    f32x2 q = t * 0.5307027145f + (-0.7265760135f); q = q * t + 0.7107068705f; q = q * t + (-0.142248368f); q = q * t + 0.127414796f; q = q * t;
    const f32x2 s = (v * v) * (-0.72134752044f);
    f32x2 e; e.x = __builtin_amdgcn_exp2f(s.x); e.y = __builtin_amdgcn_exp2f(s.y);
    const f32x2 m = v * (q * e), r = v - m;
    f32x2 o; o.x = v.x < 0.f ? m.x : r.x; o.y = v.y < 0.f ? m.y : r.y; return o;
}
template <class Epi, class Sched, bool ALIGN_EPI = false, bool SP2 = false>
__device__ __forceinline__ void gemm_phase(PG8_LAS unsigned char* lds, const Gemm g, const Sched& S, const Epi& E) {
    int tid_ = threadIdx.x; asm volatile("" : "+v"(tid_)); const int tid = tid_, wid = __builtin_amdgcn_readfirstlane(tid >> 6), lane = tid & 63, wr = wid >> 2, wc = wid & 3, fr = lane & 15, fq = lane >> 4;
    const int K = g.K; int nt = K / BK;
    unsigned voffA[2], voffB[2];
#pragma unroll
    for (int i = 0; i < 2; ++i) { int R, C; stage_rc(tid * 16 + i * 8192, R, C); const int Rb = Epi::PERM ? ((R & ~31) + perm32(R & 31)) : R;
        voffA[i] = (unsigned)(R * K + C) * 2u; voffB[i] = (unsigned)(Rb * K + C) * 2u; }
    const size_t kstep = (size_t)(BK * 2);
    const size_t hstep = (size_t)HALF * K * 2;
    const size_t tstep = 2 * hstep;
    const unsigned ldsw = (unsigned)wid * 1024u;
    const int aoff = lds_byte(wr * 64 + fr, fq * 8), boff = lds_byte(wc * 32 + fr, fq * 8);
#define PG8_SA(b, h) (((b) * 2 + (h)) * HTB)
#define PG8_SB(b, h) ((4 + (b) * 2 + (h)) * HTB)
#define PG8_STAGE(bufoff, gbase, voff) do { _Pragma("unroll") for (int _i = 0; _i < 2; ++_i) \
        __builtin_amdgcn_global_load_lds((const unsigned*)((const char*)(gbase) + (voff)[_i]), (PG8_LAS unsigned*)(lds + (bufoff) + ldsw + _i * 8192), 16, 0, 0); } while (0)
#define PG8_LDA(dst, b, h) do { _Pragma("unroll") for (int m = 0; m < 4; ++m) _Pragma("unroll") for (int k = 0; k < 2; ++k) dst[m][k] = *(const PG8_LAS bf16x8*)(lds + PG8_SA(b, h) + aoff + m * 2048 + k * 1024); } while (0)
#define PG8_LDB(dst, b, h) do { _Pragma("unroll") for (int n = 0; n < 2; ++n) _Pragma("unroll") for (int k = 0; k < 2; ++k) dst[n][k] = *(const PG8_LAS bf16x8*)(lds + PG8_SB(b, h) + boff + n * 2048 + k * 1024); } while (0)
#define PG8_MMA(ai, bj, At, Bt) do { __builtin_amdgcn_s_setprio(1); _Pragma("unroll") for (int m = 0; m < 4; ++m) _Pragma("unroll") for (int n = 0; n < 2; ++n) _Pragma("unroll") for (int k = 0; k < 2; ++k) \
        acc[ai][bj][m][n] = __builtin_amdgcn_mfma_f32_16x16x32_bf16(Bt[n][k], At[m][k], acc[ai][bj][m][n], 0, 0, 0); __builtin_amdgcn_s_setprio(0); } while (0)
#define PG8_WAIT_V(n) asm volatile("s_waitcnt vmcnt(" #n ")" ::: "memory")
#define PG8_WAIT_L(n) asm volatile("s_waitcnt lgkmcnt(" #n ")" ::: "memory")
#define PG8_BAR __builtin_amdgcn_s_barrier()
#define PG8_SCHED __builtin_amdgcn_sched_barrier(0)
    Unit cur, nxt; int ui = 0;
    if (!S.next(0, cur)) return;
    f32x4 acc[2][2][4][2];
#pragma unroll
    for (int a = 0; a < 2; ++a)
#pragma unroll
        for (int b = 0; b < 2; ++b)
#pragma unroll
            for (int m = 0; m < 4; ++m)
#pragma unroll
                for (int n = 0; n < 2; ++n) acc[a][b][m][n] = (f32x4){0.f, 0.f, 0.f, 0.f};
    bf16x8 At[4][2], B0[2][2], B1[2][2];
    const char* cA = (const char*)g.A + (size_t)cur.pm * tstep; const char* cB = (const char*)g.Bt + (size_t)cur.pn * (Epi::HALFB ? hstep : tstep);
    if constexpr (Epi::NSEG > 1) { cA += (size_t)Epi::seg_koff(cur.seg) * 2; cB += (size_t)Epi::seg_koff(cur.seg) * 2; nt = Epi::seg_nt(cur.seg); }
    S.a_ready(cur);
    if constexpr (SP2) {
        PG8_STAGE(PG8_SB(0, 0), cB, voffB); PG8_STAGE(PG8_SB(0, 1), cB + hstep, voffB); PG8_STAGE(PG8_SA(0, 0), cA, voffA); PG8_STAGE(PG8_SA(0, 1), cA + hstep, voffA);
        if (wr == 1) PG8_BAR;
        PG8_WAIT_V(2); PG8_BAR;
        PG8_STAGE(PG8_SB(1, 0), cB + kstep, voffB); PG8_STAGE(PG8_SA(1, 0), cA + kstep, voffA); PG8_STAGE(PG8_SB(1, 1), cB + hstep + kstep, voffB);
        PG8_WAIT_V(6); PG8_BAR;
    } else {
        PG8_STAGE(PG8_SB(0, 0), cB, voffB); PG8_STAGE(PG8_SA(0, 0), cA, voffA); PG8_STAGE(PG8_SB(0, 1), cB + hstep, voffB); PG8_STAGE(PG8_SA(0, 1), cA + hstep, voffA);
        if (wr == 1) PG8_BAR;
        PG8_WAIT_V(4); PG8_BAR;
        PG8_STAGE(PG8_SB(1, 0), cB + kstep, voffB); PG8_STAGE(PG8_SA(1, 0), cA + kstep, voffA); PG8_STAGE(PG8_SB(1, 1), cB + hstep + kstep, voffB);
        PG8_WAIT_V(6); PG8_BAR;
    }
    for (;;) {
        const bool has_next = S.next(ui + 1, nxt);
        const char* nA = has_next ? (const char*)g.A + (size_t)nxt.pm * tstep : cA; const char* nB = has_next ? (const char*)g.Bt + (size_t)nxt.pn * (Epi::HALFB ? hstep : tstep) : cB;
        if constexpr (Epi::NSEG > 1) { if (has_next) { nA += (size_t)Epi::seg_koff(nxt.seg) * 2; nB += (size_t)Epi::seg_koff(nxt.seg) * 2; } }
        for (int t = 0; t < nt; t += 2) {
            const bool last = (t == nt - 2);
            const char* a1 = cA + (size_t)(t + 1) * kstep;
            const char* a2 = last ? nA : cA + (size_t)(t + 2) * kstep; const char* b2 = last ? nB : cB + (size_t)(t + 2) * kstep;
            const char* a3 = a2 + kstep; const char* b3 = b2 + kstep;
            if (last && has_next) S.a_ready(nxt);
            if constexpr (SP2) {
            PG8_LDB(B0, 0, 0); if constexpr (!Epi::HALFB) PG8_LDB(B1, 0, 1); PG8_SCHED; PG8_LDA(At, 0, 0); PG8_STAGE(PG8_SA(1, 1), a1 + hstep, voffA);
            PG8_WAIT_V(8); PG8_WAIT_L(0); PG8_BAR; PG8_MMA(0, 0, At, B0); if constexpr (!Epi::HALFB) PG8_MMA(0, 1, At, B1); PG8_BAR; PG8_SCHED;
            PG8_LDA(At, 0, 1); PG8_STAGE(PG8_SB(0, 0), b2, voffB); PG8_STAGE(PG8_SB(0, 1), b2 + hstep, voffB); PG8_STAGE(PG8_SA(0, 0), a2, voffA);
            PG8_WAIT_V(8); PG8_WAIT_L(0); PG8_BAR; PG8_MMA(1, 0, At, B0); if constexpr (!Epi::HALFB) PG8_MMA(1, 1, At, B1); PG8_BAR; PG8_SCHED;
            PG8_LDB(B0, 1, 0); if constexpr (!Epi::HALFB) PG8_LDB(B1, 1, 1); PG8_SCHED; PG8_LDA(At, 1, 0); PG8_STAGE(PG8_SA(0, 1), a2 + hstep, voffA);
            PG8_WAIT_V(8); PG8_WAIT_L(0); PG8_BAR; PG8_MMA(0, 0, At, B0); if constexpr (!Epi::HALFB) PG8_MMA(0, 1, At, B1); PG8_BAR; PG8_SCHED;
            PG8_LDA(At, 1, 1); PG8_STAGE(PG8_SB(1, 0), b3, voffB); PG8_STAGE(PG8_SB(1, 1), b3 + hstep, voffB); PG8_STAGE(PG8_SA(1, 0), a3, voffA);
            PG8_WAIT_V(8); PG8_WAIT_L(0); PG8_BAR; PG8_MMA(1, 0, At, B0); if constexpr (!Epi::HALFB) PG8_MMA(1, 1, At, B1); PG8_BAR; PG8_SCHED;
            } else {
            PG8_LDB(B0, 0, 0); PG8_SCHED; PG8_LDA(At, 0, 0); PG8_STAGE(PG8_SA(1, 1), a1 + hstep, voffA);
            PG8_WAIT_L(8); PG8_BAR; PG8_WAIT_L(0); PG8_MMA(0, 0, At, B0); PG8_BAR; PG8_SCHED;
            PG8_LDB(B1, 0, 1); PG8_STAGE(PG8_SB(0, 0), b2, voffB);
            PG8_BAR; PG8_WAIT_L(0); PG8_MMA(0, 1, At, B1); PG8_BAR;
            PG8_LDA(At, 0, 1); PG8_STAGE(PG8_SA(0, 0), a2, voffA);
            PG8_BAR; PG8_WAIT_L(0); PG8_MMA(1, 0, At, B0); PG8_BAR; PG8_SCHED;
            PG8_STAGE(PG8_SB(0, 1), b2 + hstep, voffB);
            PG8_WAIT_V(6); PG8_BAR; PG8_MMA(1, 1, At, B1); PG8_BAR;
            PG8_LDB(B0, 1, 0); PG8_SCHED; PG8_LDA(At, 1, 0); PG8_STAGE(PG8_SA(0, 1), a2 + hstep, voffA);
            PG8_WAIT_L(8); PG8_BAR; PG8_WAIT_L(0); PG8_MMA(0, 0, At, B0); PG8_BAR; PG8_SCHED;
            PG8_LDB(B1, 1, 1); PG8_STAGE(PG8_SB(1, 0), b3, voffB);
            PG8_BAR; PG8_WAIT_L(0); PG8_MMA(0, 1, At, B1); PG8_BAR;
            PG8_LDA(At, 1, 1); PG8_STAGE(PG8_SA(1, 0), a3, voffA);
            PG8_BAR; PG8_WAIT_L(0); PG8_MMA(1, 0, At, B0); PG8_BAR; PG8_SCHED;
            PG8_STAGE(PG8_SB(1, 1), b3 + hstep, voffB);
            PG8_WAIT_V(6); PG8_BAR; PG8_MMA(1, 1, At, B1); PG8_BAR;
            }
        }
        if constexpr (ALIGN_EPI) { if (wr == 0) PG8_BAR; }
        bool lastseg = true; if constexpr (Epi::NSEG > 1) lastseg = (cur.seg == Epi::NSEG - 1);
        if constexpr (!Epi::AFTER_DRAIN) { if (lastseg) { E(acc, cur, wr, wc, fr, fq); S.done(cur); } else { if constexpr (Epi::NSEG > 1) E.seg(acc, cur, wr, wc, fr, fq); } }
        if (!has_next) break;
#pragma unroll
        for (int a = 0; a < 2; ++a)
#pragma unroll
            for (int b = 0; b < 2; ++b)
#pragma unroll
                for (int m = 0; m < 4; ++m)
#pragma unroll
                    for (int n = 0; n < 2; ++n) acc[a][b][m][n] = (f32x4){0.f, 0.f, 0.f, 0.f};
        cur = nxt; cA = nA; cB = nB; ++ui; if constexpr (Epi::NSEG > 1) nt = Epi::seg_nt(cur.seg);
        if constexpr (ALIGN_EPI) { if (wr == 1) PG8_BAR; }
    }
    PG8_WAIT_V(0);
    if constexpr (!ALIGN_EPI) { if (wr == 0) PG8_BAR; }
    PG8_BAR;
    if constexpr (Epi::AFTER_DRAIN) { E.fused(acc, cur, wr, wc, fr, fq, lds, wid, lane); S.done(cur); }
#undef PG8_SA
#undef PG8_SB
#undef PG8_STAGE
#undef PG8_LDA
#undef PG8_LDB
#undef PG8_MMA
#undef PG8_WAIT_V
#undef PG8_WAIT_L
#undef PG8_BAR
#undef PG8_SCHED
}
}

#define DI __device__ __forceinline__
#define LAS __attribute__((address_space(3)))
using pg8::bf16_t; using pg8::bf16x8; using pg8::f32x4; using pg8::u32x4; using pg8::Unit; using pg8::f32x2; using pg8::gelu_pk;
typedef __bf16 bf16x2_t __attribute__((ext_vector_type(2)));
__device__ __forceinline__ unsigned cvt_pk_bf16(float lo, float hi) { f32x2 v = {lo, hi}; bf16x2_t b = __builtin_convertvector(v, bf16x2_t); return __builtin_bit_cast(unsigned, b); }
typedef LAS unsigned char* lptr;
typedef unsigned u32x2 __attribute__((ext_vector_type(2)));
#define MFMA16(a, b, c) __builtin_amdgcn_mfma_f32_16x16x32_bf16((a), (b), (c), 0, 0, 0)

constexpr int T = 16384, TB = 8192, DM = 1024, FF = 2816;
constexpr float EPS = 1e-6f;
constexpr int ZUQ_LD = 3328, XBC_LD = 3072, NWIN = 7680, GATE_LD = 3072, KBR = 3328, WIN_LD = 10528;
constexpr float QSCALE = 0.125f * 1.4426950408889634f;
constexpr int PT = 272;
constexpr int LDS_BYTES = 155648;

constexpr size_t KiB = 1024, MiB = 1u << 20;
constexpr size_t WS_SS1 = 0, WS_SS2 = 64 * KiB, WS_SS3 = 128 * KiB, WS_SS4 = 192 * KiB, WS_SSV = 256 * KiB, WS_SSG = 320 * KiB  , WS_CDEC = 576 * KiB  ;
constexpr size_t WS_KMEM = 640 * KiB, WS_VMEMT = 896 * KiB, WS_DT = 2 * MiB;
constexpr size_t WS_BAR = 4 * MiB, BAR_BYTES = 65536, WS_PCNT = WS_BAR + 32768;
constexpr int LDS_BARST = LDS_BYTES - 64;
constexpr size_t WS_W2GU = 6 * MiB, WS_W2D = 17 * MiB, WS_WIN = 22 * MiB + 512 * KiB, WS_WG = 37 * MiB + 512 * KiB, WS_WBR = 43 * MiB + 512 * KiB, WS_WOUT = 50 * MiB;
constexpr size_t WS_HB = 52 * MiB, WS_MG = 84 * MiB, WS_W1GU = 116 * MiB, WS_W1D = 127 * MiB, WS_ACT = 132 * MiB + 512 * KiB;
constexpr size_t WS_ZUQ = 116 * MiB, WS_XBC = 168 * MiB, WS_ST = 216 * MiB, WS_END = 256 * MiB;
static_assert(WS_ACT + (size_t)T * FF * 2 <= WS_END && WS_ST + (size_t)64 * 32 * 8192 * 2 <= WS_END && WS_ZUQ + (size_t)TB * ZUQ_LD * 2 <= WS_XBC && WS_XBC + (size_t)TB * XBC_LD * 2 <= WS_ST, "ws map");

DI float bflo(unsigned w) { return __uint_as_float(w << 16); }
DI float bfhi(unsigned w) { return __uint_as_float(w & 0xffff0000u); }
DI float sigm(float x) { return __builtin_amdgcn_rcpf(1.f + __expf(-x)); }
DI float silu(float x) { return x * sigm(x); }
DI u32x4 pack8(f32x4 a, f32x4 b) { u32x4 w; w.x = cvt_pk_bf16(a[0], a[1]); w.y = cvt_pk_bf16(a[2], a[3]); w.z = cvt_pk_bf16(b[0], b[1]); w.w = cvt_pk_bf16(b[2], b[3]); return w; }
DI u32x2 pack4(f32x4 a) { u32x2 w; w.x = cvt_pk_bf16(a[0], a[1]); w.y = cvt_pk_bf16(a[2], a[3]); return w; }
DI f32x4 gelu4(f32x4 v) { f32x2 a = gelu_pk((f32x2){v[0], v[1]}), b = gelu_pk((f32x2){v[2], v[3]}); return (f32x4){a.x, a.y, b.x, b.y}; }
DI float rstd_of(float ss, float inv_n) { return __builtin_amdgcn_rsqf(ss * inv_n + EPS); }
DI float softplus(float v) { return v > 20.f ? v : log1pf(__expf(v)); }

struct EpiGLU {
    static constexpr bool PERM = true, AFTER_DRAIN = false; static constexpr int NSEG = 1; static constexpr bool HALFB = false;
    const float* ss; bf16_t* O;
    DI void operator()(const f32x4 (&acc)[2][2][4][2], const Unit& u, int wr, int wc, int fr, int fq) const {
        const int col = u.pn * 128 + wc * 32 + 8 * fq;
#pragma unroll
        for (int ai = 0; ai < 2; ++ai)
#pragma unroll
            for (int m = 0; m < 4; ++m) {
                const int row = u.pm * 256 + ai * 128 + wr * 64 + m * 16 + fr;
                const float r = rstd_of(ss[row], 1.f / 1024.f);
                f32x4 o[2];
#pragma unroll
                for (int n = 0; n < 2; ++n)
#pragma unroll
                    for (int e = 0; e < 4; ++e) o[n][e] = silu(acc[ai][0][m][n][e] * r) * (acc[ai][1][m][n][e] * r);
                *(u32x4*)(O + (size_t)row * FF + col) = pack8(o[0], o[1]);
            }
    }
};
struct EpiRes {
    static constexpr bool PERM = true, AFTER_DRAIN = false; static constexpr int NSEG = 1; static constexpr bool HALFB = false;
    const float* resid; float* hout; bf16_t* hb; float* ssout; float alpha;
    DI void operator()(const f32x4 (&acc)[2][2][4][2], const Unit& u, int wr, int wc, int fr, int fq) const {
#pragma unroll
        for (int ai = 0; ai < 2; ++ai)
#pragma unroll
            for (int m = 0; m < 4; ++m) {
                const int row = u.pm * 256 + ai * 128 + wr * 64 + m * 16 + fr;
                float sq = 0.f;
#pragma unroll
                for (int bj = 0; bj < 2; ++bj) {
                    const size_t off = (size_t)row * DM + u.pn * 256 + bj * 128 + wc * 32 + 8 * fq;
                    f32x4 v0 = *(const f32x4*)(resid + off) + acc[ai][bj][m][0] * alpha, v1 = *(const f32x4*)(resid + off + 4) + acc[ai][bj][m][1] * alpha;
                    *(f32x4*)(hout + off) = v0; *(f32x4*)(hout + off + 4) = v1;
                    if (hb) *(u32x4*)(hb + off) = pack8(v0, v1);
                    sq += (v0[0] * v0[0] + v0[1] * v0[1]) + (v0[2] * v0[2] + v0[3] * v0[3]) + (v1[0] * v1[0] + v1[1] * v1[1]) + (v1[2] * v1[2] + v1[3] * v1[3]);
                }
                sq += __shfl_xor(sq, 16); sq += __shfl_xor(sq, 32);
                if (fq == 0) atomicAdd(ssout + row, sq);
            }
    }
};
struct EpiResNorm {
    static constexpr bool PERM = true, AFTER_DRAIN = false, HALFB = false; static constexpr int NSEG = 1;
    const float* resid; float* out; float* ss; unsigned* cnt; const float* gain; float alpha;
    DI void operator()(f32x4 (&acc)[2][2][4][2], const Unit& u, int wr, int wc, int fr, int fq) const {
#pragma unroll
        for (int ai = 0; ai < 2; ++ai)
#pragma unroll
            for (int m = 0; m < 4; ++m) {
                const int row = u.pm * 256 + ai * 128 + wr * 64 + m * 16 + fr;
                float sq = 0.f;
#pragma unroll
                for (int bj = 0; bj < 2; ++bj) {
                    const size_t off = (size_t)row * DM + u.pn * 256 + bj * 128 + wc * 32 + 8 * fq;
                    const f32x4 v0 = *(const f32x4*)(resid + off) + acc[ai][bj][m][0] * alpha, v1 = *(const f32x4*)(resid + off + 4) + acc[ai][bj][m][1] * alpha;
                    acc[ai][bj][m][0] = v0; acc[ai][bj][m][1] = v1;
                    sq += (v0[0] * v0[0] + v0[1] * v0[1]) + (v0[2] * v0[2] + v0[3] * v0[3]) + (v1[0] * v1[0] + v1[1] * v1[1]) + (v1[2] * v1[2] + v1[3] * v1[3]);
                }
                sq += __shfl_xor(sq, 16); sq += __shfl_xor(sq, 32);
                if (fq == 0) atomicAdd(ss + row, sq);
            }
        asm volatile("s_waitcnt vmcnt(0)" ::: "memory");
        __syncthreads();
        if (threadIdx.x == 0) {
            unsigned* c = cnt + 64 * u.pm;
            (void)__hip_atomic_fetch_add(c, 1u, __ATOMIC_RELAXED, __HIP_MEMORY_SCOPE_AGENT);
            unsigned sp = 0;
            while (__hip_atomic_load(c, __ATOMIC_RELAXED, __HIP_MEMORY_SCOPE_AGENT) < 4u) { __builtin_amdgcn_s_sleep(1); if (++sp > (1u << 20)) break; }
        }
        __syncthreads();
#pragma unroll
        for (int ai = 0; ai < 2; ++ai)
#pragma unroll
            for (int m = 0; m < 4; ++m) {
                const int row = u.pm * 256 + ai * 128 + wr * 64 + m * 16 + fr;
                const float r = rstd_of(__hip_atomic_load(ss + row, __ATOMIC_RELAXED, __HIP_MEMORY_SCOPE_AGENT), 1.f / 1024.f);
#pragma unroll
                for (int bj = 0; bj < 2; ++bj) {
                    const int col = u.pn * 256 + bj * 128 + wc * 32 + 8 * fq;
                    const f32x4 g0 = *(const f32x4*)(gain + col), g1 = *(const f32x4*)(gain + col + 4);
                    *(f32x4*)(out + (size_t)row * DM + col) = acc[ai][bj][m][0] * r * g0; *(f32x4*)(out + (size_t)row * DM + col + 4) = acc[ai][bj][m][1] * r * g1;
                }
            }
    }
};
struct EpiWin {
    static constexpr bool PERM = true, AFTER_DRAIN = false; static constexpr int NSEG = 1; static constexpr bool HALFB = false;
    int row_base; const float* ss; bf16_t* zuq; bf16_t* xbc; bf16_t* gv; float* dt; const float* dt_bias; float* ssv;
    template <int KIND> DI void body(const f32x4 (&acc)[2][2][4][2], const Unit& u, int wr, int wc, int fr, int fq) const {
        const int pn = u.pn, cw = wc * 32 + 8 * fq;
#pragma unroll
        for (int ai = 0; ai < 2; ++ai)
#pragma unroll
            for (int m = 0; m < 4; ++m) {
                const int lr = u.pm * 256 + ai * 128 + wr * 64 + m * 16 + fr, gr = row_base + lr;
                const float r = rstd_of(ss[gr], 1.f / 1024.f);
                if (KIND == 0) {
#pragma unroll
                    for (int bj = 0; bj < 2; ++bj) { f32x4 a, b;
#pragma unroll
                        for (int e = 0; e < 4; ++e) { a[e] = silu(acc[ai][bj][m][0][e] * r); b[e] = silu(acc[ai][bj][m][1][e] * r); }
                        *(u32x4*)(zuq + (size_t)lr * ZUQ_LD + pn * 256 + bj * 128 + cw) = pack8(a, b); }
                } else if (KIND == 1) {
#pragma unroll
                    for (int bj = 0; bj < 2; ++bj) { f32x4 a = gelu4(acc[ai][bj][m][0] * r), b = gelu4(acc[ai][bj][m][1] * r);
                        *(u32x4*)(zuq + (size_t)lr * ZUQ_LD + pn * 256 + bj * 128 + cw) = pack8(a, b); }
                } else if (KIND == 2) {
#pragma unroll
                    for (int bj = 0; bj < 2; ++bj) { f32x4 a = acc[ai][bj][m][0] * (r * QSCALE), b = acc[ai][bj][m][1] * (r * QSCALE);
                        *(u32x4*)(zuq + (size_t)lr * ZUQ_LD + pn * 256 + bj * 128 + cw) = pack8(a, b); }
                } else if (KIND == 3) {
#pragma unroll
                    for (int bj = 0; bj < 2; ++bj) { f32x4 a = acc[ai][bj][m][0] * r, b = acc[ai][bj][m][1] * r;
                        *(u32x4*)(xbc + (size_t)lr * XBC_LD + (pn - 13) * 256 + bj * 128 + cw) = pack8(a, b); }
                } else if (KIND == 4) {
                    float sq = 0.f;
#pragma unroll
                    for (int bj = 0; bj < 2; ++bj) { f32x4 a = gelu4(acc[ai][bj][m][0] * r), b = gelu4(acc[ai][bj][m][1] * r);
                        sq += (a[0] * a[0] + a[1] * a[1]) + (a[2] * a[2] + a[3] * a[3]) + (b[0] * b[0] + b[1] * b[1]) + (b[2] * b[2] + b[3] * b[3]);
                        *(u32x4*)(gv + (size_t)lr * DM + (pn - 25) * 256 + bj * 128 + cw) = pack8(a, b); }
                    sq += __shfl_xor(sq, 16); sq += __shfl_xor(sq, 32);
                    if (fq == 0) atomicAdd(ssv + gr, sq);
                } else {
                    if (wc == 0) {
#pragma unroll
                        for (int n = 0; n < 2; ++n) { f32x4 o;
#pragma unroll
                            for (int e = 0; e < 4; ++e) o[e] = softplus(acc[ai][0][m][n][e] * r + dt_bias[8 * fq + 4 * n + e]);
                            *(f32x4*)(dt + (size_t)gr * 32 + 8 * fq + 4 * n) = o; }
                    }
                }
            }
    }
    DI void operator()(const f32x4 (&acc)[2][2][4][2], const Unit& u, int wr, int wc, int fr, int fq) const {
        const int pn = u.pn;
        if (pn < 8) body<0>(acc, u, wr, wc, fr, fq); else if (pn < 12) body<1>(acc, u, wr, wc, fr, fq); else if (pn == 12) body<2>(acc, u, wr, wc, fr, fq);
        else if (pn < 25) body<3>(acc, u, wr, wc, fr, fq); else if (pn < 29) body<4>(acc, u, wr, wc, fr, fq); else body<5>(acc, u, wr, wc, fr, fq);
    }
};
struct EpiGates {
    static constexpr bool PERM = true, AFTER_DRAIN = false; static constexpr int NSEG = 1; static constexpr bool HALFB = false;
    int row_base; const float* ss; bf16_t* O;
    DI void operator()(const f32x4 (&acc)[2][2][4][2], const Unit& u, int wr, int wc, int fr, int fq) const {
#pragma unroll
        for (int ai = 0; ai < 2; ++ai)
#pragma unroll
            for (int m = 0; m < 4; ++m) {
                const int lr = u.pm * 256 + ai * 128 + wr * 64 + m * 16 + fr;
                const float r = rstd_of(ss[row_base + lr], 1.f / 1024.f);
#pragma unroll
                for (int bj = 0; bj < 2; ++bj) { f32x4 a, b;
#pragma unroll
                    for (int e = 0; e < 4; ++e) { a[e] = sigm(acc[ai][bj][m][0][e] * r); b[e] = sigm(acc[ai][bj][m][1][e] * r); }
                    *(u32x4*)(O + (size_t)lr * GATE_LD + u.pn * 256 + bj * 128 + wc * 32 + 8 * fq) = pack8(a, b); }
            }
    }
};
struct EpiMerge {
    static constexpr bool PERM = true, AFTER_DRAIN = false, HALFB = true; static constexpr int NSEG = 3;
    const bf16_t* gates; float* run; bf16_t* O;
    static DI int seg_koff(int s) { return s == 0 ? 0 : (s == 1 ? 2048 : 3072); }
    static DI int seg_nt(int s) { return s == 0 ? 32 : (s == 1 ? 16 : 4); }
    DI void seg(const f32x4 (&acc)[2][2][4][2], const Unit& u, int wr, int wc, int fr, int fq) const {
        const int row0 = u.pm * 256 + wr * 64 + fr, cw = u.pn * 128 + wc * 32 + 8 * fq, s = u.seg;
#pragma unroll
        for (int ai = 0; ai < 2; ++ai)
#pragma unroll
            for (int m = 0; m < 4; ++m) {
                const int row = row0 + ai * 128 + m * 16;
                const u32x4 G = *(const u32x4*)(gates + (size_t)row * GATE_LD + s * 1024 + cw);
                float* rp = run + (size_t)row * DM + cw;
                f32x4 a = (f32x4){0.f, 0.f, 0.f, 0.f}, b = a;
                if (s > 0) { a = *(const f32x4*)rp; b = *(const f32x4*)(rp + 4); }
                a[0] += acc[ai][0][m][0][0] * bflo(G[0]); a[1] += acc[ai][0][m][0][1] * bfhi(G[0]); a[2] += acc[ai][0][m][0][2] * bflo(G[1]); a[3] += acc[ai][0][m][0][3] * bfhi(G[1]);
                b[0] += acc[ai][0][m][1][0] * bflo(G[2]); b[1] += acc[ai][0][m][1][1] * bfhi(G[2]); b[2] += acc[ai][0][m][1][2] * bflo(G[3]); b[3] += acc[ai][0][m][1][3] * bfhi(G[3]);
                *(f32x4*)rp = a; *(f32x4*)(rp + 4) = b;
            }
    }
    DI void operator()(const f32x4 (&acc)[2][2][4][2], const Unit& u, int wr, int wc, int fr, int fq) const {
        const int row0 = u.pm * 256 + wr * 64 + fr, cw = u.pn * 128 + wc * 32 + 8 * fq;
#pragma unroll
        for (int ai = 0; ai < 2; ++ai)
#pragma unroll
            for (int m = 0; m < 4; ++m) {
                const int row = row0 + ai * 128 + m * 16;
                const u32x4 G = *(const u32x4*)(gates + (size_t)row * GATE_LD + 2048 + cw);
                const float* rp = run + (size_t)row * DM + cw;
                f32x4 a = *(const f32x4*)rp, b = *(const f32x4*)(rp + 4);
                a[0] += acc[ai][0][m][0][0] * bflo(G[0]); a[1] += acc[ai][0][m][0][1] * bfhi(G[0]); a[2] += acc[ai][0][m][0][2] * bflo(G[1]); a[3] += acc[ai][0][m][0][3] * bfhi(G[1]);
                b[0] += acc[ai][0][m][1][0] * bflo(G[2]); b[1] += acc[ai][0][m][1][1] * bfhi(G[2]); b[2] += acc[ai][0][m][1][2] * bflo(G[3]); b[3] += acc[ai][0][m][1][3] * bfhi(G[3]);
                *(u32x4*)(O + (size_t)row * DM + cw) = pack8(a, b);
            }
    }
};

struct Frame {
    lptr lds; unsigned char* ws; const float* const* in; float* out;
    int tid, lane, wave, G, bid;
};
struct Args { const float* in[28]; float* out; unsigned char* ws; int ph_lo, ph_hi; };
enum { I_X = 0, I_MEM, I_F1N, I_F1G, I_F1U, I_F1D, I_MIXN, I_MEMN, I_WIN, I_CONVW, I_CONVB, I_DTB, I_ALOG, I_SSDD, I_SSDN, I_GVN, I_GWS, I_GBS, I_WKV, I_WBS, I_WBG, I_WBM, I_WOUT, I_F2N, I_F2G, I_F2U, I_F2D, I_FINN };

#define LDS_WAIT() asm volatile("s_waitcnt lgkmcnt(0)" ::: "memory")

#define XB_TMO      128
#define XB_XCNT(j)  (256  + 64 * (j))
#define XB_XSUB(j)  (1280 + 64 * (j))
#define XB_XGEN(j)  (2304 + 64 * (j))
#define XB_TOP      3328
#define XB_TOPGEN   3392
#define XCD_BAR_WORDS 3456
#define XB_SPIN_CAP (1u << 18)

__device__ __forceinline__ unsigned xb_ld(unsigned* p)              { return __hip_atomic_load(p, __ATOMIC_RELAXED, __HIP_MEMORY_SCOPE_AGENT); }
__device__ __forceinline__ unsigned xb_add(unsigned* p, unsigned v) { return __hip_atomic_fetch_add(p, v, __ATOMIC_RELAXED, __HIP_MEMORY_SCOPE_AGENT); }
__device__ __forceinline__ unsigned xb_xcc_id() { return (unsigned)__builtin_amdgcn_s_getreg((3 << 11) | 20) & 0xFu; }
#define XB_SPIN(cond, bar) do { unsigned _sp = 0; while (cond) { __builtin_amdgcn_s_sleep(1); \
    if ((++_sp & 255u) == 0u) { if (xb_ld(&(bar)[XB_TMO])) break; if (_sp > XB_SPIN_CAP) { atomicAdd(&(bar)[XB_TMO], 1u); break; } } } } while (0)

struct XcdBarrier {
    unsigned* bar; unsigned x;
    volatile LAS unsigned* st;
};

__device__ __forceinline__ XcdBarrier xcd_barrier_post(unsigned* bar, volatile LAS unsigned* st) {
    XcdBarrier b; b.bar = bar; b.x = xb_xcc_id(); b.st = st;
    if (threadIdx.x == 0) (void)xb_add(&bar[XB_XCNT(b.x)], 1u);
    return b;
}
__device__ __forceinline__ void xcd_barrier_complete(unsigned* bar, unsigned x, unsigned& nloc, unsigned& nx) {
    const unsigned G = gridDim.x * gridDim.y * gridDim.z;
    unsigned sum, cnt, mine, sp = 0u;
    for (;;) {
        sum = 0u; cnt = 0u; mine = 0u;
#pragma unroll
        for (unsigned j = 0; j < 16; ++j) { const unsigned c = xb_ld(&bar[XB_XCNT(j)]); sum += c; cnt += (c > 0u) ? 1u : 0u; mine = (j == x) ? c : mine; }
        if (sum == G) break;
        __builtin_amdgcn_s_sleep(1);
        if ((++sp & 255u) == 0u) { if (xb_ld(&bar[XB_TMO])) break; if (sp > XB_SPIN_CAP) { atomicAdd(&bar[XB_TMO], 1u); break; } }
    }
    nloc = mine > 0u ? mine : 1u; nx = cnt > 0u ? cnt : 1u;
}

__device__ __forceinline__ void xcd_barrier(const XcdBarrier& b) {
    asm volatile("s_waitcnt vmcnt(0)" ::: "memory");
    __syncthreads();
    if (threadIdx.x == 0) {
        unsigned* bar = b.bar;
        __builtin_amdgcn_s_waitcnt(0);
        unsigned nloc = b.st[0], nx = b.st[1];
        if (nloc == 0u) { xcd_barrier_complete(bar, b.x, nloc, nx); b.st[0] = nloc; b.st[1] = nx; }
        const unsigned old = xb_add(&bar[XB_XSUB(b.x)], 1u);
        const unsigned gen = old / nloc;
        if (old + 1u == (gen + 1u) * nloc) {
            __builtin_amdgcn_fence(__ATOMIC_RELEASE, "agent");
            asm volatile("s_waitcnt vmcnt(0)" ::: "memory");
            const unsigned og = xb_add(&bar[XB_TOP], 1u);
            const unsigned tg = og / nx;
            if (og + 1u == (tg + 1u) * nx) xb_add(&bar[XB_TOPGEN], 1u);
            else XB_SPIN(xb_ld(&bar[XB_TOPGEN]) == tg, bar);
            __builtin_amdgcn_fence(__ATOMIC_ACQUIRE, "agent");
            xb_add(&bar[XB_XGEN(b.x)], 1u);
            asm volatile("s_waitcnt vmcnt(0)" ::: "memory");
        } else {
            XB_SPIN(xb_ld(&bar[XB_XGEN(b.x)]) == gen, bar);
            __builtin_amdgcn_fence(__ATOMIC_ACQUIRE, "agent");
            asm volatile("s_waitcnt vmcnt(0)" ::: "memory");
        }
    }
    __syncthreads();
}


DI void tr_item(const float* W, int ldw, int col0, bf16_t* WT, int ldt, int dcol0, int drow0, const float* gain, LAS float* scr, int kb, int lane) {
    const int k0 = 64 * kb;
    float tv[32];
    const float* wp = W + (size_t)(k0 + (lane >> 5)) * ldw + col0 + (lane & 31);
#pragma unroll
    for (int i = 0; i < 32; ++i) tv[i] = wp[(size_t)(2 * i) * ldw];
    if (gain) {
#pragma unroll
        for (int i = 0; i < 32; ++i) tv[i] *= gain[k0 + 2 * i + (lane >> 5)];
    }
#pragma unroll
    for (int i = 0; i < 32; ++i) scr[(2 * i + (lane >> 5)) * 33 + (lane & 31)] = tv[i];
    LDS_WAIT();
    const int c = lane & 7;
#pragma unroll
    for (int j = 0; j < 4; ++j) { const int n = (lane >> 3) + 8 * j; const LAS float* s = scr + (8 * c) * 33 + n;
        u32x4 o; o.x = cvt_pk_bf16(s[0 * 33], s[1 * 33]); o.y = cvt_pk_bf16(s[2 * 33], s[3 * 33]); o.z = cvt_pk_bf16(s[4 * 33], s[5 * 33]); o.w = cvt_pk_bf16(s[6 * 33], s[7 * 33]);
        *(u32x4*)(WT + (size_t)(drow0 + n) * ldt + dcol0 + k0 + 8 * c) = o; }
    LDS_WAIT();
}
DI void kv_item(const Frame& F, int item) {
    const int rt = item >> 3, ct = item & 7, r0 = rt * 64, c0 = ct * 64, tid = F.tid, lane = F.lane, w = F.wave, fr = lane & 15, fq = lane >> 4;
    lptr As = F.lds, Bs = F.lds + 64 * PT; LAS float* rs = (LAS float*)(F.lds + 128 * PT);
    const float* mem = F.in[I_MEM]; const float* W = F.in[I_WKV]; const float* gain = F.in[I_MEMN];
    bf16_t* Kmem = (bf16_t*)(F.ws + WS_KMEM); bf16_t* VmemT = (bf16_t*)(F.ws + WS_VMEMT);
    const int ar = tid >> 3, ka = (tid & 7) * 16;
    const int kb = tid >> 2, nb = (tid & 3) * 16;
    const float* pa = mem + (size_t)(r0 + ar) * 1024 + ka; const float* pb = W + (size_t)kb * 512 + c0 + nb;
    float sq = 0.f;
    f32x4 acc[2]; acc[0] = (f32x4){0.f, 0.f, 0.f, 0.f}; acc[1] = acc[0];
    const bool ktype = ct < 4;
    f32x4 va[4], vb[4]; float gk;
#pragma unroll
    for (int i = 0; i < 4; ++i) { va[i] = *(const f32x4*)(pa + 4 * i); vb[i] = *(const f32x4*)(pb + 4 * i); }
    gk = gain[kb];
    for (int kc = 0; kc < 8; ++kc) {
#pragma unroll
        for (int i = 0; i < 4; ++i) sq += (va[i][0] * va[i][0] + va[i][1] * va[i][1]) + (va[i][2] * va[i][2] + va[i][3] * va[i][3]);
        *(LAS u32x4*)(As + ar * PT + ka * 2) = pack8(va[0], va[1]); *(LAS u32x4*)(As + ar * PT + ka * 2 + 16) = pack8(va[2], va[3]);
#pragma unroll
        for (int i = 0; i < 4; ++i) { const u32x2 pk = pack4(vb[i] * gk);
            *(LAS unsigned short*)(Bs + (nb + 4 * i + 0) * PT + kb * 2) = (unsigned short)(pk[0] & 0xffffu); *(LAS unsigned short*)(Bs + (nb + 4 * i + 1) * PT + kb * 2) = (unsigned short)(pk[0] >> 16);
            *(LAS unsigned short*)(Bs + (nb + 4 * i + 2) * PT + kb * 2) = (unsigned short)(pk[1] & 0xffffu); *(LAS unsigned short*)(Bs + (nb + 4 * i + 3) * PT + kb * 2) = (unsigned short)(pk[1] >> 16); }
        if (kc < 7) {
#pragma unroll
            for (int i = 0; i < 4; ++i) { va[i] = *(const f32x4*)(pa + (kc + 1) * 128 + 4 * i); vb[i] = *(const f32x4*)(pb + (size_t)(kc + 1) * 128 * 512 + 4 * i); }
            gk = gain[(kc + 1) * 128 + kb];
        }
        __syncthreads();
#pragma unroll
        for (int ks = 0; ks < 4; ++ks) {
            if (ktype) { const bf16x8 yf = *(const LAS bf16x8*)(As + (16 * (w >> 1) + fr) * PT + ks * 64 + fq * 16);
#pragma unroll
                for (int i = 0; i < 2; ++i) { const bf16x8 xf = *(const LAS bf16x8*)(Bs + (16 * ((w & 1) * 2 + i) + fr) * PT + ks * 64 + fq * 16); acc[i] = MFMA16(xf, yf, acc[i]); } }
            else { const bf16x8 yf = *(const LAS bf16x8*)(Bs + (16 * (w >> 1) + fr) * PT + ks * 64 + fq * 16);
#pragma unroll
                for (int i = 0; i < 2; ++i) { const bf16x8 xf = *(const LAS bf16x8*)(As + (16 * ((w & 1) * 2 + i) + fr) * PT + ks * 64 + fq * 16); acc[i] = MFMA16(xf, yf, acc[i]); } }
        }
        __syncthreads();
    }
    sq += __shfl_xor(sq, 1); sq += __shfl_xor(sq, 2); sq += __shfl_xor(sq, 4);
    if ((tid & 7) == 0) rs[ar] = rstd_of(sq, 1.f / 1024.f);
    __syncthreads();
    if (ktype) { const int tok = 16 * (w >> 1) + fr; const float r = rs[tok];
#pragma unroll
        for (int i = 0; i < 2; ++i) { const int ch = c0 + 16 * ((w & 1) * 2 + i) + 4 * fq; *(u32x2*)(Kmem + (size_t)(r0 + tok) * 256 + ch) = pack4(acc[i] * r); } }
    else { const int ch = c0 - 256 + 16 * (w >> 1) + fr;
#pragma unroll
        for (int i = 0; i < 2; ++i) { const int tok = 16 * ((w & 1) * 2 + i) + 4 * fq; f32x4 o;
#pragma unroll
            for (int e = 0; e < 4; ++e) o[e] = acc[i][e] * rs[tok + e];
            const int row = r0 + tok; *(u32x2*)(VmemT + (size_t)((row >> 8) * 256 + ch) * 256 + (row & 255)) = pack4(o); } }
    __syncthreads();
}
DI float wave_sum(float v) {
#pragma unroll
    for (int o = 1; o < 64; o <<= 1) v += __shfl_xor(v, o);
    return v;
}
#define SEG(Wp, ldw, c0, nc, Kk, WTp, ldt, dc0, gn, MAP) { const int nblk = (nc) / 32, cnt = ((Kk) / 64) * nblk; if (r < cnt) { const int kb = r / nblk, n0 = (r % nblk) * 32; \
        tr_item(Wp, ldw, (c0) + n0, WTp, ldt, dc0, (MAP), gn, scr, kb, lane); continue; } r -= cnt; }
DI void prologue(const Frame& F) {
    unsigned char* ws = F.ws;
    { u32x4* z = (u32x4*)(ws + WS_SS2); const int n = (int)((WS_CDEC - WS_SS2) / 16); for (int i = F.bid * 512 + F.tid; i < n; i += F.G * 512) z[i] = (u32x4){0u, 0u, 0u, 0u}; }
    LAS float* scr = (LAS float*)(F.lds + F.wave * 16384);
    const int gw = F.bid * 8 + F.wave, NGW = F.G * 8, lane = F.lane;
    bf16_t* W1GU = (bf16_t*)(ws + WS_W1GU);
    bf16_t* W1D = (bf16_t*)(ws + WS_W1D); bf16_t* WIN = (bf16_t*)(ws + WS_WIN);
    constexpr int NITEMS = 3 * 1408 + 16 * ((2048 + 1024 + 256 + 3072) / 32);
    for (int it = gw; it < NITEMS; it += NGW) {
        int r = it;
        SEG(F.in[I_F1G], FF, 0, FF, 1024, W1GU, 1024, 0, F.in[I_F1N], (n0 / 128) * 256 + (n0 % 128))
        SEG(F.in[I_F1U], FF, 0, FF, 1024, W1GU, 1024, 0, F.in[I_F1N], (n0 / 128) * 256 + 128 + (n0 % 128))
        SEG(F.in[I_F1D], 1024, 0, 1024, FF, W1D, FF, 0, (const float*)nullptr, n0)
        SEG(F.in[I_WIN], WIN_LD, 0, 2048, 1024, WIN, 1024, 0, F.in[I_MIXN], n0)
        SEG(F.in[I_WIN], WIN_LD, 5152, 1024, 1024, WIN, 1024, 0, F.in[I_MIXN], 2048 + n0)
        SEG(F.in[I_WIN], WIN_LD, 7200, 256, 1024, WIN, 1024, 0, F.in[I_MIXN], 3072 + n0)
        SEG(F.in[I_WIN], WIN_LD, 2048, 3072, 1024, WIN, 1024, 0, F.in[I_MIXN], 3328 + n0)
    }
    const float* x = F.in[I_X]; bf16_t* hb = (bf16_t*)(ws + WS_HB); float* ss1 = (float*)(ws + WS_SS1);
    for (int m = 2 * gw; m < T; m += 2 * NGW) {
        const f32x4* xr = (const f32x4*)(x + (size_t)m * DM) + lane; float s0 = 0.f, s1 = 0.f; f32x4 v[8];
#pragma unroll
        for (int j = 0; j < 8; ++j) v[j] = xr[64 * j];
#pragma unroll
        for (int j = 0; j < 4; ++j) { s0 += (v[j][0] * v[j][0] + v[j][1] * v[j][1]) + (v[j][2] * v[j][2] + v[j][3] * v[j][3]); s1 += (v[4 + j][0] * v[4 + j][0] + v[4 + j][1] * v[4 + j][1]) + (v[4 + j][2] * v[4 + j][2] + v[4 + j][3] * v[4 + j][3]); }
        s0 = wave_sum(s0); s1 = wave_sum(s1); if (lane == 0) { ss1[m] = s0; ss1[m + 1] = s1; }
        u32x2* o = (u32x2*)(hb + (size_t)m * DM) + lane;
#pragma unroll
        for (int j = 0; j < 8; ++j) o[64 * j] = pack4(v[j]);
    }
}
DI void mid_convert(const Frame& F, int first_blk) {
    unsigned char* ws = F.ws;
    if (F.bid - first_blk < 64) kv_item(F, F.bid - first_blk);
    LAS float* scr = (LAS float*)(F.lds + F.wave * 16384); const int lane = F.lane;
    const int gw = (F.bid - first_blk) * 8 + F.wave, NGW = (F.G - first_blk) * 8;
    bf16_t* W1D = (bf16_t*)(ws + WS_W1D); bf16_t* WIN = (bf16_t*)(ws + WS_WIN); bf16_t* WG = (bf16_t*)(ws + WS_WG); bf16_t* WBR = (bf16_t*)(ws + WS_WBR);
    constexpr int NITEMS = 16 * ((1024 + 32) / 32) + 16 * 96 + (32 + 16 + 4) * 32;
    for (int it = gw; it < NITEMS; it += NGW) {
        int r = it;
        SEG(F.in[I_WIN], WIN_LD, 6176, 1024, 1024, WIN, 1024, 0, F.in[I_MIXN], 6400 + n0)
        SEG(F.in[I_WIN], WIN_LD, 5120, 32, 1024, WIN, 1024, 0, F.in[I_MIXN], 7424 + n0)
        SEG(F.in[I_WIN], WIN_LD, 7456, 3072, 1024, WG, 1024, 0, F.in[I_MIXN], n0)
        SEG(F.in[I_WBS], 1024, 0, 1024, 2048, WBR, KBR, 0, F.in[I_SSDN], n0)
        SEG(F.in[I_WBG], 1024, 0, 1024, 1024, WBR, KBR, 2048, (const float*)nullptr, n0)
        SEG(F.in[I_WBM], 1024, 0, 1024, 256, WBR, KBR, 3072, (const float*)nullptr, n0)
    }
}
DI void late_convert(const Frame& F, int first_blk) {
    unsigned char* ws = F.ws; LAS float* scr = (LAS float*)(F.lds + F.wave * 16384); const int lane = F.lane;
    const int gw = (F.bid - first_blk) * 8 + F.wave, NGW = (F.G - first_blk) * 8;
    bf16_t* W2GU = (bf16_t*)(ws + WS_W2GU); bf16_t* W2D = (bf16_t*)(ws + WS_W2D); bf16_t* WOUT = (bf16_t*)(ws + WS_WOUT);
    constexpr int NITEMS = (3 * 1408) + 512;
    for (int it = gw; it < NITEMS; it += NGW) {
        int r = it;
        SEG(F.in[I_F2G], FF, 0, FF, 1024, W2GU, 1024, 0, F.in[I_F2N], (n0 / 128) * 256 + (n0 % 128))
        SEG(F.in[I_F2U], FF, 0, FF, 1024, W2GU, 1024, 0, F.in[I_F2N], (n0 / 128) * 256 + 128 + (n0 % 128))
        SEG(F.in[I_F2D], 1024, 0, 1024, FF, W2D, FF, 0, (const float*)nullptr, n0)
        SEG(F.in[I_WOUT], 1024, 0, 1024, 1024, WOUT, 1024, 0, (const float*)nullptr, n0)
    }
}
DI void final_norm(const Frame& F) {
    const float* ss4 = (const float*)(F.ws + WS_SS4); const float* g = F.in[I_FINN];
    const int gw = F.bid * 8 + F.wave, NGW = F.G * 8, lane = F.lane;
    f32x4 gv[4];
#pragma unroll
    for (int j = 0; j < 4; ++j) gv[j] = ((const f32x4*)g)[lane + 64 * j];
    for (int m = gw; m < T; m += NGW) {
        f32x4* xr = (f32x4*)(F.out + (size_t)m * DM) + lane; const float r = rstd_of(ss4[m], 1.f / 1024.f);
#pragma unroll
        for (int j = 0; j < 4; ++j) xr[64 * j] = xr[64 * j] * r * gv[j];
    }
}

DI void ssd_scan_prep(const Frame& F, const float* dt, int gr0, int h0, LAS float* acs, LAS float* dts, LAS float* wtot) {
    const int hl = F.tid >> 7, l = F.tid & 127, h = h0 + hl;
    const float a = -__expf(F.in[I_ALOG][h]);
    const float d = dt[(size_t)(gr0 + l) * 32 + h];
    float v = d * a;
#pragma unroll
    for (int o = 1; o < 64; o <<= 1) { const float t = __shfl_up(v, o); if (F.lane >= o) v += t; }
    if (F.lane == 63) wtot[F.wave] = v;
    __syncthreads();
    if (F.wave & 1) v += wtot[F.wave - 1];
    acs[hl * 128 + l] = v; dts[hl * 128 + l] = d;
    __syncthreads();
}
template <bool SCALED, int NCH> DI void stage_conv_T(lptr dst, const bf16_t* xbc, int t0, int chan0, const float* cw, const float* cb, const LAS float* scale, int tid) {
    constexpr int ncp = NCH >> 1, ntask = ncp * 16;
#pragma unroll 2
    for (int it_ = 0; it_ < ntask / 512; ++it_) { const int task = tid + 512 * it_;
        const int cp = task % ncp, tb = task / ncp, ch = chan0 + 2 * cp, l0 = tb * 8;
        float w[4][2];
#pragma unroll
        for (int k = 0; k < 4; ++k) { w[k][0] = cw[k * XBC_LD + ch]; w[k][1] = cw[k * XBC_LD + ch + 1]; }
        const float b0 = cb[ch], b1 = cb[ch + 1];
        float r0[11], r1[11];
#pragma unroll
        for (int i = 0; i < 11; ++i) { const int l = l0 - 3 + i; unsigned v = 0u; if (t0 + l >= 0) v = *(const unsigned*)(xbc + (long)(t0 + l) * XBC_LD + ch); r0[i] = bflo(v); r1[i] = bfhi(v); }
        f32x4 o0[2], o1[2];
#pragma unroll
        for (int j = 0; j < 8; ++j) {
            float y0 = b0 + w[0][0] * r0[j] + w[1][0] * r0[j + 1] + w[2][0] * r0[j + 2] + w[3][0] * r0[j + 3];
            float y1 = b1 + w[0][1] * r1[j] + w[1][1] * r1[j + 1] + w[2][1] * r1[j + 2] + w[3][1] * r1[j + 3];
            y0 = silu(y0); y1 = silu(y1);
            if (SCALED) { const float s = scale[((2 * cp) >> 6) * 128 + l0 + j]; y0 *= s; y1 *= s; }
            o0[j >> 2][j & 3] = y0; o1[j >> 2][j & 3] = y1;
        }
        *(LAS u32x4*)(dst + (2 * cp) * PT + l0 * 2) = pack8(o0[0], o0[1]);
        *(LAS u32x4*)(dst + (2 * cp + 1) * PT + l0 * 2) = pack8(o1[0], o1[1]);
    }
}
DI void stage_conv_N(lptr dst, const bf16_t* xbc, int t0, int chan0, const float* cw, const float* cb, int tid) {
    const int cg8 = (tid & 15) * 8, ch = chan0 + cg8;
    float w[4][8], b[8];
#pragma unroll
    for (int k = 0; k < 4; ++k) { const f32x4 a = *(const f32x4*)(cw + k * XBC_LD + ch), c = *(const f32x4*)(cw + k * XBC_LD + ch + 4);
#pragma unroll
        for (int e = 0; e < 4; ++e) { w[k][e] = a[e]; w[k][4 + e] = c[e]; } }
    { const f32x4 a = *(const f32x4*)(cb + ch), c = *(const f32x4*)(cb + ch + 4);
#pragma unroll
        for (int e = 0; e < 4; ++e) { b[e] = a[e]; b[4 + e] = c[e]; } }
#pragma unroll
    for (int i = 0; i < 4; ++i) {
        const int l = (tid >> 4) + 32 * i;
        float y[8];
#pragma unroll
        for (int e = 0; e < 8; ++e) y[e] = b[e];
#pragma unroll
        for (int k = 0; k < 4; ++k) { const int t = t0 + l - 3 + k; u32x4 v = (u32x4){0u, 0u, 0u, 0u}; if (t >= 0) v = *(const u32x4*)(xbc + (long)t * XBC_LD + ch);
#pragma unroll
            for (int q = 0; q < 4; ++q) { y[2 * q] += w[k][2 * q] * bflo(v[q]); y[2 * q + 1] += w[k][2 * q + 1] * bfhi(v[q]); } }
        f32x4 o0, o1;
#pragma unroll
        for (int e = 0; e < 4; ++e) { o0[e] = silu(y[e]); o1[e] = silu(y[4 + e]); }
        *(LAS u32x4*)(dst + l * PT + cg8 * 2) = pack8(o0, o1);
    }
}
struct Half { int b; bf16_t* zuq; bf16_t* xbc; bf16_t* gv; bf16_t* st; float* cdec; const float* dt; int row_base; };

DI void ssd_a_item(const Frame& F, const Half& H, int item) {
    const int c = item >> 3, g = (item >> 1) & 3, hh = item & 1, h0 = g * 8 + hh * 4, t0 = c * 128;
    lptr XT = F.lds, BT = F.lds + 69632; LAS float* acs = (LAS float*)(F.lds + 139264); LAS float* dts = acs + 512; LAS float* sc = dts + 512; LAS float* wtot = sc + 512;
    ssd_scan_prep(F, H.dt, H.row_base + t0, h0, acs, dts, wtot);
    { const int hl = F.tid >> 7, l = F.tid & 127; const float last = acs[hl * 128 + 127]; sc[hl * 128 + l] = dts[hl * 128 + l] * __expf(last - acs[hl * 128 + l]);
      if (l == 127) H.cdec[c * 32 + h0 + hl] = __expf(last); }
    __syncthreads();
    stage_conv_T<true, 256>(XT, H.xbc, t0, g * 512 + hh * 256, F.in[I_CONVW], F.in[I_CONVB], sc, F.tid);
    stage_conv_T<false, 128>(BT, H.xbc, t0, 2048 + g * 128, F.in[I_CONVW], F.in[I_CONVB], nullptr, F.tid);
    __syncthreads();
    const int w = F.wave, hl = w >> 1, nh = w & 1, fr = F.lane & 15, fq = F.lane >> 4;
    f32x4 acc[4][4];
#pragma unroll
    for (int i = 0; i < 4; ++i)
#pragma unroll
        for (int j = 0; j < 4; ++j) acc[i][j] = (f32x4){0.f, 0.f, 0.f, 0.f};
#pragma unroll
    for (int ks = 0; ks < 4; ++ks) {
        bf16x8 xf[4], yf[4];
#pragma unroll
        for (int i = 0; i < 4; ++i) { xf[i] = *(const LAS bf16x8*)(BT + (nh * 64 + 16 * i + fr) * PT + ks * 64 + fq * 16); yf[i] = *(const LAS bf16x8*)(XT + (hl * 64 + 16 * i + fr) * PT + ks * 64 + fq * 16); }
#pragma unroll
        for (int i = 0; i < 4; ++i)
#pragma unroll
            for (int j = 0; j < 4; ++j) acc[i][j] = MFMA16(xf[i], yf[j], acc[i][j]);
    }
    bf16_t* dst = H.st + (size_t)(c * 32 + h0 + hl) * 8192;
#pragma unroll
    for (int i = 0; i < 4; ++i)
#pragma unroll
        for (int j = 0; j < 4; ++j) *(u32x2*)(dst + (16 * j + fr) * 128 + nh * 64 + 16 * i + 4 * fq) = pack4(acc[i][j]);
    __syncthreads();
}
DI void ssd_scan(const Frame& F, const Half& H) {
    for (int e = F.bid * 512 + F.tid; e < 131072; e += F.G * 512) {
        const int h = e >> 12; unsigned* p = (unsigned*)H.st + e; float r0 = 0.f, r1 = 0.f;
#pragma unroll 8
        for (int c = 0; c < 64; ++c) { const unsigned wv = p[(size_t)c * 131072]; const float dec = H.cdec[c * 32 + h]; p[(size_t)c * 131072] = cvt_pk_bf16(r0, r1); r0 = r0 * dec + bflo(wv); r1 = r1 * dec + bfhi(wv); }
    }
}
DI void ssd_c_item(const Frame& F, const Half& H, int item) {
    const int c = item >> 2, g = item & 3, t0 = c * 128;
    lptr XT = F.lds, Cn = F.lds + 69632, Bn = F.lds + 104448; LAS float* acs = (LAS float*)(F.lds + 139264); LAS float* dts = acs + 512; LAS float* wtot = dts + 512; LAS float* tss = wtot + 16;
    stage_conv_N(Bn, H.xbc, t0, 2048 + g * 128, F.in[I_CONVW], F.in[I_CONVB], F.tid);
    stage_conv_N(Cn, H.xbc, t0, 2560 + g * 128, F.in[I_CONVW], F.in[I_CONVB], F.tid);
    __syncthreads();
    const int w = F.wave, fr = F.lane & 15, fq = F.lane >> 4;
    {
        const int lt0 = (w >> 1) * 2, st0 = (w & 1) * 4;
        f32x4 cb[4][2];
#pragma unroll
        for (int i = 0; i < 4; ++i) { cb[i][0] = (f32x4){0.f, 0.f, 0.f, 0.f}; cb[i][1] = cb[i][0]; }
#pragma unroll
        for (int ks = 0; ks < 4; ++ks) {
            bf16x8 xf[4], yf[2];
#pragma unroll
            for (int i = 0; i < 4; ++i) xf[i] = *(const LAS bf16x8*)(Bn + (16 * (st0 + i) + fr) * PT + ks * 64 + fq * 16);
#pragma unroll
            for (int j = 0; j < 2; ++j) yf[j] = *(const LAS bf16x8*)(Cn + (16 * (lt0 + j) + fr) * PT + ks * 64 + fq * 16);
#pragma unroll
            for (int i = 0; i < 4; ++i)
#pragma unroll
                for (int j = 0; j < 2; ++j) cb[i][j] = MFMA16(xf[i], yf[j], cb[i][j]);
        }
        __syncthreads();
#pragma unroll
        for (int i = 0; i < 4; ++i)
#pragma unroll
            for (int j = 0; j < 2; ++j) *(LAS u32x2*)(Bn + (16 * (lt0 + j) + fr) * PT + (16 * (st0 + i) + 4 * fq) * 2) = pack4(cb[i][j]);
    }
    const int hl = w >> 1, lh = w & 1;
#pragma unroll 1
    for (int hh = 0; hh < 2; ++hh) {
        const int h0 = g * 8 + hh * 4, h = h0 + hl;
        __syncthreads();
        ssd_scan_prep(F, H.dt, H.row_base + t0, h0, acs, dts, wtot);
        stage_conv_T<false, 256>(XT, H.xbc, t0, g * 512 + hh * 256, F.in[I_CONVW], F.in[I_CONVB], nullptr, F.tid);
        __syncthreads();
        f32x4 accd[4][4];
#pragma unroll
        for (int i = 0; i < 4; ++i)
#pragma unroll
            for (int j = 0; j < 4; ++j) accd[i][j] = (f32x4){0.f, 0.f, 0.f, 0.f};
        const LAS float* ah = acs + hl * 128; const LAS float* dh = dts + hl * 128;
        const bf16_t* Sp = H.st + (size_t)(c * 32 + h) * 8192;
#pragma unroll
        for (int ks = 0; ks < 4; ++ks) {
            bf16x8 xf[4], yf[4];
#pragma unroll
            for (int i = 0; i < 4; ++i) { xf[i] = *(const bf16x8*)(Sp + (16 * i + fr) * 128 + ks * 32 + fq * 8); yf[i] = *(const LAS bf16x8*)(Cn + (lh * 64 + 16 * i + fr) * PT + ks * 64 + fq * 16); }
#pragma unroll
            for (int i = 0; i < 4; ++i)
#pragma unroll
                for (int j = 0; j < 4; ++j) accd[i][j] = MFMA16(xf[i], yf[j], accd[i][j]);
        }
#pragma unroll
        for (int j = 0; j < 4; ++j) { const float el = __expf(ah[lh * 64 + 16 * j + fr]);
#pragma unroll
            for (int i = 0; i < 4; ++i) accd[i][j] = accd[i][j] * el; }
        const int nks = lh ? 4 : 2;
        for (int ks = 0; ks < nks; ++ks) {
            bf16x8 xf[4], yf[4];
            const int s0 = ks * 32 + fq * 8;
            const f32x4 as0 = *(const LAS f32x4*)(ah + s0), as1 = *(const LAS f32x4*)(ah + s0 + 4), ds0 = *(const LAS f32x4*)(dh + s0), ds1 = *(const LAS f32x4*)(dh + s0 + 4);
#pragma unroll
            for (int j = 0; j < 4; ++j) {
                const int l = lh * 64 + 16 * j + fr; const float al = ah[l];
                const u32x4 cbv = *(const LAS u32x4*)(Bn + l * PT + s0 * 2);
                f32x4 o0, o1;
#pragma unroll
                for (int q = 0; q < 4; ++q) {
                    const int sa = s0 + 2 * q, sb = sa + 1;
                    const float asa = (q < 2) ? as0[2 * q] : as1[2 * q - 4], asb = (q < 2) ? as0[2 * q + 1] : as1[2 * q - 3];
                    const float dsa = (q < 2) ? ds0[2 * q] : ds1[2 * q - 4], dsb = (q < 2) ? ds0[2 * q + 1] : ds1[2 * q - 3];
                    const float va = (sa <= l) ? bflo(cbv[q]) * __expf(al - asa) * dsa : 0.f;
                    const float vb = (sb <= l) ? bfhi(cbv[q]) * __expf(al - asb) * dsb : 0.f;
                    if (q < 2) { o0[2 * q] = va; o0[2 * q + 1] = vb; } else { o1[2 * q - 4] = va; o1[2 * q - 3] = vb; }
                }
                yf[j] = __builtin_bit_cast(bf16x8, pack8(o0, o1));
            }
#pragma unroll
            for (int i = 0; i < 4; ++i) xf[i] = *(const LAS bf16x8*)(XT + (hl * 64 + 16 * i + fr) * PT + ks * 64 + fq * 16);
#pragma unroll
            for (int i = 0; i < 4; ++i)
#pragma unroll
                for (int j = 0; j < 4; ++j) accd[i][j] = MFMA16(xf[i], yf[j], accd[i][j]);
        }
        const float Dh = F.in[I_SSDD][h];
#pragma unroll
        for (int j = 0; j < 4; ++j) {
            const int l = lh * 64 + 16 * j + fr; float sq = 0.f;
            bf16_t* zr = H.zuq + (size_t)(t0 + l) * ZUQ_LD + h * 64;
#pragma unroll
            for (int i = 0; i < 4; ++i) {
                const int p = 16 * i + 4 * fq;
                const u32x2 zv = *(const u32x2*)(zr + p);
                f32x4 y;
#pragma unroll
                for (int e = 0; e < 4; ++e) { const float xv = __uint_as_float(((unsigned)*(const LAS unsigned short*)(XT + (hl * 64 + p + e) * PT + l * 2)) << 16); y[e] = accd[i][j][e] + Dh * xv; }
                y[0] *= bflo(zv[0]); y[1] *= bfhi(zv[0]); y[2] *= bflo(zv[1]); y[3] *= bfhi(zv[1]);
                sq += (y[0] * y[0] + y[1] * y[1]) + (y[2] * y[2] + y[3] * y[3]);
                *(u32x2*)(zr + p) = pack4(y);
            }
            sq += __shfl_xor(sq, 16); sq += __shfl_xor(sq, 32);
            if (fq == 0) tss[(hh * 4 + hl) * 128 + l] = sq;
        }
    }
    __syncthreads();
    {
        const int l = F.tid >> 2, qd = F.tid & 3; float tsum = 0.f;
#pragma unroll
        for (int k = 0; k < 8; ++k) tsum += tss[k * 128 + l];
        const float r = rstd_of(tsum, 1.f / 512.f);
        u32x4* p = (u32x4*)(H.zuq + (size_t)(t0 + l) * ZUQ_LD + g * 512 + qd * 128);
#pragma unroll
        for (int i = 0; i < 16; ++i) { const u32x4 v = p[i]; f32x4 a, b; a[0] = bflo(v[0]) * r; a[1] = bfhi(v[0]) * r; a[2] = bflo(v[1]) * r; a[3] = bfhi(v[1]) * r; b[0] = bflo(v[2]) * r; b[1] = bfhi(v[2]) * r; b[2] = bflo(v[3]) * r; b[3] = bfhi(v[3]) * r; p[i] = pack8(a, b); }
    }
    __syncthreads();
}


DI void gmlp_item(const Frame& F, const Half& H, int item) {
    const int c = item >> 3, g = item & 7, t0 = c * 128, d0 = g * 128, tid = F.tid;
    lptr VT = F.lds, WS = F.lds + 34816; LAS float* rv = (LAS float*)(F.lds + 69632);
    const float* ssv = (const float*)(F.ws + WS_SSV);
    if (tid < 128) rv[tid] = rstd_of(ssv[H.row_base + t0 + tid], 1.f / 1024.f);
    __syncthreads();
#pragma unroll
    for (int i = 0; i < 4; ++i) {
        const int v = tid + 512 * i, s = v >> 4, seg = v & 15;
        const u32x4 pk = *(const u32x4*)(H.gv + (size_t)(t0 + s) * DM + d0 + seg * 8);
#pragma unroll
        for (int e = 0; e < 8; ++e) { const unsigned short hv = (unsigned short)((e & 1) ? (pk[e >> 1] >> 16) : (pk[e >> 1] & 0xffffu)); *(LAS unsigned short*)(VT + (seg * 8 + e) * PT + s * 2) = hv; }
        const int t = s, s0 = seg * 8;
        const float* wp = F.in[I_GWS] + (size_t)(g * 128 + t) * 128 + s0; const f32x4 w0 = *(const f32x4*)wp, w1 = *(const f32x4*)(wp + 4);
        f32x4 o0, o1;
#pragma unroll
        for (int e = 0; e < 4; ++e) { o0[e] = (s0 + e <= t) ? w0[e] * rv[s0 + e] : 0.f; o1[e] = (s0 + 4 + e <= t) ? w1[e] * rv[s0 + 4 + e] : 0.f; }
        *(LAS u32x4*)(WS + t * PT + s0 * 2) = pack8(o0, o1);
    }
    __syncthreads();
    const int w = F.wave, fr = F.lane & 15, fq = F.lane >> 4, mtb = (w & 3) * 2, ntb = (w >> 2) * 4;
    f32x4 acc[2][4];
#pragma unroll
    for (int i = 0; i < 2; ++i)
#pragma unroll
        for (int j = 0; j < 4; ++j) acc[i][j] = (f32x4){0.f, 0.f, 0.f, 0.f};
    const int nks = ntb ? 4 : 2;
    for (int ks = 0; ks < nks; ++ks) {
        bf16x8 xf[2], yf[4];
#pragma unroll
        for (int i = 0; i < 2; ++i) xf[i] = *(const LAS bf16x8*)(VT + (16 * (mtb + i) + fr) * PT + ks * 64 + fq * 16);
#pragma unroll
        for (int j = 0; j < 4; ++j) yf[j] = *(const LAS bf16x8*)(WS + (16 * (ntb + j) + fr) * PT + ks * 64 + fq * 16);
#pragma unroll
        for (int i = 0; i < 2; ++i)
#pragma unroll
            for (int j = 0; j < 4; ++j) acc[i][j] = MFMA16(xf[i], yf[j], acc[i][j]);
    }
#pragma unroll
    for (int j = 0; j < 4; ++j) {
        const int t = 16 * (ntb + j) + fr; const float bias = F.in[I_GBS][g * 128 + t];
#pragma unroll
        for (int i = 0; i < 2; ++i) {
            const int d = d0 + 16 * (mtb + i) + 4 * fq;
            const f32x4 gn = *(const f32x4*)(F.in[I_GVN] + d);
            bf16_t* up = H.zuq + (size_t)(t0 + t) * ZUQ_LD + 2048 + d;
            const u32x2 uv = *(const u32x2*)up;
            f32x4 y;
            y[0] = bflo(uv[0]) * (gn[0] * acc[i][j][0] + bias); y[1] = bfhi(uv[0]) * (gn[1] * acc[i][j][1] + bias);
            y[2] = bflo(uv[1]) * (gn[2] * acc[i][j][2] + bias); y[3] = bfhi(uv[1]) * (gn[3] * acc[i][j][3] + bias);
            *(u32x2*)up = pack4(y);
        }
    }
    __syncthreads();
}
DI void memattn_item(const Frame& F, const Half& H, int item) {
    const int h = item & 3, t0 = (item >> 2) * 128, tid = F.tid, w = F.wave, fr = F.lane & 15, fq = F.lane >> 4;
    lptr Ks = F.lds, VT = F.lds + 36864, Pw = F.lds + 70656 + w * 8448;
    const bf16_t* Kmem = (const bf16_t*)(F.ws + WS_KMEM) + (size_t)H.b * 256 * 256; const bf16_t* VmemT = (const bf16_t*)(F.ws + WS_VMEMT) + (size_t)H.b * 256 * 256;
#pragma unroll
    for (int i = 0; i < 4; ++i) {
        const int v = tid + 512 * i;
        { const int m = v >> 3, seg = v & 7; *(LAS u32x4*)(Ks + m * 144 + seg * 16) = *(const u32x4*)(Kmem + (size_t)m * 256 + h * 64 + seg * 8); }
        { const int d = v >> 5, seg = v & 31; *(LAS u32x4*)(VT + d * 528 + seg * 16) = *(const u32x4*)(VmemT + (size_t)(h * 64 + d) * 256 + seg * 8); }
    }
    __syncthreads();
    for (int sub = 0; sub < 1; ++sub) {
        const int tw = t0 + sub * 128 + w * 16;
        bf16_t* qrow = H.zuq + (size_t)(tw + fr) * ZUQ_LD + 3072 + h * 64;
        bf16x8 qf[2];
        qf[0] = *(const bf16x8*)(qrow + fq * 8); qf[1] = *(const bf16x8*)(qrow + 32 + fq * 8);
        f32x4 s[16];
#pragma unroll
        for (int i = 0; i < 16; ++i) { s[i] = (f32x4){0.f, 0.f, 0.f, 0.f};
#pragma unroll
            for (int ks = 0; ks < 2; ++ks) { const bf16x8 kf = *(const LAS bf16x8*)(Ks + (16 * i + fr) * 144 + ks * 64 + fq * 16); s[i] = MFMA16(kf, qf[ks], s[i]); } }
        float mx = -3.0e38f;
#pragma unroll
        for (int i = 0; i < 16; ++i) mx = fmaxf(mx, fmaxf(fmaxf(s[i][0], s[i][1]), fmaxf(s[i][2], s[i][3])));
        mx = fmaxf(mx, __shfl_xor(mx, 16)); mx = fmaxf(mx, __shfl_xor(mx, 32));
        float sum = 0.f;
#pragma unroll
        for (int i = 0; i < 16; ++i) { f32x4 p;
#pragma unroll
            for (int e = 0; e < 4; ++e) { p[e] = __builtin_amdgcn_exp2f(s[i][e] - mx); sum += p[e]; }
            *(LAS u32x2*)(Pw + fr * 528 + (16 * i + 4 * fq) * 2) = pack4(p); }
        sum += __shfl_xor(sum, 16); sum += __shfl_xor(sum, 32);
        LDS_WAIT(); __builtin_amdgcn_wave_barrier();
        f32x4 o[4];
#pragma unroll
        for (int i = 0; i < 4; ++i) o[i] = (f32x4){0.f, 0.f, 0.f, 0.f};
#pragma unroll
        for (int ks = 0; ks < 8; ++ks) { const bf16x8 pf = *(const LAS bf16x8*)(Pw + fr * 528 + ks * 64 + fq * 16);
#pragma unroll
            for (int i = 0; i < 4; ++i) { const bf16x8 vf = *(const LAS bf16x8*)(VT + (16 * i + fr) * 528 + ks * 64 + fq * 16); o[i] = MFMA16(vf, pf, o[i]); } }
        const float inv = __builtin_amdgcn_rcpf(sum);
#pragma unroll
        for (int i = 0; i < 4; ++i) *(u32x2*)(qrow + 16 * i + 4 * fq) = pack4(o[i] * inv);
        LDS_WAIT(); __builtin_amdgcn_wave_barrier();
    }
    __syncthreads();
}

#define PH_GEMM(EpiT, Aptr, Bptr, Mm, Nn, Kk, Eobj) do { pg8::Gemm g_{(const bf16_t*)(Aptr), (const bf16_t*)(Bptr), Mm, Nn, Kk}; pg8::StaticOrder S_; S_.init(Mm, Nn, F.G, F.bid); \
        pg8::gemm_phase<EpiT, pg8::StaticOrder, true, true>(F.lds, g_, S_, Eobj); } while (0)

__global__ void __launch_bounds__(512) mega_fwd(Args args) {
    extern __shared__ __attribute__((aligned(16))) unsigned char lds_raw[];
    cg::grid_group grid = cg::this_grid();
    Frame F; F.lds = (lptr)lds_raw; F.ws = args.ws; F.in = args.in; F.out = args.out;
    F.tid = threadIdx.x; F.lane = F.tid & 63; F.wave = __builtin_amdgcn_readfirstlane(F.tid >> 6); F.G = gridDim.x; F.bid = blockIdx.x;
    unsigned char* ws = args.ws;
    const int lo = args.ph_lo, hi = args.ph_hi;
    { volatile LAS unsigned* st_ = (volatile LAS unsigned*)(F.lds + LDS_BARST); if (F.tid < 2) st_[F.tid] = 0u; }
    __syncthreads();
    XcdBarrier xbar; xbar.bar = (unsigned*)(ws + WS_BAR); xbar.x = 0; xbar.st = nullptr;
    if (hi - lo > 1) grid.sync();
    if (hi - lo > 1) xbar = xcd_barrier_post((unsigned*)(ws + WS_BAR), (volatile LAS unsigned*)(F.lds + LDS_BARST));
#define HB ((bf16_t*)(ws + WS_HB))
#define ACT ((bf16_t*)(ws + WS_ACT))
#define MG ((bf16_t*)(ws + WS_MG))
#define SS1 ((float*)(ws + WS_SS1))
#define SS2 ((float*)(ws + WS_SS2))
#define SS3 ((float*)(ws + WS_SS3))
#define SS4 ((float*)(ws + WS_SS4))
#ifndef PHMASK
#define PHMASK 0xFFFFFFFFu
#endif
#define RELAUNDER() do { int t_ = threadIdx.x; asm volatile("" : "+v"(t_)); F.tid = t_; F.lane = t_ & 63; F.wave = __builtin_amdgcn_readfirstlane(t_ >> 6); \
        unsigned long long w_ = (unsigned long long)args.ws; asm volatile("" : "+s"(w_)); ws = (unsigned char*)w_; F.ws = ws; } while (0)
#define IN(k) (((PHMASK >> ((k) > 8 ? (k) - 6 : (k))) & 1u) && lo <= (k) && (k) < hi)
#define SEAM(k) do { if ((k) + 1 < hi) { xcd_barrier(xbar); } } while (0)

    if (IN(0)) { RELAUNDER(); prologue(F); SEAM(0); }
    if (IN(1)) { RELAUNDER(); EpiGLU E{SS1, ACT}; PH_GEMM(EpiGLU, HB, ws + WS_W1GU, T, 2 * FF, DM, E);
        if (F.G >= 256) { if (F.bid >= 128) mid_convert(F, 128); } else mid_convert(F, 0);
        SEAM(1); }
    if (IN(2)) { RELAUNDER(); EpiRes E{F.in[I_X], F.out, HB, SS2, 0.5f}; PH_GEMM(EpiRes, ACT, ws + WS_W1D, T, DM, FF, E); SEAM(2); }
#pragma unroll 1
    for (int b = 0; b < 2; ++b) {
        const int k0 = 3 + 6 * b;
#define MKHALF() Half H; H.b = b; H.zuq = (bf16_t*)(ws + WS_ZUQ); H.xbc = (bf16_t*)(ws + WS_XBC); H.gv = MG + (size_t)TB * DM; H.st = (bf16_t*)(ws + WS_ST); H.cdec = (float*)(ws + WS_CDEC) + b * 2048; H.dt = (const float*)(ws + WS_DT); H.row_base = b * TB;
        if (IN(k0)) { RELAUNDER(); MKHALF(); EpiWin E{H.row_base, SS2, H.zuq, H.xbc, H.gv, (float*)(ws + WS_DT), F.in[I_DTB], (float*)(ws + WS_SSV)};
            PH_GEMM(EpiWin, HB + (size_t)H.row_base * DM, ws + WS_WIN, TB, NWIN, DM, E); SEAM(k0); }
        if (IN(k0 + 1)) { RELAUNDER(); MKHALF();
            for (int it = F.bid; it < 512 + 512 + 256; it += F.G) {
                if (it < 512) ssd_a_item(F, H, it); else if (it < 1024) gmlp_item(F, H, it - 512); else memattn_item(F, H, it - 1024);
            }
            SEAM(k0 + 1); }
        if (IN(k0 + 2)) { RELAUNDER(); MKHALF(); ssd_scan(F, H); SEAM(k0 + 2); }
        if (IN(k0 + 3)) { RELAUNDER(); MKHALF(); for (int it = F.bid; it < 256; it += F.G) ssd_c_item(F, H, it); SEAM(k0 + 3); }
        if (IN(k0 + 4)) { RELAUNDER(); MKHALF(); if (b == 0) { if (F.G >= 256) { if (F.bid >= 128) late_convert(F, 128); } else late_convert(F, 0); __syncthreads(); }
            EpiGates E{H.row_base, SS2, H.xbc}; PH_GEMM(EpiGates, HB + (size_t)H.row_base * DM, ws + WS_WG, TB, GATE_LD, DM, E); SEAM(k0 + 4); }
        if (IN(k0 + 5)) { RELAUNDER(); MKHALF(); EpiMerge E{H.xbc, (float*)(ws + WS_ST), MG + (size_t)b * TB * DM};
            { pg8::Gemm g_{(const bf16_t*)H.zuq, (const bf16_t*)(ws + WS_WBR), TB, DM, KBR}; pg8::SegOrder<3> S_; S_.init(TB, 2 * DM, F.G, F.bid);     pg8::gemm_phase<EpiMerge, pg8::SegOrder<3>, true, true>(F.lds, g_, S_, E); } SEAM(k0 + 5); }
    }
    if (IN(15)) { RELAUNDER(); EpiRes E{F.out, F.out, HB, SS3, 1.0f}; PH_GEMM(EpiRes, MG, ws + WS_WOUT, T, DM, DM, E); SEAM(15); }
    if (IN(16)) { RELAUNDER(); EpiGLU E{SS3, ACT}; PH_GEMM(EpiGLU, HB, ws + WS_W2GU, T, 2 * FF, DM, E); SEAM(16); }
    if (IN(17)) { RELAUNDER(); EpiResNorm E{F.out, F.out, SS4, (unsigned*)(ws + WS_PCNT), F.in[I_FINN], 0.5f}; PH_GEMM(EpiResNorm, ACT, ws + WS_W2D, T, DM, FF, E); }
}

#ifndef N_PHASES
#define N_PHASES 18
#endif
#ifndef ONE_LAUNCH
#define ONE_LAUNCH 1
#endif
extern "C" void kernel_launch(void* const* d_in, const int* in_sizes, int n_in, void* d_out, int out_size, void* d_ws, size_t ws_size, hipStream_t stream) {
    static int grid = 0;
    if (grid == 0) {
        int dev = 0, cus = 0, per_cu = 0;
        hipGetDevice(&dev); hipDeviceGetAttribute(&cus, hipDeviceAttributeMultiprocessorCount, dev);
        if (hipFuncSetAttribute((const void*)mega_fwd, hipFuncAttributeMaxDynamicSharedMemorySize, LDS_BYTES) != hipSuccess) { fprintf(stderr, "kernel_launch: hipFuncSetAttribute failed\n"); grid = -1; return; }
        if (hipOccupancyMaxActiveBlocksPerMultiprocessor(&per_cu, (const void*)mega_fwd, 512, LDS_BYTES) != hipSuccess || per_cu < 1) { fprintf(stderr, "kernel_launch: occupancy query says %d\n", per_cu); per_cu = 1; }
        (void)hipGetLastError();
        grid = cus;
        if (n_in != 28 || ws_size < WS_END) { fprintf(stderr, "kernel_launch: unexpected n_in %d / ws %zu\n", n_in, ws_size); grid = -1; return; }
    }
    if (grid < 0) return;
    if (hipMemsetAsync((char*)d_ws + WS_BAR, 0, BAR_BYTES, stream) != hipSuccess) { fprintf(stderr, "kernel_launch: memset failed\n"); return; }
    Args a{};
    for (int i = 0; i < 28; ++i) a.in[i] = (const float*)d_in[i];
    a.out = (float*)d_out; a.ws = (unsigned char*)d_ws;
#if ONE_LAUNCH
    a.ph_lo = 0; a.ph_hi = N_PHASES;
    void* kargs[] = {&a};
    hipError_t e = hipLaunchCooperativeKernel((const void*)mega_fwd, dim3(grid), dim3(512), kargs, LDS_BYTES, stream);
    if (e != hipSuccess) fprintf(stderr, "cooperative launch failed: %s (grid %d)\n", hipGetErrorString(e), grid);
#else
    for (int k = 0; k < N_PHASES; ++k) { a.ph_lo = k; a.ph_hi = k + 1; hipLaunchKernelGGL(mega_fwd, dim3(grid), dim3(512), LDS_BYTES, stream, a); }
#endif
}
```

```cpp
#include <hip/hip_runtime.h>
#include <hip/hip_cooperative_groups.h>
#include <cstdio>
#include <cstdint>
namespace cg = cooperative_groups;
namespace pg8 {
#define PG8_LAS __attribute__((address_space(3)))
typedef unsigned short bf16_t;
typedef short bf16x8 __attribute__((ext_vector_type(8)));
typedef float f32x4 __attribute__((ext_vector_type(4)));
typedef unsigned u32x4 __attribute__((ext_vector_type(4)));
constexpr int BM = 256, BK = 64, HALF = 128, HTB = HALF * BK * 2  , STAGE_BYTES = 8 * HTB, NXCD = 8, WGM = 8;

__host__ __device__ __forceinline__ int lds_byte(int r, int c) { const int st = (r >> 4) * 2 + (c >> 5), rr = r & 15, cc = c & 31, ob = rr * 64 + cc * 2; return st * 1024 + (ob ^ (((ob >> 9) & 1) << 5)); }
__host__ __device__ __forceinline__ void stage_rc(int b, int& R, int& C) { const int st = b / 1024, sb = b % 1024, swz = sb ^ (((sb >> 9) & 1) << 5); R = (st >> 1) * 16 + swz / 64; C = (st & 1) * 32 + (swz % 64) / 2; }
__host__ __device__ __forceinline__ int perm32(int rho) { const int n = rho >> 4, i = rho & 15; return 8 * (i >> 2) + 4 * n + (i & 3); }

struct Unit { int pm, pn, seg; };
struct Gemm { const bf16_t* A; const bf16_t* Bt; int M, N, K; };

struct StaticOrder {
    int nM, nN, nwg, G, c;
    __host__ __device__ void init(int M, int N, int G_, int c_) { nM = M / BM; nN = N / BM; nwg = nM * nN; G = G_; c = c_; }
    __host__ __device__ bool next(int i, Unit& u) const {
        const long L = (long)i * G + c; if (L >= nwg) return false;
        int wgid = (int)L; { const int q = nwg / NXCD, r = nwg % NXCD, xcd = wgid % NXCD, off = wgid / NXCD; wgid = (xcd < r ? xcd * (q + 1) : r * (q + 1) + (xcd - r) * q) + off; }
        const int nig = WGM * nN, gid = wgid / nig, fm = gid * WGM, gsz = (nM - fm) < WGM ? (nM - fm) : WGM;
        u.pm = fm + ((wgid % nig) % gsz); u.pn = (wgid % nig) / gsz; u.seg = 0; return true;
    }
    __device__ __forceinline__ void a_ready(const Unit&) const {}
    __device__ __forceinline__ void done(const Unit&) const {}
};

template <int NSEG> struct SegOrder {
    StaticOrder base;
    __host__ __device__ void init(int M, int N, int G_, int c_) { base.init(M, N, G_, c_); }
    __host__ __device__ bool next(int i, Unit& u) const { if (!base.next(i / NSEG, u)) return false; u.seg = i % NSEG; return true; }
    __device__ __forceinline__ void a_ready(const Unit&) const {}
    __device__ __forceinline__ void done(const Unit&) const {}
};
__device__ __forceinline__ unsigned cvt_pk_bf16(float lo, float hi) { unsigned r; asm volatile("v_cvt_pk_bf16_f32 %0, %1, %2" : "=v"(r) : "v"(lo), "v"(hi)); return r; }
typedef float f32x2 __attribute__((ext_vector_type(2)));
__device__ __forceinline__ f32x2 gelu_pk(f32x2 v) {
    const f32x2 av = __builtin_elementwise_abs(v), d = av * 0.2316418882f + 1.0f;
    f32x2 t; t.x = __builtin_amdgcn_rcpf(d.x); t.y = __builtin_amdgcn_rcpf(d.y);
    f32x2 q = t * 0.5307027145f + (-0.7265760135f); q = q * t + 0.7107068705f; q = q * t + (-0.142248368f); q = q * t + 0.127414796f; q = q * t;
    const f32x2 s = (v * v) * (-0.72134752044f);
    f32x2 e; e.x = __builtin_amdgcn_exp2f(s.x); e.y = __builtin_amdgcn_exp2f(s.y);
    const f32x2 m = v * (q * e), r = v - m;
    f32x2 o; o.x = v.x < 0.f ? m.x : r.x; o.y = v.y < 0.f ? m.y : r.y; return o;
}
template <class Epi, class Sched, bool ALIGN_EPI = false, bool SP2 = false>
__device__ __forceinline__ void gemm_phase(PG8_LAS unsigned char* lds, const Gemm g, const Sched& S, const Epi& E) {
    int tid_ = threadIdx.x; asm volatile("" : "+v"(tid_)); const int tid = tid_, wid = __builtin_amdgcn_readfirstlane(tid >> 6), lane = tid & 63, wr = wid >> 2, wc = wid & 3, fr = lane & 15, fq = lane >> 4;
    const int K = g.K; int nt = K / BK;
    unsigned voffA[2], voffB[2];
#pragma unroll
    for (int i = 0; i < 2; ++i) { int R, C; stage_rc(tid * 16 + i * 8192, R, C); const int Rb = Epi::PERM ? ((R & ~31) + perm32(R & 31)) : R;
        voffA[i] = (unsigned)(R * K + C) * 2u; voffB[i] = (unsigned)(Rb * K + C) * 2u; }
    const size_t kstep = (size_t)(BK * 2);
    const size_t hstep = (size_t)HALF * K * 2;
    const size_t tstep = 2 * hstep;
    const unsigned ldsw = (unsigned)wid * 1024u;
    const int aoff = lds_byte(wr * 64 + fr, fq * 8), boff = lds_byte(wc * 32 + fr, fq * 8);
#define PG8_SA(b, h) (((b) * 2 + (h)) * HTB)
#define PG8_SB(b, h) ((4 + (b) * 2 + (h)) * HTB)
#define PG8_STAGE(bufoff, gbase, voff) do { _Pragma("unroll") for (int _i = 0; _i < 2; ++_i) \
        __builtin_amdgcn_global_load_lds((const unsigned*)((const char*)(gbase) + (voff)[_i]), (PG8_LAS unsigned*)(lds + (bufoff) + ldsw + _i * 8192), 16, 0, 0); } while (0)
#define PG8_LDA(dst, b, h) do { _Pragma("unroll") for (int m = 0; m < 4; ++m) _Pragma("unroll") for (int k = 0; k < 2; ++k) dst[m][k] = *(const PG8_LAS bf16x8*)(lds + PG8_SA(b, h) + aoff + m * 2048 + k * 1024); } while (0)
#define PG8_LDB(dst, b, h) do { _Pragma("unroll") for (int n = 0; n < 2; ++n) _Pragma("unroll") for (int k = 0; k < 2; ++k) dst[n][k] = *(const PG8_LAS bf16x8*)(lds + PG8_SB(b, h) + boff + n * 2048 + k * 1024); } while (0)
#define PG8_MMA(ai, bj, At, Bt) do { __builtin_amdgcn_s_setprio(1); _Pragma("unroll") for (int m = 0; m < 4; ++m) _Pragma("unroll") for (int n = 0; n < 2; ++n) _Pragma("unroll") for (int k = 0; k < 2; ++k) \
        acc[ai][bj][m][n] = __builtin_amdgcn_mfma_f32_16x16x32_bf16(Bt[n][k], At[m][k], acc[ai][bj][m][n], 0, 0, 0); __builtin_amdgcn_s_setprio(0); } while (0)
#define PG8_WAIT_V(n) asm volatile("s_waitcnt vmcnt(" #n ")" ::: "memory")
#define PG8_WAIT_L(n) asm volatile("s_waitcnt lgkmcnt(" #n ")" ::: "memory")
#define PG8_BAR __builtin_amdgcn_s_barrier()
#define PG8_SCHED __builtin_amdgcn_sched_barrier(0)
    Unit cur, nxt; int ui = 0;
    if (!S.next(0, cur)) return;
    f32x4 acc[2][2][4][2];
#pragma unroll
    for (int a = 0; a < 2; ++a)
#pragma unroll
        for (int b = 0; b < 2; ++b)
#pragma unroll
            for (int m = 0; m < 4; ++m)
#pragma unroll
                for (int n = 0; n < 2; ++n) acc[a][b][m][n] = (f32x4){0.f, 0.f, 0.f, 0.f};
    bf16x8 At[4][2], B0[2][2], B1[2][2];
    const char* cA = (const char*)g.A + (size_t)cur.pm * tstep; const char* cB = (const char*)g.Bt + (size_t)cur.pn * (Epi::HALFB ? hstep : tstep);
    if constexpr (Epi::NSEG > 1) { cA += (size_t)Epi::seg_koff(cur.seg) * 2; cB += (size_t)Epi::seg_koff(cur.seg) * 2; nt = Epi::seg_nt(cur.seg); }
    S.a_ready(cur);
    if constexpr (SP2) {
        PG8_STAGE(PG8_SB(0, 0), cB, voffB); PG8_STAGE(PG8_SB(0, 1), cB + hstep, voffB); PG8_STAGE(PG8_SA(0, 0), cA, voffA); PG8_STAGE(PG8_SA(0, 1), cA + hstep, voffA);
        if (wr == 1) PG8_BAR;
        PG8_WAIT_V(2); PG8_BAR;
        PG8_STAGE(PG8_SB(1, 0), cB + kstep, voffB); PG8_STAGE(PG8_SA(1, 0), cA + kstep, voffA); PG8_STAGE(PG8_SB(1, 1), cB + hstep + kstep, voffB);
        PG8_WAIT_V(6); PG8_BAR;
    } else {
        PG8_STAGE(PG8_SB(0, 0), cB, voffB); PG8_STAGE(PG8_SA(0, 0), cA, voffA); PG8_STAGE(PG8_SB(0, 1), cB + hstep, voffB); PG8_STAGE(PG8_SA(0, 1), cA + hstep, voffA);
        if (wr == 1) PG8_BAR;
        PG8_WAIT_V(4); PG8_BAR;
        PG8_STAGE(PG8_SB(1, 0), cB + kstep, voffB); PG8_STAGE(PG8_SA(1, 0), cA + kstep, voffA); PG8_STAGE(PG8_SB(1, 1), cB + hstep + kstep, voffB);
        PG8_WAIT_V(6); PG8_BAR;
    }
    for (;;) {
        const bool has_next = S.next(ui + 1, nxt);
        const char* nA = has_next ? (const char*)g.A + (size_t)nxt.pm * tstep : cA; const char* nB = has_next ? (const char*)g.Bt + (size_t)nxt.pn * (Epi::HALFB ? hstep : tstep) : cB;
        if constexpr (Epi::NSEG > 1) { if (has_next) { nA += (size_t)Epi::seg_koff(nxt.seg) * 2; nB += (size_t)Epi::seg_koff(nxt.seg) * 2; } }
        for (int t = 0; t < nt; t += 2) {
            const bool last = (t == nt - 2);
            const char* a1 = cA + (size_t)(t + 1) * kstep;
            const char* a2 = last ? nA : cA + (size_t)(t + 2) * kstep; const char* b2 = last ? nB : cB + (size_t)(t + 2) * kstep;
            const char* a3 = a2 + kstep; const char* b3 = b2 + kstep;
            if (last && has_next) S.a_ready(nxt);
            if constexpr (SP2) {
            PG8_LDB(B0, 0, 0); if constexpr (!Epi::HALFB) PG8_LDB(B1, 0, 1); PG8_SCHED; PG8_LDA(At, 0, 0); PG8_STAGE(PG8_SA(1, 1), a1 + hstep, voffA);
            PG8_WAIT_V(8); PG8_WAIT_L(0); PG8_BAR; PG8_MMA(0, 0, At, B0); if constexpr (!Epi::HALFB) PG8_MMA(0, 1, At, B1); PG8_BAR; PG8_SCHED;
            PG8_LDA(At, 0, 1); PG8_STAGE(PG8_SB(0, 0), b2, voffB); PG8_STAGE(PG8_SB(0, 1), b2 + hstep, voffB); PG8_STAGE(PG8_SA(0, 0), a2, voffA);
            PG8_WAIT_V(8); PG8_WAIT_L(0); PG8_BAR; PG8_MMA(1, 0, At, B0); if constexpr (!Epi::HALFB) PG8_MMA(1, 1, At, B1); PG8_BAR; PG8_SCHED;
            PG8_LDB(B0, 1, 0); if constexpr (!Epi::HALFB) PG8_LDB(B1, 1, 1); PG8_SCHED; PG8_LDA(At, 1, 0); PG8_STAGE(PG8_SA(0, 1), a2 + hstep, voffA);
            PG8_WAIT_V(8); PG8_WAIT_L(0); PG8_BAR; PG8_MMA(0, 0, At, B0); if constexpr (!Epi::HALFB) PG8_MMA(0, 1, At, B1); PG8_BAR; PG8_SCHED;
            PG8_LDA(At, 1, 1); PG8_STAGE(PG8_SB(1, 0), b3, voffB); PG8_STAGE(PG8_SB(1, 1), b3 + hstep, voffB); PG8_STAGE(PG8_SA(1, 0), a3, voffA);
            PG8_WAIT_V(8); PG8_WAIT_L(0); PG8_BAR; PG8_MMA(1, 0, At, B0); if constexpr (!Epi::HALFB) PG8_MMA(1, 1, At, B1); PG8_BAR; PG8_SCHED;
            } else {
            PG8_LDB(B0, 0, 0); PG8_SCHED; PG8_LDA(At, 0, 0); PG8_STAGE(PG8_SA(1, 1), a1 + hstep, voffA);
            PG8_WAIT_L(8); PG8_BAR; PG8_WAIT_L(0); PG8_MMA(0, 0, At, B0); PG8_BAR; PG8_SCHED;
            PG8_LDB(B1, 0, 1); PG8_STAGE(PG8_SB(0, 0), b2, voffB);
            PG8_BAR; PG8_WAIT_L(0); PG8_MMA(0, 1, At, B1); PG8_BAR;
            PG8_LDA(At, 0, 1); PG8_STAGE(PG8_SA(0, 0), a2, voffA);
            PG8_BAR; PG8_WAIT_L(0); PG8_MMA(1, 0, At, B0); PG8_BAR; PG8_SCHED;
            PG8_STAGE(PG8_SB(0, 1), b2 + hstep, voffB);
            PG8_WAIT_V(6); PG8_BAR; PG8_MMA(1, 1, At, B1); PG8_BAR;
            PG8_LDB(B0, 1, 0); PG8_SCHED; PG8_LDA(At, 1, 0); PG8_STAGE(PG8_SA(0, 1), a2 + hstep, voffA);
            PG8_WAIT_L(8); PG8_BAR; PG8_WAIT_L(0); PG8_MMA(0, 0, At, B0); PG8_BAR; PG8_SCHED;
            PG8_LDB(B1, 1, 1); PG8_STAGE(PG8_SB(1, 0), b3, voffB);
            PG8_BAR; PG8_WAIT_L(0); PG8_MMA(0, 1, At, B1); PG8_BAR;
            PG8_LDA(At, 1, 1); PG8_STAGE(PG8_SA(1, 0), a3, voffA);
            PG8_BAR; PG8_WAIT_L(0); PG8_MMA(1, 0, At, B0); PG8_BAR; PG8_SCHED;
            PG8_STAGE(PG8_SB(1, 1), b3 + hstep, voffB);
            PG8_WAIT_V(6); PG8_BAR; PG8_MMA(1, 1, At, B1); PG8_BAR;
            }
        }
        if constexpr (ALIGN_EPI) { if (wr == 0) PG8_BAR; }
        bool lastseg = true; if constexpr (Epi::NSEG > 1) lastseg = (cur.seg == Epi::NSEG - 1);
        if constexpr (!Epi::AFTER_DRAIN) { if (lastseg) { E(acc, cur, wr, wc, fr, fq); S.done(cur); } else { if constexpr (Epi::NSEG > 1) E.seg(acc, cur, wr, wc, fr, fq); } }
        if (!has_next) break;
#pragma unroll
        for (int a = 0; a < 2; ++a)
#pragma unroll
            for (int b = 0; b < 2; ++b)
#pragma unroll
                for (int m = 0; m < 4; ++m)
#pragma unroll
                    for (int n = 0; n < 2; ++n) acc[a][b][m][n] = (f32x4){0.f, 0.f, 0.f, 0.f};
        cur = nxt; cA = nA; cB = nB; ++ui; if constexpr (Epi::NSEG > 1) nt = Epi::seg_nt(cur.seg);
        if constexpr (ALIGN_EPI) { if (wr == 1) PG8_BAR; }
    }
    PG8_WAIT_V(0);
    if constexpr (!ALIGN_EPI) { if (wr == 0) PG8_BAR; }
    PG8_BAR;
    if constexpr (Epi::AFTER_DRAIN) { E.fused(acc, cur, wr, wc, fr, fq, lds, wid, lane); S.done(cur); }
#undef PG8_SA
#undef PG8_SB
#undef PG8_STAGE
#undef PG8_LDA
#undef PG8_LDB
#undef PG8_MMA
#undef PG8_WAIT_V
#undef PG8_WAIT_L
#undef PG8_BAR
#undef PG8_SCHED
}
}

#define DI __device__ __forceinline__
#define LAS __attribute__((address_space(3)))
using pg8::bf16_t; using pg8::bf16x8; using pg8::f32x4; using pg8::u32x4; using pg8::Unit; using pg8::f32x2; using pg8::gelu_pk;
typedef __bf16 bf16x2_t __attribute__((ext_vector_type(2)));
__device__ __forceinline__ unsigned cvt_pk_bf16(float lo, float hi) { f32x2 v = {lo, hi}; bf16x2_t b = __builtin_convertvector(v, bf16x2_t); return __builtin_bit_cast(unsigned, b); }
typedef LAS unsigned char* lptr;
typedef unsigned u32x2 __attribute__((ext_vector_type(2)));
#define MFMA16(a, b, c) __builtin_amdgcn_mfma_f32_16x16x32_bf16((a), (b), (c), 0, 0, 0)

constexpr int T = 16384, TB = 8192, DM = 1024, FF = 2816;
constexpr float EPS = 1e-6f;
constexpr int ZUQ_LD = 3328, XBC_LD = 3072, NWIN = 7680, GATE_LD = 3072, KBR = 3328, WIN_LD = 10528;
constexpr float QSCALE = 0.125f * 1.4426950408889634f;
constexpr int PT = 272;
constexpr int LDS_BYTES = 155648;

constexpr size_t KiB = 1024, MiB = 1u << 20;
constexpr size_t WS_SS1 = 0, WS_SS2 = 64 * KiB, WS_SS3 = 128 * KiB, WS_SS4 = 192 * KiB, WS_SSV = 256 * KiB, WS_SSG = 320 * KiB  , WS_CDEC = 576 * KiB  ;
constexpr size_t WS_KMEM = 640 * KiB, WS_VMEMT = 896 * KiB, WS_DT = 2 * MiB;
constexpr size_t WS_BAR = 4 * MiB, BAR_BYTES = 65536, WS_PCNT = WS_BAR + 32768;
constexpr int LDS_BARST = LDS_BYTES - 64;
constexpr size_t WS_W2GU = 6 * MiB, WS_W2D = 17 * MiB, WS_WIN = 22 * MiB + 512 * KiB, WS_WG = 37 * MiB + 512 * KiB, WS_WBR = 43 * MiB + 512 * KiB, WS_WOUT = 50 * MiB;
constexpr size_t WS_HB = 52 * MiB, WS_MG = 84 * MiB, WS_W1GU = 116 * MiB, WS_W1D = 127 * MiB, WS_ACT = 132 * MiB + 512 * KiB;
constexpr size_t WS_ZUQ = 116 * MiB, WS_XBC = 168 * MiB, WS_ST = 216 * MiB, WS_END = 256 * MiB;
static_assert(WS_ACT + (size_t)T * FF * 2 <= WS_END && WS_ST + (size_t)64 * 32 * 8192 * 2 <= WS_END && WS_ZUQ + (size_t)TB * ZUQ_LD * 2 <= WS_XBC && WS_XBC + (size_t)TB * XBC_LD * 2 <= WS_ST, "ws map");

DI float bflo(unsigned w) { return __uint_as_float(w << 16); }
DI float bfhi(unsigned w) { return __uint_as_float(w & 0xffff0000u); }
DI float sigm(float x) { return __builtin_amdgcn_rcpf(1.f + __expf(-x)); }
DI float silu(float x) { return x * sigm(x); }
DI u32x4 pack8(f32x4 a, f32x4 b) { u32x4 w; w.x = cvt_pk_bf16(a[0], a[1]); w.y = cvt_pk_bf16(a[2], a[3]); w.z = cvt_pk_bf16(b[0], b[1]); w.w = cvt_pk_bf16(b[2], b[3]); return w; }
DI u32x2 pack4(f32x4 a) { u32x2 w; w.x = cvt_pk_bf16(a[0], a[1]); w.y = cvt_pk_bf16(a[2], a[3]); return w; }
DI f32x4 gelu4(f32x4 v) { f32x2 a = gelu_pk((f32x2){v[0], v[1]}), b = gelu_pk((f32x2){v[2], v[3]}); return (f32x4){a.x, a.y, b.x, b.y}; }
DI float rstd_of(float ss, float inv_n) { return __builtin_amdgcn_rsqf(ss * inv_n + EPS); }
DI float softplus(float v) { return v > 20.f ? v : log1pf(__expf(v)); }

struct EpiGLU {
    static constexpr bool PERM = true, AFTER_DRAIN = false; static constexpr int NSEG = 1; static constexpr bool HALFB = false;
    const float* ss; bf16_t* O;
    DI void operator()(const f32x4 (&acc)[2][2][4][2], const Unit& u, int wr, int wc, int fr, int fq) const {
        const int col = u.pn * 128 + wc * 32 + 8 * fq;
#pragma unroll
        for (int ai = 0; ai < 2; ++ai)
#pragma unroll
            for (int m = 0; m < 4; ++m) {
                const int row = u.pm * 256 + ai * 128 + wr * 64 + m * 16 + fr;
                const float r = rstd_of(ss[row], 1.f / 1024.f);
                f32x4 o[2];
#pragma unroll
                for (int n = 0; n < 2; ++n)
#pragma unroll
                    for (int e = 0; e < 4; ++e) o[n][e] = silu(acc[ai][0][m][n][e] * r) * (acc[ai][1][m][n][e] * r);
                *(u32x4*)(O + (size_t)row * FF + col) = pack8(o[0], o[1]);
            }
    }
};
struct EpiRes {
    static constexpr bool PERM = true, AFTER_DRAIN = false; static constexpr int NSEG = 1; static constexpr bool HALFB = false;
    const float* resid; float* hout; bf16_t* hb; float* ssout; float alpha;
    DI void operator()(const f32x4 (&acc)[2][2][4][2], const Unit& u, int wr, int wc, int fr, int fq) const {
#pragma unroll
        for (int ai = 0; ai < 2; ++ai)
#pragma unroll
            for (int m = 0; m < 4; ++m) {
                const int row = u.pm * 256 + ai * 128 + wr * 64 + m * 16 + fr;
                float sq = 0.f;
#pragma unroll
                for (int bj = 0; bj < 2; ++bj) {
                    const size_t off = (size_t)row * DM + u.pn * 256 + bj * 128 + wc * 32 + 8 * fq;
                    f32x4 v0 = *(const f32x4*)(resid + off) + acc[ai][bj][m][0] * alpha, v1 = *(const f32x4*)(resid + off + 4) + acc[ai][bj][m][1] * alpha;
                    *(f32x4*)(hout + off) = v0; *(f32x4*)(hout + off + 4) = v1;
                    if (hb) *(u32x4*)(hb + off) = pack8(v0, v1);
                    sq += (v0[0] * v0[0] + v0[1] * v0[1]) + (v0[2] * v0[2] + v0[3] * v0[3]) + (v1[0] * v1[0] + v1[1] * v1[1]) + (v1[2] * v1[2] + v1[3] * v1[3]);
                }
                sq += __shfl_xor(sq, 16); sq += __shfl_xor(sq, 32);
                if (fq == 0) atomicAdd(ssout + row, sq);
            }
    }
};
struct EpiResNorm {
    static constexpr bool PERM = true, AFTER_DRAIN = false, HALFB = false; static constexpr int NSEG = 1;
    const float* resid; float* out; float* ss; unsigned* cnt; const float* gain; float alpha;
    DI void operator()(f32x4 (&acc)[2][2][4][2], const Unit& u, int wr, int wc, int fr, int fq) const {
#pragma unroll
        for (int ai = 0; ai < 2; ++ai)
#pragma unroll
            for (int m = 0; m < 4; ++m) {
                const int row = u.pm * 256 + ai * 128 + wr * 64 + m * 16 + fr;
                float sq = 0.f;
#pragma unroll
                for (int bj = 0; bj < 2; ++bj) {
                    const size_t off = (size_t)row * DM + u.pn * 256 + bj * 128 + wc * 32 + 8 * fq;
                    const f32x4 v0 = *(const f32x4*)(resid + off) + acc[ai][bj][m][0] * alpha, v1 = *(const f32x4*)(resid + off + 4) + acc[ai][bj][m][1] * alpha;
                    acc[ai][bj][m][0] = v0; acc[ai][bj][m][1] = v1;
                    sq += (v0[0] * v0[0] + v0[1] * v0[1]) + (v0[2] * v0[2] + v0[3] * v0[3]) + (v1[0] * v1[0] + v1[1] * v1[1]) + (v1[2] * v1[2] + v1[3] * v1[3]);
                }
                sq += __shfl_xor(sq, 16); sq += __shfl_xor(sq, 32);
                if (fq == 0) atomicAdd(ss + row, sq);
            }
        asm volatile("s_waitcnt vmcnt(0)" ::: "memory");
        __syncthreads();
        if (threadIdx.x == 0) {
            unsigned* c = cnt + 64 * u.pm;
            (void)__hip_atomic_fetch_add(c, 1u, __ATOMIC_RELAXED, __HIP_MEMORY_SCOPE_AGENT);
            unsigned sp = 0;
            while (__hip_atomic_load(c, __ATOMIC_RELAXED, __HIP_MEMORY_SCOPE_AGENT) < 4u) { __builtin_amdgcn_s_sleep(1); if (++sp > (1u << 20)) break; }
        }
        __syncthreads();
#pragma unroll
        for (int ai = 0; ai < 2; ++ai)
#pragma unroll
            for (int m = 0; m < 4; ++m) {
                const int row = u.pm * 256 + ai * 128 + wr * 64 + m * 16 + fr;
                const float r = rstd_of(__hip_atomic_load(ss + row, __ATOMIC_RELAXED, __HIP_MEMORY_SCOPE_AGENT), 1.f / 1024.f);
#pragma unroll
                for (int bj = 0; bj < 2; ++bj) {
                    const int col = u.pn * 256 + bj * 128 + wc * 32 + 8 * fq;
                    const f32x4 g0 = *(const f32x4*)(gain + col), g1 = *(const f32x4*)(gain + col + 4);
                    *(f32x4*)(out + (size_t)row * DM + col) = acc[ai][bj][m][0] * r * g0; *(f32x4*)(out + (size_t)row * DM + col + 4) = acc[ai][bj][m][1] * r * g1;
                }
            }
    }
};
struct EpiWin {
    static constexpr bool PERM = true, AFTER_DRAIN = false; static constexpr int NSEG = 1; static constexpr bool HALFB = false;
    int row_base; const float* ss; bf16_t* zuq; bf16_t* xbc; bf16_t* gv; float* dt; const float* dt_bias; float* ssv;
    template <int KIND> DI void body(const f32x4 (&acc)[2][2][4][2], const Unit& u, int wr, int wc, int fr, int fq) const {
        const int pn = u.pn, cw = wc * 32 + 8 * fq;
#pragma unroll
        for (int ai = 0; ai < 2; ++ai)
#pragma unroll
            for (int m = 0; m < 4; ++m) {
                const int lr = u.pm * 256 + ai * 128 + wr * 64 + m * 16 + fr, gr = row_base + lr;
                const float r = rstd_of(ss[gr], 1.f / 1024.f);
                if (KIND == 0) {
#pragma unroll
                    for (int bj = 0; bj < 2; ++bj) { f32x4 a, b;
#pragma unroll
                        for (int e = 0; e < 4; ++e) { a[e] = silu(acc[ai][bj][m][0][e] * r); b[e] = silu(acc[ai][bj][m][1][e] * r); }
                        *(u32x4*)(zuq + (size_t)lr * ZUQ_LD + pn * 256 + bj * 128 + cw) = pack8(a, b); }
                } else if (KIND == 1) {
#pragma unroll
                    for (int bj = 0; bj < 2; ++bj) { f32x4 a = gelu4(acc[ai][bj][m][0] * r), b = gelu4(acc[ai][bj][m][1] * r);
                        *(u32x4*)(zuq + (size_t)lr * ZUQ_LD + pn * 256 + bj * 128 + cw) = pack8(a, b); }
                } else if (KIND == 2) {
#pragma unroll
                    for (int bj = 0; bj < 2; ++bj) { f32x4 a = acc[ai][bj][m][0] * (r * QSCALE), b = acc[ai][bj][m][1] * (r * QSCALE);
                        *(u32x4*)(zuq + (size_t)lr * ZUQ_LD + pn * 256 + bj * 128 + cw) = pack8(a, b); }
                } else if (KIND == 3) {
#pragma unroll
                    for (int bj = 0; bj < 2; ++bj) { f32x4 a = acc[ai][bj][m][0] * r, b = acc[ai][bj][m][1] * r;
                        *(u32x4*)(xbc + (size_t)lr * XBC_LD + (pn - 13) * 256 + bj * 128 + cw) = pack8(a, b); }
                } else if (KIND == 4) {
                    float sq = 0.f;
#pragma unroll
                    for (int bj = 0; bj < 2; ++bj) { f32x4 a = gelu4(acc[ai][bj][m][0] * r), b = gelu4(acc[ai][bj][m][1] * r);
                        sq += (a[0] * a[0] + a[1] * a[1]) + (a[2] * a[2] + a[3] * a[3]) + (b[0] * b[0] + b[1] * b[1]) + (b[2] * b[2] + b[3] * b[3]);
                        *(u32x4*)(gv + (size_t)lr * DM + (pn - 25) * 256 + bj * 128 + cw) = pack8(a, b); }
                    sq += __shfl_xor(sq, 16); sq += __shfl_xor(sq, 32);
                    if (fq == 0) atomicAdd(ssv + gr, sq);
                } else {
                    if (wc == 0) {
#pragma unroll
                        for (int n = 0; n < 2; ++n) { f32x4 o;
#pragma unroll
                            for (int e = 0; e < 4; ++e) o[e] = softplus(acc[ai][0][m][n][e] * r + dt_bias[8 * fq + 4 * n + e]);
                            *(f32x4*)(dt + (size_t)gr * 32 + 8 * fq + 4 * n) = o; }
                    }
                }
            }
    }
    DI void operator()(const f32x4 (&acc)[2][2][4][2], const Unit& u, int wr, int wc, int fr, int fq) const {
        const int pn = u.pn;
        if (pn < 8) body<0>(acc, u, wr, wc, fr, fq); else if (pn < 12) body<1>(acc, u, wr, wc, fr, fq); else if (pn == 12) body<2>(acc, u, wr, wc, fr, fq);
        else if (pn < 25) body<3>(acc, u, wr, wc, fr, fq); else if (pn < 29) body<4>(acc, u, wr, wc, fr, fq); else body<5>(acc, u, wr, wc, fr, fq);
    }
};
struct EpiGates {
    static constexpr bool PERM = true, AFTER_DRAIN = false; static constexpr int NSEG = 1; static constexpr bool HALFB = false;
    int row_base; const float* ss; bf16_t* O;
    DI void operator()(const f32x4 (&acc)[2][2][4][2], const Unit& u, int wr, int wc, int fr, int fq) const {
#pragma unroll
        for (int ai = 0; ai < 2; ++ai)
#pragma unroll
            for (int m = 0; m < 4; ++m) {
                const int lr = u.pm * 256 + ai * 128 + wr * 64 + m * 16 + fr;
                const float r = rstd_of(ss[row_base + lr], 1.f / 1024.f);
#pragma unroll
                for (int bj = 0; bj < 2; ++bj) { f32x4 a, b;
#pragma unroll
                    for (int e = 0; e < 4; ++e) { a[e] = sigm(acc[ai][bj][m][0][e] * r); b[e] = sigm(acc[ai][bj][m][1][e] * r); }
                    *(u32x4*)(O + (size_t)lr * GATE_LD + u.pn * 256 + bj * 128 + wc * 32 + 8 * fq) = pack8(a, b); }
            }
    }
};
struct EpiMerge {
    static constexpr bool PERM = true, AFTER_DRAIN = false, HALFB = true; static constexpr int NSEG = 3;
    const bf16_t* gates; float* run; bf16_t* O;
    static DI int seg_koff(int s) { return s == 0 ? 0 : (s == 1 ? 2048 : 3072); }
    static DI int seg_nt(int s) { return s == 0 ? 32 : (s == 1 ? 16 : 4); }
    DI void seg(const f32x4 (&acc)[2][2][4][2], const Unit& u, int wr, int wc, int fr, int fq) const {
        const int row0 = u.pm * 256 + wr * 64 + fr, cw = u.pn * 128 + wc * 32 + 8 * fq, s = u.seg;
#pragma unroll
        for (int ai = 0; ai < 2; ++ai)
#pragma unroll
            for (int m = 0; m < 4; ++m) {
                const int row = row0 + ai * 128 + m * 16;
                const u32x4 G = *(const u32x4*)(gates + (size_t)row * GATE_LD + s * 1024 + cw);
                float* rp = run + (size_t)row * DM + cw;
                f32x4 a = (f32x4){0.f, 0.f, 0.f, 0.f}, b = a;
                if (s > 0) { a = *(const f32x4*)rp; b = *(const f32x4*)(rp + 4); }
                a[0] += acc[ai][0][m][0][0] * bflo(G[0]); a[1] += acc[ai][0][m][0][1] * bfhi(G[0]); a[2] += acc[ai][0][m][0][2] * bflo(G[1]); a[3] += acc[ai][0][m][0][3] * bfhi(G[1]);
                b[0] += acc[ai][0][m][1][0] * bflo(G[2]); b[1] += acc[ai][0][m][1][1] * bfhi(G[2]); b[2] += acc[ai][0][m][1][2] * bflo(G[3]); b[3] += acc[ai][0][m][1][3] * bfhi(G[3]);
                *(f32x4*)rp = a; *(f32x4*)(rp + 4) = b;
            }
    }
    DI void operator()(const f32x4 (&acc)[2][2][4][2], const Unit& u, int wr, int wc, int fr, int fq) const {
        const int row0 = u.pm * 256 + wr * 64 + fr, cw = u.pn * 128 + wc * 32 + 8 * fq;
#pragma unroll
        for (int ai = 0; ai < 2; ++ai)
#pragma unroll
            for (int m = 0; m < 4; ++m) {
                const int row = row0 + ai * 128 + m * 16;
                const u32x4 G = *(const u32x4*)(gates + (size_t)row * GATE_LD + 2048 + cw);
                const float* rp = run + (size_t)row * DM + cw;
                f32x4 a = *(const f32x4*)rp, b = *(const f32x4*)(rp + 4);
                a[0] += acc[ai][0][m][0][0] * bflo(G[0]); a[1] += acc[ai][0][m][0][1] * bfhi(G[0]); a[2] += acc[ai][0][m][0][2] * bflo(G[1]); a[3] += acc[ai][0][m][0][3] * bfhi(G[1]);
                b[0] += acc[ai][0][m][1][0] * bflo(G[2]); b[1] += acc[ai][0][m][1][1] * bfhi(G[2]); b[2] += acc[ai][0][m][1][2] * bflo(G[3]); b[3] += acc[ai][0][m][1][3] * bfhi(G[3]);
                *(u32x4*)(O + (size_t)row * DM + cw) = pack8(a, b);
            }
    }
};

struct Frame {
    lptr lds; unsigned char* ws; const float* const* in; float* out;
    int tid, lane, wave, G, bid;
};
struct Args { const float* in[28]; float* out; unsigned char* ws; int ph_lo, ph_hi; };
enum { I_X = 0, I_MEM, I_F1N, I_F1G, I_F1U, I_F1D, I_MIXN, I_MEMN, I_WIN, I_CONVW, I_CONVB, I_DTB, I_ALOG, I_SSDD, I_SSDN, I_GVN, I_GWS, I_GBS, I_WKV, I_WBS, I_WBG, I_WBM, I_WOUT, I_F2N, I_F2G, I_F2U, I_F2D, I_FINN };

#define LDS_WAIT() asm volatile("s_waitcnt lgkmcnt(0)" ::: "memory")

#define XB_TMO      128
#define XB_XCNT(j)  (256  + 64 * (j))
#define XB_XSUB(j)  (1280 + 64 * (j))
#define XB_XGEN(j)  (2304 + 64 * (j))
#define XB_TOP      3328
#define XB_TOPGEN   3392
#define XCD_BAR_WORDS 3456
#define XB_SPIN_CAP (1u << 18)

__device__ __forceinline__ unsigned xb_ld(unsigned* p)              { return __hip_atomic_load(p, __ATOMIC_RELAXED, __HIP_MEMORY_SCOPE_AGENT); }
__device__ __forceinline__ unsigned xb_add(unsigned* p, unsigned v) { return __hip_atomic_fetch_add(p, v, __ATOMIC_RELAXED, __HIP_MEMORY_SCOPE_AGENT); }
__device__ __forceinline__ unsigned xb_xcc_id() { return (unsigned)__builtin_amdgcn_s_getreg((3 << 11) | 20) & 0xFu; }
#define XB_SPIN(cond, bar) do { unsigned _sp = 0; while (cond) { __builtin_amdgcn_s_sleep(1); \
    if ((++_sp & 255u) == 0u) { if (xb_ld(&(bar)[XB_TMO])) break; if (_sp > XB_SPIN_CAP) { atomicAdd(&(bar)[XB_TMO], 1u); break; } } } } while (0)

struct XcdBarrier {
    unsigned* bar; unsigned x;
    volatile LAS unsigned* st;
};

__device__ __forceinline__ XcdBarrier xcd_barrier_post(unsigned* bar, volatile LAS unsigned* st) {
    XcdBarrier b; b.bar = bar; b.x = xb_xcc_id(); b.st = st;
    if (threadIdx.x == 0) (void)xb_add(&bar[XB_XCNT(b.x)], 1u);
    return b;
}
__device__ __forceinline__ void xcd_barrier_complete(unsigned* bar, unsigned x, unsigned& nloc, unsigned& nx) {
    const unsigned G = gridDim.x * gridDim.y * gridDim.z;
    unsigned sum, cnt, mine, sp = 0u;
    for (;;) {
        sum = 0u; cnt = 0u; mine = 0u;
#pragma unroll
        for (unsigned j = 0; j < 16; ++j) { const unsigned c = xb_ld(&bar[XB_XCNT(j)]); sum += c; cnt += (c > 0u) ? 1u : 0u; mine = (j == x) ? c : mine; }
        if (sum == G) break;
        __builtin_amdgcn_s_sleep(1);
        if ((++sp & 255u) == 0u) { if (xb_ld(&bar[XB_TMO])) break; if (sp > XB_SPIN_CAP) { atomicAdd(&bar[XB_TMO], 1u); break; } }
    }
    nloc = mine > 0u ? mine : 1u; nx = cnt > 0u ? cnt : 1u;
}

__device__ __forceinline__ void xcd_barrier(const XcdBarrier& b) {
    asm volatile("s_waitcnt vmcnt(0)" ::: "memory");
    __syncthreads();
    if (threadIdx.x == 0) {
        unsigned* bar = b.bar;
        __builtin_amdgcn_s_waitcnt(0);
        unsigned nloc = b.st[0], nx = b.st[1];
        if (nloc == 0u) { xcd_barrier_complete(bar, b.x, nloc, nx); b.st[0] = nloc; b.st[1] = nx; }
        const unsigned old = xb_add(&bar[XB_XSUB(b.x)], 1u);
        const unsigned gen = old / nloc;
        if (old + 1u == (gen + 1u) * nloc) {
            __builtin_amdgcn_fence(__ATOMIC_RELEASE, "agent");
            asm volatile("s_waitcnt vmcnt(0)" ::: "memory");
            const unsigned og = xb_add(&bar[XB_TOP], 1u);
            const unsigned tg = og / nx;
            if (og + 1u == (tg + 1u) * nx) xb_add(&bar[XB_TOPGEN], 1u);
            else XB_SPIN(xb_ld(&bar[XB_TOPGEN]) == tg, bar);
            __builtin_amdgcn_fence(__ATOMIC_ACQUIRE, "agent");
            xb_add(&bar[XB_XGEN(b.x)], 1u);
            asm volatile("s_waitcnt vmcnt(0)" ::: "memory");
        } else {
            XB_SPIN(xb_ld(&bar[XB_XGEN(b.x)]) == gen, bar);
            __builtin_amdgcn_fence(__ATOMIC_ACQUIRE, "agent");
            asm volatile("s_waitcnt vmcnt(0)" ::: "memory");
        }
    }
    __syncthreads();
}


DI void tr_item(const float* W, int ldw, int col0, bf16_t* WT, int ldt, int dcol0, int drow0, const float* gain, LAS float* scr, int kb, int lane) {
    const int k0 = 64 * kb;
    float tv[32];
    const float* wp = W + (size_t)(k0 + (lane >> 5)) * ldw + col0 + (lane & 31);
#pragma unroll
    for (int i = 0; i < 32; ++i) tv[i] = wp[(size_t)(2 * i) * ldw];
    if (gain) {
#pragma unroll
        for (int i = 0; i < 32; ++i) tv[i] *= gain[k0 + 2 * i + (lane >> 5)];
    }
#pragma unroll
    for (int i = 0; i < 32; ++i) scr[(2 * i + (lane >> 5)) * 33 + (lane & 31)] = tv[i];
    LDS_WAIT();
    const int c = lane & 7;
#pragma unroll
    for (int j = 0; j < 4; ++j) { const int n = (lane >> 3) + 8 * j; const LAS float* s = scr + (8 * c) * 33 + n;
        u32x4 o; o.x = cvt_pk_bf16(s[0 * 33], s[1 * 33]); o.y = cvt_pk_bf16(s[2 * 33], s[3 * 33]); o.z = cvt_pk_bf16(s[4 * 33], s[5 * 33]); o.w = cvt_pk_bf16(s[6 * 33], s[7 * 33]);
        *(u32x4*)(WT + (size_t)(drow0 + n) * ldt + dcol0 + k0 + 8 * c) = o; }
    LDS_WAIT();
}
DI void kv_item(const Frame& F, int item) {
    const int rt = item >> 3, ct = item & 7, r0 = rt * 64, c0 = ct * 64, tid = F.tid, lane = F.lane, w = F.wave, fr = lane & 15, fq = lane >> 4;
    lptr As = F.lds, Bs = F.lds + 64 * PT; LAS float* rs = (LAS float*)(F.lds + 128 * PT);
    const float* mem = F.in[I_MEM]; const float* W = F.in[I_WKV]; const float* gain = F.in[I_MEMN];
    bf16_t* Kmem = (bf16_t*)(F.ws + WS_KMEM); bf16_t* VmemT = (bf16_t*)(F.ws + WS_VMEMT);
    const int ar = tid >> 3, ka = (tid & 7) * 16;
    const int kb = tid >> 2, nb = (tid & 3) * 16;
    const float* pa = mem + (size_t)(r0 + ar) * 1024 + ka; const float* pb = W + (size_t)kb * 512 + c0 + nb;
    float sq = 0.f;
    f32x4 acc[2]; acc[0] = (f32x4){0.f, 0.f, 0.f, 0.f}; acc[1] = acc[0];
    const bool ktype = ct < 4;
    f32x4 va[4], vb[4]; float gk;
#pragma unroll
    for (int i = 0; i < 4; ++i) { va[i] = *(const f32x4*)(pa + 4 * i); vb[i] = *(const f32x4*)(pb + 4 * i); }
    gk = gain[kb];
    for (int kc = 0; kc < 8; ++kc) {
#pragma unroll
        for (int i = 0; i < 4; ++i) sq += (va[i][0] * va[i][0] + va[i][1] * va[i][1]) + (va[i][2] * va[i][2] + va[i][3] * va[i][3]);
        *(LAS u32x4*)(As + ar * PT + ka * 2) = pack8(va[0], va[1]); *(LAS u32x4*)(As + ar * PT + ka * 2 + 16) = pack8(va[2], va[3]);
#pragma unroll
        for (int i = 0; i < 4; ++i) { const u32x2 pk = pack4(vb[i] * gk);
            *(LAS unsigned short*)(Bs + (nb + 4 * i + 0) * PT + kb * 2) = (unsigned short)(pk[0] & 0xffffu); *(LAS unsigned short*)(Bs + (nb + 4 * i + 1) * PT + kb * 2) = (unsigned short)(pk[0] >> 16);
            *(LAS unsigned short*)(Bs + (nb + 4 * i + 2) * PT + kb * 2) = (unsigned short)(pk[1] & 0xffffu); *(LAS unsigned short*)(Bs + (nb + 4 * i + 3) * PT + kb * 2) = (unsigned short)(pk[1] >> 16); }
        if (kc < 7) {
#pragma unroll
            for (int i = 0; i < 4; ++i) { va[i] = *(const f32x4*)(pa + (kc + 1) * 128 + 4 * i); vb[i] = *(const f32x4*)(pb + (size_t)(kc + 1) * 128 * 512 + 4 * i); }
            gk = gain[(kc + 1) * 128 + kb];
        }
        __syncthreads();
#pragma unroll
        for (int ks = 0; ks < 4; ++ks) {
            if (ktype) { const bf16x8 yf = *(const LAS bf16x8*)(As + (16 * (w >> 1) + fr) * PT + ks * 64 + fq * 16);
#pragma unroll
                for (int i = 0; i < 2; ++i) { const bf16x8 xf = *(const LAS bf16x8*)(Bs + (16 * ((w & 1) * 2 + i) + fr) * PT + ks * 64 + fq * 16); acc[i] = MFMA16(xf, yf, acc[i]); } }
            else { const bf16x8 yf = *(const LAS bf16x8*)(Bs + (16 * (w >> 1) + fr) * PT + ks * 64 + fq * 16);
#pragma unroll
                for (int i = 0; i < 2; ++i) { const bf16x8 xf = *(const LAS bf16x8*)(As + (16 * ((w & 1) * 2 + i) + fr) * PT + ks * 64 + fq * 16); acc[i] = MFMA16(xf, yf, acc[i]); } }
        }
        __syncthreads();
    }
    sq += __shfl_xor(sq, 1); sq += __shfl_xor(sq, 2); sq += __shfl_xor(sq, 4);
    if ((tid & 7) == 0) rs[ar] = rstd_of(sq, 1.f / 1024.f);
    __syncthreads();
    if (ktype) { const int tok = 16 * (w >> 1) + fr; const float r = rs[tok];
#pragma unroll
        for (int i = 0; i < 2; ++i) { const int ch = c0 + 16 * ((w & 1) * 2 + i) + 4 * fq; *(u32x2*)(Kmem + (size_t)(r0 + tok) * 256 + ch) = pack4(acc[i] * r); } }
    else { const int ch = c0 - 256 + 16 * (w >> 1) + fr;
#pragma unroll
        for (int i = 0; i < 2; ++i) { const int tok = 16 * ((w & 1) * 2 + i) + 4 * fq; f32x4 o;
#pragma unroll
            for (int e = 0; e < 4; ++e) o[e] = acc[i][e] * rs[tok + e];
            const int row = r0 + tok; *(u32x2*)(VmemT + (size_t)((row >> 8) * 256 + ch) * 256 + (row & 255)) = pack4(o); } }
    __syncthreads();
}
DI float wave_sum(float v) {
#pragma unroll
    for (int o = 1; o < 64; o <<= 1) v += __shfl_xor(v, o);
    return v;
}
#define SEG(Wp, ldw, c0, nc, Kk, WTp, ldt, dc0, gn, MAP) { const int nblk = (nc) / 32, cnt = ((Kk) / 64) * nblk; if (r < cnt) { const int kb = r / nblk, n0 = (r % nblk) * 32; \
        tr_item(Wp, ldw, (c0) + n0, WTp, ldt, dc0, (MAP), gn, scr, kb, lane); continue; } r -= cnt; }
DI void prologue(const Frame& F) {
    unsigned char* ws = F.ws;
    { u32x4* z = (u32x4*)(ws + WS_SS2); const int n = (int)((WS_CDEC - WS_SS2) / 16); for (int i = F.bid * 512 + F.tid; i < n; i += F.G * 512) z[i] = (u32x4){0u, 0u, 0u, 0u}; }
    LAS float* scr = (LAS float*)(F.lds + F.wave * 16384);
    const int gw = F.bid * 8 + F.wave, NGW = F.G * 8, lane = F.lane;
    bf16_t* W1GU = (bf16_t*)(ws + WS_W1GU);
    bf16_t* W1D = (bf16_t*)(ws + WS_W1D); bf16_t* WIN = (bf16_t*)(ws + WS_WIN);
    constexpr int NITEMS = 3 * 1408 + 16 * ((2048 + 1024 + 256 + 3072) / 32);
    for (int it = gw; it < NITEMS; it += NGW) {
        int r = it;
        SEG(F.in[I_F1G], FF, 0, FF, 1024, W1GU, 1024, 0, F.in[I_F1N], (n0 / 128) * 256 + (n0 % 128))
        SEG(F.in[I_F1U], FF, 0, FF, 1024, W1GU, 1024, 0, F.in[I_F1N], (n0 / 128) * 256 + 128 + (n0 % 128))
        SEG(F.in[I_F1D], 1024, 0, 1024, FF, W1D, FF, 0, (const float*)nullptr, n0)
        SEG(F.in[I_WIN], WIN_LD, 0, 2048, 1024, WIN, 1024, 0, F.in[I_MIXN], n0)
        SEG(F.in[I_WIN], WIN_LD, 5152, 1024, 1024, WIN, 1024, 0, F.in[I_MIXN], 2048 + n0)
        SEG(F.in[I_WIN], WIN_LD, 7200, 256, 1024, WIN, 1024, 0, F.in[I_MIXN], 3072 + n0)
        SEG(F.in[I_WIN], WIN_LD, 2048, 3072, 1024, WIN, 1024, 0, F.in[I_MIXN], 3328 + n0)
    }
    const float* x = F.in[I_X]; bf16_t* hb = (bf16_t*)(ws + WS_HB); float* ss1 = (float*)(ws + WS_SS1);
    for (int m = 2 * gw; m < T; m += 2 * NGW) {
        const f32x4* xr = (const f32x4*)(x + (size_t)m * DM) + lane; float s0 = 0.f, s1 = 0.f; f32x4 v[8];
#pragma unroll
        for (int j = 0; j < 8; ++j) v[j] = xr[64 * j];
#pragma unroll
        for (int j = 0; j < 4; ++j) { s0 += (v[j][0] * v[j][0] + v[j][1] * v[j][1]) + (v[j][2] * v[j][2] + v[j][3] * v[j][3]); s1 += (v[4 + j][0] * v[4 + j][0] + v[4 + j][1] * v[4 + j][1]) + (v[4 + j][2] * v[4 + j][2] + v[4 + j][3] * v[4 + j][3]); }
        s0 = wave_sum(s0); s1 = wave_sum(s1); if (lane == 0) { ss1[m] = s0; ss1[m + 1] = s1; }
        u32x2* o = (u32x2*)(hb + (size_t)m * DM) + lane;
#pragma unroll
        for (int j = 0; j < 8; ++j) o[64 * j] = pack4(v[j]);
    }
}
DI void mid_convert(const Frame& F, int first_blk) {
    unsigned char* ws = F.ws;
    if (F.bid - first_blk < 64) kv_item(F, F.bid - first_blk);
    LAS float* scr = (LAS float*)(F.lds + F.wave * 16384); const int lane = F.lane;
    const int gw = (F.bid - first_blk) * 8 + F.wave, NGW = (F.G - first_blk) * 8;
    bf16_t* W1D = (bf16_t*)(ws + WS_W1D); bf16_t* WIN = (bf16_t*)(ws + WS_WIN); bf16_t* WG = (bf16_t*)(ws + WS_WG); bf16_t* WBR = (bf16_t*)(ws + WS_WBR);
    constexpr int NITEMS = 16 * ((1024 + 32) / 32) + 16 * 96 + (32 + 16 + 4) * 32;
    for (int it = gw; it < NITEMS; it += NGW) {
        int r = it;
        SEG(F.in[I_WIN], WIN_LD, 6176, 1024, 1024, WIN, 1024, 0, F.in[I_MIXN], 6400 + n0)
        SEG(F.in[I_WIN], WIN_LD, 5120, 32, 1024, WIN, 1024, 0, F.in[I_MIXN], 7424 + n0)
        SEG(F.in[I_WIN], WIN_LD, 7456, 3072, 1024, WG, 1024, 0, F.in[I_MIXN], n0)
        SEG(F.in[I_WBS], 1024, 0, 1024, 2048, WBR, KBR, 0, F.in[I_SSDN], n0)
        SEG(F.in[I_WBG], 1024, 0, 1024, 1024, WBR, KBR, 2048, (const float*)nullptr, n0)
        SEG(F.in[I_WBM], 1024, 0, 1024, 256, WBR, KBR, 3072, (const float*)nullptr, n0)
    }
}
DI void late_convert(const Frame& F, int first_blk) {
    unsigned char* ws = F.ws; LAS float* scr = (LAS float*)(F.lds + F.wave * 16384); const int lane = F.lane;
    const int gw = (F.bid - first_blk) * 8 + F.wave, NGW = (F.G - first_blk) * 8;
    bf16_t* W2GU = (bf16_t*)(ws + WS_W2GU); bf16_t* W2D = (bf16_t*)(ws + WS_W2D); bf16_t* WOUT = (bf16_t*)(ws + WS_WOUT);
    constexpr int NITEMS = (3 * 1408) + 512;
    for (int it = gw; it < NITEMS; it += NGW) {
        int r = it;
        SEG(F.in[I_F2G], FF, 0, FF, 1024, W2GU, 1024, 0, F.in[I_F2N], (n0 / 128) * 256 + (n0 % 128))
        SEG(F.in[I_F2U], FF, 0, FF, 1024, W2GU, 1024, 0, F.in[I_F2N], (n0 / 128) * 256 + 128 + (n0 % 128))
        SEG(F.in[I_F2D], 1024, 0, 1024, FF, W2D, FF, 0, (const float*)nullptr, n0)
        SEG(F.in[I_WOUT], 1024, 0, 1024, 1024, WOUT, 1024, 0, (const float*)nullptr, n0)
    }
}
DI void final_norm(const Frame& F) {
    const float* ss4 = (const float*)(F.ws + WS_SS4); const float* g = F.in[I_FINN];
    const int gw = F.bid * 8 + F.wave, NGW = F.G * 8, lane = F.lane;
    f32x4 gv[4];
#pragma unroll
    for (int j = 0; j < 4; ++j) gv[j] = ((const f32x4*)g)[lane + 64 * j];
    for (int m = gw; m < T; m += NGW) {
        f32x4* xr = (f32x4*)(F.out + (size_t)m * DM) + lane; const float r = rstd_of(ss4[m], 1.f / 1024.f);
#pragma unroll
        for (int j = 0; j < 4; ++j) xr[64 * j] = xr[64 * j] * r * gv[j];
    }
}

DI void ssd_scan_prep(const Frame& F, const float* dt, int gr0, int h0, LAS float* acs, LAS float* dts, LAS float* wtot) {
    const int hl = F.tid >> 7, l = F.tid & 127, h = h0 + hl;
    const float a = -__expf(F.in[I_ALOG][h]);
    const float d = dt[(size_t)(gr0 + l) * 32 + h];
    float v = d * a;
#pragma unroll
    for (int o = 1; o < 64; o <<= 1) { const float t = __shfl_up(v, o); if (F.lane >= o) v += t; }
    if (F.lane == 63) wtot[F.wave] = v;
    __syncthreads();
    if (F.wave & 1) v += wtot[F.wave - 1];
    acs[hl * 128 + l] = v; dts[hl * 128 + l] = d;
    __syncthreads();
}
template <bool SCALED, int NCH> DI void stage_conv_T(lptr dst, const bf16_t* xbc, int t0, int chan0, const float* cw, const float* cb, const LAS float* scale, int tid) {
    constexpr int ncp = NCH >> 1, ntask = ncp * 16;
#pragma unroll 2
    for (int it_ = 0; it_ < ntask / 512; ++it_) { const int task = tid + 512 * it_;
        const int cp = task % ncp, tb = task / ncp, ch = chan0 + 2 * cp, l0 = tb * 8;
        float w[4][2];
#pragma unroll
        for (int k = 0; k < 4; ++k) { w[k][0] = cw[k * XBC_LD + ch]; w[k][1] = cw[k * XBC_LD + ch + 1]; }
        const float b0 = cb[ch], b1 = cb[ch + 1];
        float r0[11], r1[11];
#pragma unroll
        for (int i = 0; i < 11; ++i) { const int l = l0 - 3 + i; unsigned v = 0u; if (t0 + l >= 0) v = *(const unsigned*)(xbc + (long)(t0 + l) * XBC_LD + ch); r0[i] = bflo(v); r1[i] = bfhi(v); }
        f32x4 o0[2], o1[2];
#pragma unroll
        for (int j = 0; j < 8; ++j) {
            float y0 = b0 + w[0][0] * r0[j] + w[1][0] * r0[j + 1] + w[2][0] * r0[j + 2] + w[3][0] * r0[j + 3];
            float y1 = b1 + w[0][1] * r1[j] + w[1][1] * r1[j + 1] + w[2][1] * r1[j + 2] + w[3][1] * r1[j + 3];
            y0 = silu(y0); y1 = silu(y1);
            if (SCALED) { const float s = scale[((2 * cp) >> 6) * 128 + l0 + j]; y0 *= s; y1 *= s; }
            o0[j >> 2][j & 3] = y0; o1[j >> 2][j & 3] = y1;
        }
        *(LAS u32x4*)(dst + (2 * cp) * PT + l0 * 2) = pack8(o0[0], o0[1]);
        *(LAS u32x4*)(dst + (2 * cp + 1) * PT + l0 * 2) = pack8(o1[0], o1[1]);
    }
}
DI void stage_conv_N(lptr dst, const bf16_t* xbc, int t0, int chan0, const float* cw, const float* cb, int tid) {
    const int cg8 = (tid & 15) * 8, ch = chan0 + cg8;
    float w[4][8], b[8];
#pragma unroll
    for (int k = 0; k < 4; ++k) { const f32x4 a = *(const f32x4*)(cw + k * XBC_LD + ch), c = *(const f32x4*)(cw + k * XBC_LD + ch + 4);
#pragma unroll
        for (int e = 0; e < 4; ++e) { w[k][e] = a[e]; w[k][4 + e] = c[e]; } }
    { const f32x4 a = *(const f32x4*)(cb + ch), c = *(const f32x4*)(cb + ch + 4);
#pragma unroll
        for (int e = 0; e < 4; ++e) { b[e] = a[e]; b[4 + e] = c[e]; } }
#pragma unroll
    for (int i = 0; i < 4; ++i) {
        const int l = (tid >> 4) + 32 * i;
        float y[8];
#pragma unroll
        for (int e = 0; e < 8; ++e) y[e] = b[e];
#pragma unroll
        for (int k = 0; k < 4; ++k) { const int t = t0 + l - 3 + k; u32x4 v = (u32x4){0u, 0u, 0u, 0u}; if (t >= 0) v = *(const u32x4*)(xbc + (long)t * XBC_LD + ch);
#pragma unroll
            for (int q = 0; q < 4; ++q) { y[2 * q] += w[k][2 * q] * bflo(v[q]); y[2 * q + 1] += w[k][2 * q + 1] * bfhi(v[q]); } }
        f32x4 o0, o1;
#pragma unroll
        for (int e = 0; e < 4; ++e) { o0[e] = silu(y[e]); o1[e] = silu(y[4 + e]); }
        *(LAS u32x4*)(dst + l * PT + cg8 * 2) = pack8(o0, o1);
    }
}
struct Half { int b; bf16_t* zuq; bf16_t* xbc; bf16_t* gv; bf16_t* st; float* cdec; const float* dt; int row_base; };

DI void ssd_a_item(const Frame& F, const Half& H, int item) {
    const int c = item >> 3, g = (item >> 1) & 3, hh = item & 1, h0 = g * 8 + hh * 4, t0 = c * 128;
    lptr XT = F.lds, BT = F.lds + 69632; LAS float* acs = (LAS float*)(F.lds + 139264); LAS float* dts = acs + 512; LAS float* sc = dts + 512; LAS float* wtot = sc + 512;
    ssd_scan_prep(F, H.dt, H.row_base + t0, h0, acs, dts, wtot);
    { const int hl = F.tid >> 7, l = F.tid & 127; const float last = acs[hl * 128 + 127]; sc[hl * 128 + l] = dts[hl * 128 + l] * __expf(last - acs[hl * 128 + l]);
      if (l == 127) H.cdec[c * 32 + h0 + hl] = __expf(last); }
    __syncthreads();
    stage_conv_T<true, 256>(XT, H.xbc, t0, g * 512 + hh * 256, F.in[I_CONVW], F.in[I_CONVB], sc, F.tid);
    stage_conv_T<false, 128>(BT, H.xbc, t0, 2048 + g * 128, F.in[I_CONVW], F.in[I_CONVB], nullptr, F.tid);
    __syncthreads();
    const int w = F.wave, hl = w >> 1, nh = w & 1, fr = F.lane & 15, fq = F.lane >> 4;
    f32x4 acc[4][4];
#pragma unroll
    for (int i = 0; i < 4; ++i)
#pragma unroll
        for (int j = 0; j < 4; ++j) acc[i][j] = (f32x4){0.f, 0.f, 0.f, 0.f};
#pragma unroll
    for (int ks = 0; ks < 4; ++ks) {
        bf16x8 xf[4], yf[4];
#pragma unroll
        for (int i = 0; i < 4; ++i) { xf[i] = *(const LAS bf16x8*)(BT + (nh * 64 + 16 * i + fr) * PT + ks * 64 + fq * 16); yf[i] = *(const LAS bf16x8*)(XT + (hl * 64 + 16 * i + fr) * PT + ks * 64 + fq * 16); }
#pragma unroll
        for (int i = 0; i < 4; ++i)
#pragma unroll
            for (int j = 0; j < 4; ++j) acc[i][j] = MFMA16(xf[i], yf[j], acc[i][j]);
    }
    bf16_t* dst = H.st + (size_t)(c * 32 + h0 + hl) * 8192;
#pragma unroll
    for (int i = 0; i < 4; ++i)
#pragma unroll
        for (int j = 0; j < 4; ++j) *(u32x2*)(dst + (16 * j + fr) * 128 + nh * 64 + 16 * i + 4 * fq) = pack4(acc[i][j]);
    __syncthreads();
}
DI void ssd_scan(const Frame& F, const Half& H) {
    for (int e = F.bid * 512 + F.tid; e < 131072; e += F.G * 512) {
        const int h = e >> 12; unsigned* p = (unsigned*)H.st + e; float r0 = 0.f, r1 = 0.f;
#pragma unroll 8
        for (int c = 0; c < 64; ++c) { const unsigned wv = p[(size_t)c * 131072]; const float dec = H.cdec[c * 32 + h]; p[(size_t)c * 131072] = cvt_pk_bf16(r0, r1); r0 = r0 * dec + bflo(wv); r1 = r1 * dec + bfhi(wv); }
    }
}
DI void ssd_c_item(const Frame& F, const Half& H, int item) {
    const int c = item >> 2, g = item & 3, t0 = c * 128;
    lptr XT = F.lds, Cn = F.lds + 69632, Bn = F.lds + 104448; LAS float* acs = (LAS float*)(F.lds + 139264); LAS float* dts = acs + 512; LAS float* wtot = dts + 512; LAS float* tss = wtot + 16;
    stage_conv_N(Bn, H.xbc, t0, 2048 + g * 128, F.in[I_CONVW], F.in[I_CONVB], F.tid);
    stage_conv_N(Cn, H.xbc, t0, 2560 + g * 128, F.in[I_CONVW], F.in[I_CONVB], F.tid);
    __syncthreads();
    const int w = F.wave, fr = F.lane & 15, fq = F.lane >> 4;
    {
        const int lt0 = (w >> 1) * 2, st0 = (w & 1) * 4;
        f32x4 cb[4][2];
#pragma unroll
        for (int i = 0; i < 4; ++i) { cb[i][0] = (f32x4){0.f, 0.f, 0.f, 0.f}; cb[i][1] = cb[i][0]; }
#pragma unroll
        for (int ks = 0; ks < 4; ++ks) {
            bf16x8 xf[4], yf[2];
#pragma unroll
            for (int i = 0; i < 4; ++i) xf[i] = *(const LAS bf16x8*)(Bn + (16 * (st0 + i) + fr) * PT + ks * 64 + fq * 16);
#pragma unroll
            for (int j = 0; j < 2; ++j) yf[j] = *(const LAS bf16x8*)(Cn + (16 * (lt0 + j) + fr) * PT + ks * 64 + fq * 16);
#pragma unroll
            for (int i = 0; i < 4; ++i)
#pragma unroll
                for (int j = 0; j < 2; ++j) cb[i][j] = MFMA16(xf[i], yf[j], cb[i][j]);
        }
        __syncthreads();
#pragma unroll
        for (int i = 0; i < 4; ++i)
#pragma unroll
            for (int j = 0; j < 2; ++j) *(LAS u32x2*)(Bn + (16 * (lt0 + j) + fr) * PT + (16 * (st0 + i) + 4 * fq) * 2) = pack4(cb[i][j]);
    }
    const int hl = w >> 1, lh = w & 1;
#pragma unroll 1
    for (int hh = 0; hh < 2; ++hh) {
        const int h0 = g * 8 + hh * 4, h = h0 + hl;
        __syncthreads();
        ssd_scan_prep(F, H.dt, H.row_base + t0, h0, acs, dts, wtot);
        stage_conv_T<false, 256>(XT, H.xbc, t0, g * 512 + hh * 256, F.in[I_CONVW], F.in[I_CONVB], nullptr, F.tid);
        __syncthreads();
        f32x4 accd[4][4];
#pragma unroll
        for (int i = 0; i < 4; ++i)
#pragma unroll
            for (int j = 0; j < 4; ++j) accd[i][j] = (f32x4){0.f, 0.f, 0.f, 0.f};
        const LAS float* ah = acs + hl * 128; const LAS float* dh = dts + hl * 128;
        const bf16_t* Sp = H.st + (size_t)(c * 32 + h) * 8192;
#pragma unroll
        for (int ks = 0; ks < 4; ++ks) {
            bf16x8 xf[4], yf[4];
#pragma unroll
            for (int i = 0; i < 4; ++i) { xf[i] = *(const bf16x8*)(Sp + (16 * i + fr) * 128 + ks * 32 + fq * 8); yf[i] = *(const LAS bf16x8*)(Cn + (lh * 64 + 16 * i + fr) * PT + ks * 64 + fq * 16); }
#pragma unroll
            for (int i = 0; i < 4; ++i)
#pragma unroll
                for (int j = 0; j < 4; ++j) accd[i][j] = MFMA16(xf[i], yf[j], accd[i][j]);
        }
#pragma unroll
        for (int j = 0; j < 4; ++j) { const float el = __expf(ah[lh * 64 + 16 * j + fr]);
#pragma unroll
            for (int i = 0; i < 4; ++i) accd[i][j] = accd[i][j] * el; }
        const int nks = lh ? 4 : 2;
        for (int ks = 0; ks < nks; ++ks) {
            bf16x8 xf[4], yf[4];
            const int s0 = ks * 32 + fq * 8;
            const f32x4 as0 = *(const LAS f32x4*)(ah + s0), as1 = *(const LAS f32x4*)(ah + s0 + 4), ds0 = *(const LAS f32x4*)(dh + s0), ds1 = *(const LAS f32x4*)(dh + s0 + 4);
#pragma unroll
            for (int j = 0; j < 4; ++j) {
                const int l = lh * 64 + 16 * j + fr; const float al = ah[l];
                const u32x4 cbv = *(const LAS u32x4*)(Bn + l * PT + s0 * 2);
                f32x4 o0, o1;
#pragma unroll
                for (int q = 0; q < 4; ++q) {
                    const int sa = s0 + 2 * q, sb = sa + 1;
                    const float asa = (q < 2) ? as0[2 * q] : as1[2 * q - 4], asb = (q < 2) ? as0[2 * q + 1] : as1[2 * q - 3];
                    const float dsa = (q < 2) ? ds0[2 * q] : ds1[2 * q - 4], dsb = (q < 2) ? ds0[2 * q + 1] : ds1[2 * q - 3];
                    const float va = (sa <= l) ? bflo(cbv[q]) * __expf(al - asa) * dsa : 0.f;
                    const float vb = (sb <= l) ? bfhi(cbv[q]) * __expf(al - asb) * dsb : 0.f;
                    if (q < 2) { o0[2 * q] = va; o0[2 * q + 1] = vb; } else { o1[2 * q - 4] = va; o1[2 * q - 3] = vb; }
                }
                yf[j] = __builtin_bit_cast(bf16x8, pack8(o0, o1));
            }
#pragma unroll
            for (int i = 0; i < 4; ++i) xf[i] = *(const LAS bf16x8*)(XT + (hl * 64 + 16 * i + fr) * PT + ks * 64 + fq * 16);
#pragma unroll
            for (int i = 0; i < 4; ++i)
#pragma unroll
                for (int j = 0; j < 4; ++j) accd[i][j] = MFMA16(xf[i], yf[j], accd[i][j]);
        }
        const float Dh = F.in[I_SSDD][h];
#pragma unroll
        for (int j = 0; j < 4; ++j) {
            const int l = lh * 64 + 16 * j + fr; float sq = 0.f;
            bf16_t* zr = H.zuq + (size_t)(t0 + l) * ZUQ_LD + h * 64;
#pragma unroll
            for (int i = 0; i < 4; ++i) {
                const int p = 16 * i + 4 * fq;
                const u32x2 zv = *(const u32x2*)(zr + p);
                f32x4 y;
#pragma unroll
                for (int e = 0; e < 4; ++e) { const float xv = __uint_as_float(((unsigned)*(const LAS unsigned short*)(XT + (hl * 64 + p + e) * PT + l * 2)) << 16); y[e] = accd[i][j][e] + Dh * xv; }
                y[0] *= bflo(zv[0]); y[1] *= bfhi(zv[0]); y[2] *= bflo(zv[1]); y[3] *= bfhi(zv[1]);
                sq += (y[0] * y[0] + y[1] * y[1]) + (y[2] * y[2] + y[3] * y[3]);
                *(u32x2*)(zr + p) = pack4(y);
            }
            sq += __shfl_xor(sq, 16); sq += __shfl_xor(sq, 32);
            if (fq == 0) tss[(hh * 4 + hl) * 128 + l] = sq;
        }
    }
    __syncthreads();
    {
        const int l = F.tid >> 2, qd = F.tid & 3; float tsum = 0.f;
#pragma unroll
        for (int k = 0; k < 8; ++k) tsum += tss[k * 128 + l];
        const float r = rstd_of(tsum, 1.f / 512.f);
        u32x4* p = (u32x4*)(H.zuq + (size_t)(t0 + l) * ZUQ_LD + g * 512 + qd * 128);
#pragma unroll
        for (int i = 0; i < 16; ++i) { const u32x4 v = p[i]; f32x4 a, b; a[0] = bflo(v[0]) * r; a[1] = bfhi(v[0]) * r; a[2] = bflo(v[1]) * r; a[3] = bfhi(v[1]) * r; b[0] = bflo(v[2]) * r; b[1] = bfhi(v[2]) * r; b[2] = bflo(v[3]) * r; b[3] = bfhi(v[3]) * r; p[i] = pack8(a, b); }
    }
    __syncthreads();
}


DI void gmlp_item(const Frame& F, const Half& H, int item) {
    const int c = item >> 3, g = item & 7, t0 = c * 128, d0 = g * 128, tid = F.tid;
    lptr VT = F.lds, WS = F.lds + 34816; LAS float* rv = (LAS float*)(F.lds + 69632);
    const float* ssv = (const float*)(F.ws + WS_SSV);
    if (tid < 128) rv[tid] = rstd_of(ssv[H.row_base + t0 + tid], 1.f / 1024.f);
    __syncthreads();
#pragma unroll
    for (int i = 0; i < 4; ++i) {
        const int v = tid + 512 * i, s = v >> 4, seg = v & 15;
        const u32x4 pk = *(const u32x4*)(H.gv + (size_t)(t0 + s) * DM + d0 + seg * 8);
#pragma unroll
        for (int e = 0; e < 8; ++e) { const unsigned short hv = (unsigned short)((e & 1) ? (pk[e >> 1] >> 16) : (pk[e >> 1] & 0xffffu)); *(LAS unsigned short*)(VT + (seg * 8 + e) * PT + s * 2) = hv; }
        const int t = s, s0 = seg * 8;
        const float* wp = F.in[I_GWS] + (size_t)(g * 128 + t) * 128 + s0; const f32x4 w0 = *(const f32x4*)wp, w1 = *(const f32x4*)(wp + 4);
        f32x4 o0, o1;
#pragma unroll
        for (int e = 0; e < 4; ++e) { o0[e] = (s0 + e <= t) ? w0[e] * rv[s0 + e] : 0.f; o1[e] = (s0 + 4 + e <= t) ? w1[e] * rv[s0 + 4 + e] : 0.f; }
        *(LAS u32x4*)(WS + t * PT + s0 * 2) = pack8(o0, o1);
    }
    __syncthreads();
    const int w = F.wave, fr = F.lane & 15, fq = F.lane >> 4, mtb = (w & 3) * 2, ntb = (w >> 2) * 4;
    f32x4 acc[2][4];
#pragma unroll
    for (int i = 0; i < 2; ++i)
#pragma unroll
        for (int j = 0; j < 4; ++j) acc[i][j] = (f32x4){0.f, 0.f, 0.f, 0.f};
    const int nks = ntb ? 4 : 2;
    for (int ks = 0; ks < nks; ++ks) {
        bf16x8 xf[2], yf[4];
#pragma unroll
        for (int i = 0; i < 2; ++i) xf[i] = *(const LAS bf16x8*)(VT + (16 * (mtb + i) + fr) * PT + ks * 64 + fq * 16);
#pragma unroll
        for (int j = 0; j < 4; ++j) yf[j] = *(const LAS bf16x8*)(WS + (16 * (ntb + j) + fr) * PT + ks * 64 + fq * 16);
#pragma unroll
        for (int i = 0; i < 2; ++i)
#pragma unroll
            for (int j = 0; j < 4; ++j) acc[i][j] = MFMA16(xf[i], yf[j], acc[i][j]);
    }
#pragma unroll
    for (int j = 0; j < 4; ++j) {
        const int t = 16 * (ntb + j) + fr; const float bias = F.in[I_GBS][g * 128 + t];
#pragma unroll
        for (int i = 0; i < 2; ++i) {
            const int d = d0 + 16 * (mtb + i) + 4 * fq;
            const f32x4 gn = *(const f32x4*)(F.in[I_GVN] + d);
            bf16_t* up = H.zuq + (size_t)(t0 + t) * ZUQ_LD + 2048 + d;
            const u32x2 uv = *(const u32x2*)up;
            f32x4 y;
            y[0] = bflo(uv[0]) * (gn[0] * acc[i][j][0] + bias); y[1] = bfhi(uv[0]) * (gn[1] * acc[i][j][1] + bias);
            y[2] = bflo(uv[1]) * (gn[2] * acc[i][j][2] + bias); y[3] = bfhi(uv[1]) * (gn[3] * acc[i][j][3] + bias);
            *(u32x2*)up = pack4(y);
        }
    }
    __syncthreads();
}
DI void memattn_item(const Frame& F, const Half& H, int item) {
    const int h = item & 3, t0 = (item >> 2) * 128, tid = F.tid, w = F.wave, fr = F.lane & 15, fq = F.lane >> 4;
    lptr Ks = F.lds, VT = F.lds + 36864, Pw = F.lds + 70656 + w * 8448;
    const bf16_t* Kmem = (const bf16_t*)(F.ws + WS_KMEM) + (size_t)H.b * 256 * 256; const bf16_t* VmemT = (const bf16_t*)(F.ws + WS_VMEMT) + (size_t)H.b * 256 * 256;
#pragma unroll
    for (int i = 0; i < 4; ++i) {
        const int v = tid + 512 * i;
        { const int m = v >> 3, seg = v & 7; *(LAS u32x4*)(Ks + m * 144 + seg * 16) = *(const u32x4*)(Kmem + (size_t)m * 256 + h * 64 + seg * 8); }
        { const int d = v >> 5, seg = v & 31; *(LAS u32x4*)(VT + d * 528 + seg * 16) = *(const u32x4*)(VmemT + (size_t)(h * 64 + d) * 256 + seg * 8); }
    }
    __syncthreads();
    for (int sub = 0; sub < 1; ++sub) {
        const int tw = t0 + sub * 128 + w * 16;
        bf16_t* qrow = H.zuq + (size_t)(tw + fr) * ZUQ_LD + 3072 + h * 64;
        bf16x8 qf[2];
        qf[0] = *(const bf16x8*)(qrow + fq * 8); qf[1] = *(const bf16x8*)(qrow + 32 + fq * 8);
        f32x4 s[16];
#pragma unroll
        for (int i = 0; i < 16; ++i) { s[i] = (f32x4){0.f, 0.f, 0.f, 0.f};
#pragma unroll
            for (int ks = 0; ks < 2; ++ks) { const bf16x8 kf = *(const LAS bf16x8*)(Ks + (16 * i + fr) * 144 + ks * 64 + fq * 16); s[i] = MFMA16(kf, qf[ks], s[i]); } }
        float mx = -3.0e38f;
#pragma unroll
        for (int i = 0; i < 16; ++i) mx = fmaxf(mx, fmaxf(fmaxf(s[i][0], s[i][1]), fmaxf(s[i][2], s[i][3])));
        mx = fmaxf(mx, __shfl_xor(mx, 16)); mx = fmaxf(mx, __shfl_xor(mx, 32));
        float sum = 0.f;
#pragma unroll
        for (int i = 0; i < 16; ++i) { f32x4 p;
#pragma unroll
            for (int e = 0; e < 4; ++e) { p[e] = __builtin_amdgcn_exp2f(s[i][e] - mx); sum += p[e]; }
            *(LAS u32x2*)(Pw + fr * 528 + (16 * i + 4 * fq) * 2) = pack4(p); }
        sum += __shfl_xor(sum, 16); sum += __shfl_xor(sum, 32);
        LDS_WAIT(); __builtin_amdgcn_wave_barrier();
        f32x4 o[4];
#pragma unroll
        for (int i = 0; i < 4; ++i) o[i] = (f32x4){0.f, 0.f, 0.f, 0.f};
#pragma unroll
        for (int ks = 0; ks < 8; ++ks) { const bf16x8 pf = *(const LAS bf16x8*)(Pw + fr * 528 + ks * 64 + fq * 16);
#pragma unroll
            for (int i = 0; i < 4; ++i) { const bf16x8 vf = *(const LAS bf16x8*)(VT + (16 * i + fr) * 528 + ks * 64 + fq * 16); o[i] = MFMA16(vf, pf, o[i]); } }
        const float inv = __builtin_amdgcn_rcpf(sum);
#pragma unroll
        for (int i = 0; i < 4; ++i) *(u32x2*)(qrow + 16 * i + 4 * fq) = pack4(o[i] * inv);
        LDS_WAIT(); __builtin_amdgcn_wave_barrier();
    }
    __syncthreads();
}

#define PH_GEMM(EpiT, Aptr, Bptr, Mm, Nn, Kk, Eobj) do { pg8::Gemm g_{(const bf16_t*)(Aptr), (const bf16_t*)(Bptr), Mm, Nn, Kk}; pg8::StaticOrder S_; S_.init(Mm, Nn, F.G, F.bid); \
        pg8::gemm_phase<EpiT, pg8::StaticOrder, true, true>(F.lds, g_, S_, Eobj); } while (0)

__global__ void __launch_bounds__(512) mega_fwd(Args args) {
    extern __shared__ __attribute__((aligned(16))) unsigned char lds_raw[];
    cg::grid_group grid = cg::this_grid();
    Frame F; F.lds = (lptr)lds_raw; F.ws = args.ws; F.in = args.in; F.out = args.out;
    F.tid = threadIdx.x; F.lane = F.tid & 63; F.wave = __builtin_amdgcn_readfirstlane(F.tid >> 6); F.G = gridDim.x; F.bid = blockIdx.x;
    unsigned char* ws = args.ws;
    const int lo = args.ph_lo, hi = args.ph_hi;
    { volatile LAS unsigned* st_ = (volatile LAS unsigned*)(F.lds + LDS_BARST); if (F.tid < 2) st_[F.tid] = 0u; }
    __syncthreads();
    XcdBarrier xbar; xbar.bar = (unsigned*)(ws + WS_BAR); xbar.x = 0; xbar.st = nullptr;
    if (hi - lo > 1) grid.sync();
    if (hi - lo > 1) xbar = xcd_barrier_post((unsigned*)(ws + WS_BAR), (volatile LAS unsigned*)(F.lds + LDS_BARST));
#define HB ((bf16_t*)(ws + WS_HB))
#define ACT ((bf16_t*)(ws + WS_ACT))
#define MG ((bf16_t*)(ws + WS_MG))
#define SS1 ((float*)(ws + WS_SS1))
#define SS2 ((float*)(ws + WS_SS2))
#define SS3 ((float*)(ws + WS_SS3))
#define SS4 ((float*)(ws + WS_SS4))
#ifndef PHMASK
#define PHMASK 0xFFFFFFFFu
#endif
#define RELAUNDER() do { int t_ = threadIdx.x; asm volatile("" : "+v"(t_)); F.tid = t_; F.lane = t_ & 63; F.wave = __builtin_amdgcn_readfirstlane(t_ >> 6); \
        unsigned long long w_ = (unsigned long long)args.ws; asm volatile("" : "+s"(w_)); ws = (unsigned char*)w_; F.ws = ws; } while (0)
#define IN(k) (((PHMASK >> ((k) > 8 ? (k) - 6 : (k))) & 1u) && lo <= (k) && (k) < hi)
#define SEAM(k) do { if ((k) + 1 < hi) { xcd_barrier(xbar); } } while (0)

    if (IN(0)) { RELAUNDER(); prologue(F); SEAM(0); }
    if (IN(1)) { RELAUNDER(); EpiGLU E{SS1, ACT}; PH_GEMM(EpiGLU, HB, ws + WS_W1GU, T, 2 * FF, DM, E);
        if (F.G >= 256) { if (F.bid >= 128) mid_convert(F, 128); } else mid_convert(F, 0);
        SEAM(1); }
    if (IN(2)) { RELAUNDER(); EpiRes E{F.in[I_X], F.out, HB, SS2, 0.5f}; PH_GEMM(EpiRes, ACT, ws + WS_W1D, T, DM, FF, E); SEAM(2); }
#pragma unroll 1
    for (int b = 0; b < 2; ++b) {
        const int k0 = 3 + 6 * b;
#define MKHALF() Half H; H.b = b; H.zuq = (bf16_t*)(ws + WS_ZUQ); H.xbc = (bf16_t*)(ws + WS_XBC); H.gv = MG + (size_t)TB * DM; H.st = (bf16_t*)(ws + WS_ST); H.cdec = (float*)(ws + WS_CDEC) + b * 2048; H.dt = (const float*)(ws + WS_DT); H.row_base = b * TB;
        if (IN(k0)) { RELAUNDER(); MKHALF(); if (b == 1) { if (F.G >= 256) { if (F.bid >= 192) late_convert(F, 192); } else late_convert(F, 0); __syncthreads(); }
            EpiWin E{H.row_base, SS2, H.zuq, H.xbc, H.gv, (float*)(ws + WS_DT), F.in[I_DTB], (float*)(ws + WS_SSV)};
            PH_GEMM(EpiWin, HB + (size_t)H.row_base * DM, ws + WS_WIN, TB, NWIN, DM, E); SEAM(k0); }
        if (IN(k0 + 1)) { RELAUNDER(); MKHALF();
            for (int it = F.bid; it < 512 + 512; it += F.G) {
                if (it < 512) ssd_a_item(F, H, it); else gmlp_item(F, H, it - 512);
            }
            if (F.G < 256) for (int it = F.bid; it < 256; it += F.G) memattn_item(F, H, it);
            SEAM(k0 + 1); }
        if (IN(k0 + 2)) { RELAUNDER(); MKHALF(); ssd_scan(F, H); SEAM(k0 + 2); }
        if (IN(k0 + 3)) { RELAUNDER(); MKHALF(); for (int it = F.bid; it < 256; it += F.G) ssd_c_item(F, H, it); SEAM(k0 + 3); }
        if (IN(k0 + 4)) { RELAUNDER(); MKHALF(); if (F.G >= 256 && F.bid >= 128) { for (int it = F.bid - 128; it < 256; it += F.G - 128) memattn_item(F, H, it); }
            EpiGates E{H.row_base, SS2, H.xbc}; PH_GEMM(EpiGates, HB + (size_t)H.row_base * DM, ws + WS_WG, TB, GATE_LD, DM, E); SEAM(k0 + 4); }
        if (IN(k0 + 5)) { RELAUNDER(); MKHALF(); EpiMerge E{H.xbc, (float*)(ws + WS_ST), MG + (size_t)b * TB * DM};
            { pg8::Gemm g_{(const bf16_t*)H.zuq, (const bf16_t*)(ws + WS_WBR), TB, DM, KBR}; pg8::SegOrder<3> S_; S_.init(TB, 2 * DM, F.G, F.bid);     pg8::gemm_phase<EpiMerge, pg8::SegOrder<3>, true, true>(F.lds, g_, S_, E); } SEAM(k0 + 5); }
    }
    if (IN(15)) { RELAUNDER(); EpiRes E{F.out, F.out, HB, SS3, 1.0f}; PH_GEMM(EpiRes, MG, ws + WS_WOUT, T, DM, DM, E); SEAM(15); }
    if (IN(16)) { RELAUNDER(); EpiGLU E{SS3, ACT}; PH_GEMM(EpiGLU, HB, ws + WS_W2GU, T, 2 * FF, DM, E); SEAM(16); }
    if (IN(17)) { RELAUNDER(); EpiResNorm E{F.out, F.out, SS4, (unsigned*)(ws + WS_PCNT), F.in[I_FINN], 0.5f}; PH_GEMM(EpiResNorm, ACT, ws + WS_W2D, T, DM, FF, E); }
}

#ifndef N_PHASES
#define N_PHASES 18
#endif
#ifndef ONE_LAUNCH
#define ONE_LAUNCH 1
#endif
extern "C" void kernel_launch(void* const* d_in, const int* in_sizes, int n_in, void* d_out, int out_size, void* d_ws, size_t ws_size, hipStream_t stream) {
    static int grid = 0;
    if (grid == 0) {
        int dev = 0, cus = 0, per_cu = 0;
        hipGetDevice(&dev); hipDeviceGetAttribute(&cus, hipDeviceAttributeMultiprocessorCount, dev);
        if (hipFuncSetAttribute((const void*)mega_fwd, hipFuncAttributeMaxDynamicSharedMemorySize, LDS_BYTES) != hipSuccess) { fprintf(stderr, "kernel_launch: hipFuncSetAttribute failed\n"); grid = -1; return; }
        if (hipOccupancyMaxActiveBlocksPerMultiprocessor(&per_cu, (const void*)mega_fwd, 512, LDS_BYTES) != hipSuccess || per_cu < 1) { fprintf(stderr, "kernel_launch: occupancy query says %d\n", per_cu); per_cu = 1; }
        (void)hipGetLastError();
        grid = cus;
        if (n_in != 28 || ws_size < WS_END) { fprintf(stderr, "kernel_launch: unexpected n_in %d / ws %zu\n", n_in, ws_size); grid = -1; return; }
    }
    if (grid < 0) return;
    if (hipMemsetAsync((char*)d_ws + WS_BAR, 0, BAR_BYTES, stream) != hipSuccess) { fprintf(stderr, "kernel_launch: memset failed\n"); return; }
    Args a{};
    for (int i = 0; i < 28; ++i) a.in[i] = (const float*)d_in[i];
    a.out = (float*)d_out; a.ws = (unsigned char*)d_ws;
#if ONE_LAUNCH
    a.ph_lo = 0; a.ph_hi = N_PHASES;
    void* kargs[] = {&a};
    hipError_t e = hipLaunchCooperativeKernel((const void*)mega_fwd, dim3(grid), dim3(512), kargs, LDS_BYTES, stream);
    if (e != hipSuccess) fprintf(stderr, "cooperative launch failed: %s (grid %d)\n", hipGetErrorString(e), grid);
#else
    for (int k = 0; k < N_PHASES; ++k) { a.ph_lo = k; a.ph_hi = k + 1; hipLaunchKernelGGL(mega_fwd, dim3(grid), dim3(512), LDS_BYTES, stream, a); }
#endif
}
```

```cpp
#include <hip/hip_runtime.h>
#include <hip/hip_cooperative_groups.h>
#include <cstdio>
#include <cstdint>
namespace cg = cooperative_groups;
namespace pg8 {
#define PG8_LAS __attribute__((address_space(3)))
typedef unsigned short bf16_t;
typedef short bf16x8 __attribute__((ext_vector_type(8)));
typedef float f32x4 __attribute__((ext_vector_type(4)));
typedef unsigned u32x4 __attribute__((ext_vector_type(4)));
constexpr int BM = 256, BK = 64, HALF = 128, HTB = HALF * BK * 2  , STAGE_BYTES = 8 * HTB, NXCD = 8, WGM = 8;

__host__ __device__ __forceinline__ int lds_byte(int r, int c) { const int st = (r >> 4) * 2 + (c >> 5), rr = r & 15, cc = c & 31, ob = rr * 64 + cc * 2; return st * 1024 + (ob ^ (((ob >> 9) & 1) << 5)); }
__host__ __device__ __forceinline__ void stage_rc(int b, int& R, int& C) { const int st = b / 1024, sb = b % 1024, swz = sb ^ (((sb >> 9) & 1) << 5); R = (st >> 1) * 16 + swz / 64; C = (st & 1) * 32 + (swz % 64) / 2; }
__host__ __device__ __forceinline__ int perm32(int rho) { const int n = rho >> 4, i = rho & 15; return 8 * (i >> 2) + 4 * n + (i & 3); }

struct Unit { int pm, pn, seg; };
struct Gemm { const bf16_t* A; const bf16_t* Bt; int M, N, K; };

struct StaticOrder {
    int nM, nN, nwg, G, c, wgm;
    __host__ __device__ void init(int M, int N, int G_, int c_, int wgm_ = WGM) { nM = M / BM; nN = N / BM; nwg = nM * nN; G = G_; c = c_; wgm = wgm_; }
    __host__ __device__ bool next(int i, Unit& u) const {
        const long L = (long)i * G + c; if (L >= nwg) return false;
        int wgid = (int)L; { const int q = nwg / NXCD, r = nwg % NXCD, xcd = wgid % NXCD, off = wgid / NXCD; wgid = (xcd < r ? xcd * (q + 1) : r * (q + 1) + (xcd - r) * q) + off; }
        const int nig = wgm * nN, gid = wgid / nig, fm = gid * wgm, gsz = (nM - fm) < wgm ? (nM - fm) : wgm;
        u.pm = fm + ((wgid % nig) % gsz); u.pn = (wgid % nig) / gsz; u.seg = 0; return true;
    }
    __device__ __forceinline__ void a_ready(const Unit&) const {}
    __device__ __forceinline__ void done(const Unit&) const {}
};

template <int NSEG> struct SegOrder {
    StaticOrder base;
    __host__ __device__ void init(int M, int N, int G_, int c_) { base.init(M, N, G_, c_); }
    __host__ __device__ bool next(int i, Unit& u) const { if (!base.next(i / NSEG, u)) return false; u.seg = i % NSEG; return true; }
    __device__ __forceinline__ void a_ready(const Unit&) const {}
    __device__ __forceinline__ void done(const Unit&) const {}
};
__device__ __forceinline__ unsigned cvt_pk_bf16(float lo, float hi) { unsigned r; asm volatile("v_cvt_pk_bf16_f32 %0, %1, %2" : "=v"(r) : "v"(lo), "v"(hi)); return r; }
typedef float f32x2 __attribute__((ext_vector_type(2)));
__device__ __forceinline__ f32x2 gelu_pk(f32x2 v) {
    const f32x2 av = __builtin_elementwise_abs(v), d = av * 0.2316418882f + 1.0f;
    f32x2 t; t.x = __builtin_amdgcn_rcpf(d.x); t.y = __builtin_amdgcn_rcpf(d.y);
    f32x2 q = t * 0.5307027145f + (-0.7265760135f); q = q * t + 0.7107068705f; q = q * t + (-0.142248368f); q = q * t + 0.127414796f; q = q * t;
    const f32x2 s = (v * v) * (-0.72134752044f);
    f32x2 e; e.x = __builtin_amdgcn_exp2f(s.x); e.y = __builtin_amdgcn_exp2f(s.y);
    const f32x2 m = v * (q * e), r = v - m;
    f32x2 o; o.x = v.x < 0.f ? m.x : r.x; o.y = v.y < 0.f ? m.y : r.y; return o;
}
template <class Epi, class Sched, bool ALIGN_EPI = false, bool SP2 = false>
__device__ __forceinline__ void gemm_phase(PG8_LAS unsigned char* lds, const Gemm g, const Sched& S, const Epi& E) {
    int tid_ = threadIdx.x; asm volatile("" : "+v"(tid_)); const int tid = tid_, wid = __builtin_amdgcn_readfirstlane(tid >> 6), lane = tid & 63, wr = wid >> 2, wc = wid & 3, fr = lane & 15, fq = lane >> 4;
    const int K = g.K; int nt = K / BK;
    unsigned voffA[2], voffB[2];
#pragma unroll
    for (int i = 0; i < 2; ++i) { int R, C; stage_rc(tid * 16 + i * 8192, R, C); const int Rb = Epi::PERM ? ((R & ~31) + perm32(R & 31)) : R;
        voffA[i] = (unsigned)(R * K + C) * 2u; voffB[i] = (unsigned)(Rb * K + C) * 2u; }
    const size_t kstep = (size_t)(BK * 2);
    const size_t hstep = (size_t)HALF * K * 2;
    const size_t tstep = 2 * hstep;
    const unsigned ldsw = (unsigned)wid * 1024u;
    const int aoff = lds_byte(wr * 64 + fr, fq * 8), boff = lds_byte(wc * 32 + fr, fq * 8);
#define PG8_SA(b, h) (((b) * 2 + (h)) * HTB)
#define PG8_SB(b, h) ((4 + (b) * 2 + (h)) * HTB)
#define PG8_STAGE(bufoff, gbase, voff) do { _Pragma("unroll") for (int _i = 0; _i < 2; ++_i) \
        __builtin_amdgcn_global_load_lds((const unsigned*)((const char*)(gbase) + (voff)[_i]), (PG8_LAS unsigned*)(lds + (bufoff) + ldsw + _i * 8192), 16, 0, 0); } while (0)
#define PG8_LDA(dst, b, h) do { _Pragma("unroll") for (int m = 0; m < 4; ++m) _Pragma("unroll") for (int k = 0; k < 2; ++k) dst[m][k] = *(const PG8_LAS bf16x8*)(lds + PG8_SA(b, h) + aoff + m * 2048 + k * 1024); } while (0)
#define PG8_LDB(dst, b, h) do { _Pragma("unroll") for (int n = 0; n < 2; ++n) _Pragma("unroll") for (int k = 0; k < 2; ++k) dst[n][k] = *(const PG8_LAS bf16x8*)(lds + PG8_SB(b, h) + boff + n * 2048 + k * 1024); } while (0)
#define PG8_MMA(ai, bj, At, Bt) do { __builtin_amdgcn_s_setprio(1); _Pragma("unroll") for (int m = 0; m < 4; ++m) _Pragma("unroll") for (int n = 0; n < 2; ++n) _Pragma("unroll") for (int k = 0; k < 2; ++k) \
        acc[ai][bj][m][n] = __builtin_amdgcn_mfma_f32_16x16x32_bf16(Bt[n][k], At[m][k], acc[ai][bj][m][n], 0, 0, 0); __builtin_amdgcn_s_setprio(0); } while (0)
#define PG8_WAIT_V(n) asm volatile("s_waitcnt vmcnt(" #n ")" ::: "memory")
#define PG8_WAIT_L(n) asm volatile("s_waitcnt lgkmcnt(" #n ")" ::: "memory")
#define PG8_BAR __builtin_amdgcn_s_barrier()
#define PG8_SCHED __builtin_amdgcn_sched_barrier(0)
    Unit cur, nxt; int ui = 0;
    if (!S.next(0, cur)) return;
    f32x4 acc[2][2][4][2];
#pragma unroll
    for (int a = 0; a < 2; ++a)
#pragma unroll
        for (int b = 0; b < 2; ++b)
#pragma unroll
            for (int m = 0; m < 4; ++m)
#pragma unroll
                for (int n = 0; n < 2; ++n) acc[a][b][m][n] = (f32x4){0.f, 0.f, 0.f, 0.f};
    bf16x8 At[4][2], B0[2][2], B1[2][2];
    const char* cA = (const char*)g.A + (size_t)cur.pm * tstep; const char* cB = (const char*)g.Bt + (size_t)cur.pn * (Epi::HALFB ? hstep : tstep);
    if constexpr (Epi::NSEG > 1) { cA += (size_t)Epi::seg_koff(cur.seg) * 2; cB += (size_t)Epi::seg_koff(cur.seg) * 2; nt = Epi::seg_nt(cur.seg); }
    S.a_ready(cur);
    if constexpr (SP2) {
        PG8_STAGE(PG8_SB(0, 0), cB, voffB); PG8_STAGE(PG8_SB(0, 1), cB + hstep, voffB); PG8_STAGE(PG8_SA(0, 0), cA, voffA); PG8_STAGE(PG8_SA(0, 1), cA + hstep, voffA);
        if (wr == 1) PG8_BAR;
        PG8_WAIT_V(2); PG8_BAR;
        PG8_STAGE(PG8_SB(1, 0), cB + kstep, voffB); PG8_STAGE(PG8_SA(1, 0), cA + kstep, voffA); PG8_STAGE(PG8_SB(1, 1), cB + hstep + kstep, voffB);
        PG8_WAIT_V(6); PG8_BAR;
    } else {
        PG8_STAGE(PG8_SB(0, 0), cB, voffB); PG8_STAGE(PG8_SA(0, 0), cA, voffA); PG8_STAGE(PG8_SB(0, 1), cB + hstep, voffB); PG8_STAGE(PG8_SA(0, 1), cA + hstep, voffA);
        if (wr == 1) PG8_BAR;
        PG8_WAIT_V(4); PG8_BAR;
        PG8_STAGE(PG8_SB(1, 0), cB + kstep, voffB); PG8_STAGE(PG8_SA(1, 0), cA + kstep, voffA); PG8_STAGE(PG8_SB(1, 1), cB + hstep + kstep, voffB);
        PG8_WAIT_V(6); PG8_BAR;
    }
    for (;;) {
        const bool has_next = S.next(ui + 1, nxt);
        const char* nA = has_next ? (const char*)g.A + (size_t)nxt.pm * tstep : cA; const char* nB = has_next ? (const char*)g.Bt + (size_t)nxt.pn * (Epi::HALFB ? hstep : tstep) : cB;
        if constexpr (Epi::NSEG > 1) { if (has_next) { nA += (size_t)Epi::seg_koff(nxt.seg) * 2; nB += (size_t)Epi::seg_koff(nxt.seg) * 2; } }
        for (int t = 0; t < nt; t += 2) {
            const bool last = (t == nt - 2);
            const char* a1 = cA + (size_t)(t + 1) * kstep;
            const char* a2 = last ? nA : cA + (size_t)(t + 2) * kstep; const char* b2 = last ? nB : cB + (size_t)(t + 2) * kstep;
            const char* a3 = a2 + kstep; const char* b3 = b2 + kstep;
            if (last && has_next) S.a_ready(nxt);
            if constexpr (SP2) {
            PG8_LDB(B0, 0, 0); if constexpr (!Epi::HALFB) PG8_LDB(B1, 0, 1); PG8_SCHED; PG8_LDA(At, 0, 0); PG8_STAGE(PG8_SA(1, 1), a1 + hstep, voffA);
            PG8_WAIT_V(8); PG8_WAIT_L(0); PG8_BAR; PG8_MMA(0, 0, At, B0); if constexpr (!Epi::HALFB) PG8_MMA(0, 1, At, B1); PG8_BAR; PG8_SCHED;
            PG8_LDA(At, 0, 1); PG8_STAGE(PG8_SB(0, 0), b2, voffB); PG8_STAGE(PG8_SB(0, 1), b2 + hstep, voffB); PG8_STAGE(PG8_SA(0, 0), a2, voffA);
            PG8_WAIT_V(8); PG8_WAIT_L(0); PG8_BAR; PG8_MMA(1, 0, At, B0); if constexpr (!Epi::HALFB) PG8_MMA(1, 1, At, B1); PG8_BAR; PG8_SCHED;
            PG8_LDB(B0, 1, 0); if constexpr (!Epi::HALFB) PG8_LDB(B1, 1, 1); PG8_SCHED; PG8_LDA(At, 1, 0); PG8_STAGE(PG8_SA(0, 1), a2 + hstep, voffA);
            PG8_WAIT_V(8); PG8_WAIT_L(0); PG8_BAR; PG8_MMA(0, 0, At, B0); if constexpr (!Epi::HALFB) PG8_MMA(0, 1, At, B1); PG8_BAR; PG8_SCHED;
            PG8_LDA(At, 1, 1); PG8_STAGE(PG8_SB(1, 0), b3, voffB); PG8_STAGE(PG8_SB(1, 1), b3 + hstep, voffB); PG8_STAGE(PG8_SA(1, 0), a3, voffA);
            PG8_WAIT_V(8); PG8_WAIT_L(0); PG8_BAR; PG8_MMA(1, 0, At, B0); if constexpr (!Epi::HALFB) PG8_MMA(1, 1, At, B1); PG8_BAR; PG8_SCHED;
            } else {
            PG8_LDB(B0, 0, 0); PG8_SCHED; PG8_LDA(At, 0, 0); PG8_STAGE(PG8_SA(1, 1), a1 + hstep, voffA);
            PG8_WAIT_L(8); PG8_BAR; PG8_WAIT_L(0); PG8_MMA(0, 0, At, B0); PG8_BAR; PG8_SCHED;
            PG8_LDB(B1, 0, 1); PG8_STAGE(PG8_SB(0, 0), b2, voffB);
            PG8_BAR; PG8_WAIT_L(0); PG8_MMA(0, 1, At, B1); PG8_BAR;
            PG8_LDA(At, 0, 1); PG8_STAGE(PG8_SA(0, 0), a2, voffA);
            PG8_BAR; PG8_WAIT_L(0); PG8_MMA(1, 0, At, B0); PG8_BAR; PG8_SCHED;
            PG8_STAGE(PG8_SB(0, 1), b2 + hstep, voffB);
            PG8_WAIT_V(6); PG8_BAR; PG8_MMA(1, 1, At, B1); PG8_BAR;
            PG8_LDB(B0, 1, 0); PG8_SCHED; PG8_LDA(At, 1, 0); PG8_STAGE(PG8_SA(0, 1), a2 + hstep, voffA);
            PG8_WAIT_L(8); PG8_BAR; PG8_WAIT_L(0); PG8_MMA(0, 0, At, B0); PG8_BAR; PG8_SCHED;
            PG8_LDB(B1, 1, 1); PG8_STAGE(PG8_SB(1, 0), b3, voffB);
            PG8_BAR; PG8_WAIT_L(0); PG8_MMA(0, 1, At, B1); PG8_BAR;
            PG8_LDA(At, 1, 1); PG8_STAGE(PG8_SA(1, 0), a3, voffA);
            PG8_BAR; PG8_WAIT_L(0); PG8_MMA(1, 0, At, B0); PG8_BAR; PG8_SCHED;
            PG8_STAGE(PG8_SB(1, 1), b3 + hstep, voffB);
            PG8_WAIT_V(6); PG8_BAR; PG8_MMA(1, 1, At, B1); PG8_BAR;
            }
        }
        if constexpr (ALIGN_EPI) { if (wr == 0) PG8_BAR; }
        bool lastseg = true; if constexpr (Epi::NSEG > 1) lastseg = (cur.seg == Epi::NSEG - 1);
        if constexpr (!Epi::AFTER_DRAIN) { if (lastseg) { E(acc, cur, wr, wc, fr, fq); S.done(cur); } else { if constexpr (Epi::NSEG > 1) E.seg(acc, cur, wr, wc, fr, fq); } }
        if (!has_next) break;
#pragma unroll
        for (int a = 0; a < 2; ++a)
#pragma unroll
            for (int b = 0; b < 2; ++b)
#pragma unroll
                for (int m = 0; m < 4; ++m)
#pragma unroll
                    for (int n = 0; n < 2; ++n) acc[a][b][m][n] = (f32x4){0.f, 0.f, 0.f, 0.f};
        cur = nxt; cA = nA; cB = nB; ++ui; if constexpr (Epi::NSEG > 1) nt = Epi::seg_nt(cur.seg);
        if constexpr (ALIGN_EPI) { if (wr == 1) PG8_BAR; }
    }
    PG8_WAIT_V(0);
    if constexpr (!ALIGN_EPI) { if (wr == 0) PG8_BAR; }
    PG8_BAR;
    if constexpr (Epi::AFTER_DRAIN) { E.fused(acc, cur, wr, wc, fr, fq, lds, wid, lane); S.done(cur); }
#undef PG8_SA
#undef PG8_SB
#undef PG8_STAGE
#undef PG8_LDA
#undef PG8_LDB
#undef PG8_MMA
#undef PG8_WAIT_V
#undef PG8_WAIT_L
#undef PG8_BAR
#undef PG8_SCHED
}
}

#define DI __device__ __forceinline__
#define LAS __attribute__((address_space(3)))
using pg8::bf16_t; using pg8::bf16x8; using pg8::f32x4; using pg8::u32x4; using pg8::Unit; using pg8::f32x2; using pg8::gelu_pk;
typedef __bf16 bf16x2_t __attribute__((ext_vector_type(2)));
__device__ __forceinline__ unsigned cvt_pk_bf16(float lo, float hi) { f32x2 v = {lo, hi}; bf16x2_t b = __builtin_convertvector(v, bf16x2_t); return __builtin_bit_cast(unsigned, b); }
typedef LAS unsigned char* lptr;
typedef unsigned u32x2 __attribute__((ext_vector_type(2)));
#define MFMA16(a, b, c) __builtin_amdgcn_mfma_f32_16x16x32_bf16((a), (b), (c), 0, 0, 0)

constexpr int T = 16384, TB = 8192, DM = 1024, FF = 2816;
constexpr float EPS = 1e-6f;
constexpr int ZUQ_LD = 3328, XBC_LD = 3072, NWIN = 7680, GATE_LD = 3072, KBR = 3328, WIN_LD = 10528;
constexpr float QSCALE = 0.125f * 1.4426950408889634f;
constexpr int PT = 272;
constexpr int LDS_BYTES = 155648;

constexpr size_t KiB = 1024, MiB = 1u << 20;
constexpr size_t WS_SS1 = 0, WS_SS2 = 64 * KiB, WS_SS3 = 128 * KiB, WS_SS4 = 192 * KiB, WS_SSV = 256 * KiB, WS_SSG = 320 * KiB  , WS_CDEC = 576 * KiB  ;
constexpr size_t WS_KMEM = 640 * KiB, WS_VMEMT = 896 * KiB, WS_DT = 2 * MiB;
constexpr size_t WS_BAR = 4 * MiB, BAR_BYTES = 65536, WS_PCNT = WS_BAR + 32768;
constexpr int LDS_BARST = LDS_BYTES - 64;
constexpr size_t WS_W2GU = 6 * MiB, WS_W2D = 17 * MiB, WS_WIN = 22 * MiB + 512 * KiB, WS_WG = 37 * MiB + 512 * KiB, WS_WBR = 43 * MiB + 512 * KiB, WS_WOUT = 50 * MiB;
constexpr size_t WS_HB = 52 * MiB, WS_MG = 84 * MiB, WS_W1GU = 116 * MiB, WS_W1D = 127 * MiB, WS_ACT = 132 * MiB + 512 * KiB;
constexpr size_t WS_ZUQ = 116 * MiB, WS_XBC = 168 * MiB, WS_ST = 216 * MiB, WS_END = 256 * MiB;
static_assert(WS_ACT + (size_t)T * FF * 2 <= WS_END && WS_ST + (size_t)64 * 32 * 8192 * 2 <= WS_END && WS_ZUQ + (size_t)TB * ZUQ_LD * 2 <= WS_XBC && WS_XBC + (size_t)TB * XBC_LD * 2 <= WS_ST, "ws map");

DI float bflo(unsigned w) { return __uint_as_float(w << 16); }
DI float bfhi(unsigned w) { return __uint_as_float(w & 0xffff0000u); }
DI float sigm(float x) { return __builtin_amdgcn_rcpf(1.f + __expf(-x)); }
DI float silu(float x) { return x * sigm(x); }
DI u32x4 pack8(f32x4 a, f32x4 b) { u32x4 w; w.x = cvt_pk_bf16(a[0], a[1]); w.y = cvt_pk_bf16(a[2], a[3]); w.z = cvt_pk_bf16(b[0], b[1]); w.w = cvt_pk_bf16(b[2], b[3]); return w; }
DI u32x2 pack4(f32x4 a) { u32x2 w; w.x = cvt_pk_bf16(a[0], a[1]); w.y = cvt_pk_bf16(a[2], a[3]); return w; }
DI f32x4 gelu4(f32x4 v) { f32x2 a = gelu_pk((f32x2){v[0], v[1]}), b = gelu_pk((f32x2){v[2], v[3]}); return (f32x4){a.x, a.y, b.x, b.y}; }
DI float rstd_of(float ss, float inv_n) { return __builtin_amdgcn_rsqf(ss * inv_n + EPS); }
DI float softplus(float v) { return v > 20.f ? v : log1pf(__expf(v)); }

struct EpiGLU {
    static constexpr bool PERM = true, AFTER_DRAIN = false; static constexpr int NSEG = 1; static constexpr bool HALFB = false;
    const float* ss; bf16_t* O;
    DI void operator()(const f32x4 (&acc)[2][2][4][2], const Unit& u, int wr, int wc, int fr, int fq) const {
        const int col = u.pn * 128 + wc * 32 + 8 * fq;
#pragma unroll
        for (int ai = 0; ai < 2; ++ai)
#pragma unroll
            for (int m = 0; m < 4; ++m) {
                const int row = u.pm * 256 + ai * 128 + wr * 64 + m * 16 + fr;
                const float r = rstd_of(ss[row], 1.f / 1024.f);
                f32x4 o[2];
#pragma unroll
                for (int n = 0; n < 2; ++n)
#pragma unroll
                    for (int e = 0; e < 4; ++e) o[n][e] = silu(acc[ai][0][m][n][e] * r) * (acc[ai][1][m][n][e] * r);
                *(u32x4*)(O + (size_t)row * FF + col) = pack8(o[0], o[1]);
            }
    }
};
template <bool RES_BF16> struct EpiRes {
    static constexpr bool PERM = true, AFTER_DRAIN = false, HALFB = false; static constexpr int NSEG = 1;
    const float* resid; const bf16_t* residb; bf16_t* hb; float* ssout; float alpha;
    DI void operator()(const f32x4 (&acc)[2][2][4][2], const Unit& u, int wr, int wc, int fr, int fq) const {
#pragma unroll
        for (int ai = 0; ai < 2; ++ai)
#pragma unroll
            for (int m = 0; m < 4; ++m) {
                const int row = u.pm * 256 + ai * 128 + wr * 64 + m * 16 + fr;
                float sq = 0.f;
#pragma unroll
                for (int bj = 0; bj < 2; ++bj) {
                    const size_t off = (size_t)row * DM + u.pn * 256 + bj * 128 + wc * 32 + 8 * fq;
                    f32x4 r0, r1;
                    if (RES_BF16) { const u32x4 rb = *(const u32x4*)(residb + off); r0 = (f32x4){bflo(rb[0]), bfhi(rb[0]), bflo(rb[1]), bfhi(rb[1])}; r1 = (f32x4){bflo(rb[2]), bfhi(rb[2]), bflo(rb[3]), bfhi(rb[3])}; }
                    else { r0 = __builtin_nontemporal_load((const f32x4*)(resid + off)); r1 = __builtin_nontemporal_load((const f32x4*)(resid + off + 4)); }
                    const f32x4 v0 = r0 + acc[ai][bj][m][0] * alpha, v1 = r1 + acc[ai][bj][m][1] * alpha;
                    *(u32x4*)(hb + off) = pack8(v0, v1);
                    sq += (v0[0] * v0[0] + v0[1] * v0[1]) + (v0[2] * v0[2] + v0[3] * v0[3]) + (v1[0] * v1[0] + v1[1] * v1[1]) + (v1[2] * v1[2] + v1[3] * v1[3]);
                }
                sq += __shfl_xor(sq, 16); sq += __shfl_xor(sq, 32);
                if (fq == 0) atomicAdd(ssout + row, sq);
            }
    }
};
struct EpiResNorm {
    static constexpr bool PERM = true, AFTER_DRAIN = false, HALFB = false; static constexpr int NSEG = 1;
    const bf16_t* residb; float* out; float* ss; unsigned* cnt; const float* gain; float alpha;
    DI void operator()(f32x4 (&acc)[2][2][4][2], const Unit& u, int wr, int wc, int fr, int fq) const {
#pragma unroll
        for (int ai = 0; ai < 2; ++ai)
#pragma unroll
            for (int m = 0; m < 4; ++m) {
                const int row = u.pm * 256 + ai * 128 + wr * 64 + m * 16 + fr;
                float sq = 0.f;
#pragma unroll
                for (int bj = 0; bj < 2; ++bj) {
                    const size_t off = (size_t)row * DM + u.pn * 256 + bj * 128 + wc * 32 + 8 * fq;
                    const u32x4 rb = __builtin_nontemporal_load((const u32x4*)(residb + off));
                    const f32x4 v0 = (f32x4){bflo(rb[0]), bfhi(rb[0]), bflo(rb[1]), bfhi(rb[1])} + acc[ai][bj][m][0] * alpha, v1 = (f32x4){bflo(rb[2]), bfhi(rb[2]), bflo(rb[3]), bfhi(rb[3])} + acc[ai][bj][m][1] * alpha;
                    acc[ai][bj][m][0] = v0; acc[ai][bj][m][1] = v1;
                    sq += (v0[0] * v0[0] + v0[1] * v0[1]) + (v0[2] * v0[2] + v0[3] * v0[3]) + (v1[0] * v1[0] + v1[1] * v1[1]) + (v1[2] * v1[2] + v1[3] * v1[3]);
                }
                sq += __shfl_xor(sq, 16); sq += __shfl_xor(sq, 32);
                if (fq == 0) atomicAdd(ss + row, sq);
            }
        asm volatile("s_waitcnt vmcnt(0)" ::: "memory");
        __syncthreads();
        if (threadIdx.x == 0) {
            unsigned* c = cnt + 64 * u.pm;
            (void)__hip_atomic_fetch_add(c, 1u, __ATOMIC_RELAXED, __HIP_MEMORY_SCOPE_AGENT);
            unsigned sp = 0;
            while (__hip_atomic_load(c, __ATOMIC_RELAXED, __HIP_MEMORY_SCOPE_AGENT) < 4u) { __builtin_amdgcn_s_sleep(1); if (++sp > (1u << 20)) break; }
        }
        __syncthreads();
#pragma unroll
        for (int ai = 0; ai < 2; ++ai)
#pragma unroll
            for (int m = 0; m < 4; ++m) {
                const int row = u.pm * 256 + ai * 128 + wr * 64 + m * 16 + fr;
                const float r = rstd_of(__hip_atomic_load(ss + row, __ATOMIC_RELAXED, __HIP_MEMORY_SCOPE_AGENT), 1.f / 1024.f);
#pragma unroll
                for (int bj = 0; bj < 2; ++bj) {
                    const int col = u.pn * 256 + bj * 128 + wc * 32 + 8 * fq;
                    const f32x4 g0 = *(const f32x4*)(gain + col), g1 = *(const f32x4*)(gain + col + 4);
                    __builtin_nontemporal_store(acc[ai][bj][m][0] * r * g0, (f32x4*)(out + (size_t)row * DM + col)); __builtin_nontemporal_store(acc[ai][bj][m][1] * r * g1, (f32x4*)(out + (size_t)row * DM + col + 4));
                }
            }
    }
};
DI int win_tile(int p) {
    return p < 4 ? p : p < 10 ? p + 9 : p < 12 ? p - 2 : p < 14 ? p + 13 : p == 14 ? 12 : p < 19 ? p - 11 : p < 25 ? p : p < 27 ? p - 15 : p;
}
__host__ __device__ __forceinline__ int win_pos(int L) {
    return L < 4 ? L : L < 8 ? L + 11 : L < 10 ? L + 2 : L < 12 ? L + 15 : L == 12 ? 14 : L < 19 ? L - 9 : L < 25 ? L : L < 27 ? L - 13 : L;
}
DI int win_row(int r) { return win_pos(r >> 8) * 256 + (r & 255); }
struct EpiWin {
    static constexpr bool PERM = true, AFTER_DRAIN = false; static constexpr int NSEG = 1; static constexpr bool HALFB = false;
    int row_base; const float* ss; bf16_t* zuq; bf16_t* xbc; bf16_t* gv; float* dt; const float* dt_bias; float* ssv;
    template <int KIND> DI void body(const f32x4 (&acc)[2][2][4][2], const Unit& u, int wr, int wc, int fr, int fq) const {
        const int pn = win_tile(u.pn), cw = wc * 32 + 8 * fq;
#pragma unroll
        for (int ai = 0; ai < 2; ++ai)
#pragma unroll
            for (int m = 0; m < 4; ++m) {
                const int lr = u.pm * 256 + ai * 128 + wr * 64 + m * 16 + fr, gr = row_base + lr;
                const float r = rstd_of(ss[gr], 1.f / 1024.f);
                if (KIND == 0) {
#pragma unroll
                    for (int bj = 0; bj < 2; ++bj) { f32x4 a, b;
#pragma unroll
                        for (int e = 0; e < 4; ++e) { a[e] = silu(acc[ai][bj][m][0][e] * r); b[e] = silu(acc[ai][bj][m][1][e] * r); }
                        *(u32x4*)(zuq + (size_t)lr * ZUQ_LD + pn * 256 + bj * 128 + cw) = pack8(a, b); }
                } else if (KIND == 1) {
#pragma unroll
                    for (int bj = 0; bj < 2; ++bj) { f32x4 a = gelu4(acc[ai][bj][m][0] * r), b = gelu4(acc[ai][bj][m][1] * r);
                        *(u32x4*)(zuq + (size_t)lr * ZUQ_LD + pn * 256 + bj * 128 + cw) = pack8(a, b); }
                } else if (KIND == 2) {
#pragma unroll
                    for (int bj = 0; bj < 2; ++bj) { f32x4 a = acc[ai][bj][m][0] * (r * QSCALE), b = acc[ai][bj][m][1] * (r * QSCALE);
                        *(u32x4*)(zuq + (size_t)lr * ZUQ_LD + pn * 256 + bj * 128 + cw) = pack8(a, b); }
                } else if (KIND == 3) {
#pragma unroll
                    for (int bj = 0; bj < 2; ++bj) { f32x4 a = acc[ai][bj][m][0] * r, b = acc[ai][bj][m][1] * r;
                        *(u32x4*)(xbc + (size_t)lr * XBC_LD + (pn - 13) * 256 + bj * 128 + cw) = pack8(a, b); }
                } else if (KIND == 4) {
                    float sq = 0.f;
#pragma unroll
                    for (int bj = 0; bj < 2; ++bj) { f32x4 a = gelu4(acc[ai][bj][m][0] * r), b = gelu4(acc[ai][bj][m][1] * r);
                        sq += (a[0] * a[0] + a[1] * a[1]) + (a[2] * a[2] + a[3] * a[3]) + (b[0] * b[0] + b[1] * b[1]) + (b[2] * b[2] + b[3] * b[3]);
                        *(u32x4*)(gv + (size_t)lr * DM + (pn - 25) * 256 + bj * 128 + cw) = pack8(a, b); }
                    sq += __shfl_xor(sq, 16); sq += __shfl_xor(sq, 32);
                    if (fq == 0) atomicAdd(ssv + gr, sq);
                } else {
                    if (wc == 0) {
#pragma unroll
                        for (int n = 0; n < 2; ++n) { f32x4 o;
#pragma unroll
                            for (int e = 0; e < 4; ++e) o[e] = softplus(acc[ai][0][m][n][e] * r + dt_bias[8 * fq + 4 * n + e]);
                            *(f32x4*)(dt + (size_t)gr * 32 + 8 * fq + 4 * n) = o; }
                    }
                }
            }
    }
    DI void operator()(const f32x4 (&acc)[2][2][4][2], const Unit& u, int wr, int wc, int fr, int fq) const {
        const int pn = win_tile(u.pn);
        if (pn < 8) body<0>(acc, u, wr, wc, fr, fq); else if (pn < 12) body<1>(acc, u, wr, wc, fr, fq); else if (pn == 12) body<2>(acc, u, wr, wc, fr, fq);
        else if (pn < 25) body<3>(acc, u, wr, wc, fr, fq); else if (pn < 29) body<4>(acc, u, wr, wc, fr, fq); else body<5>(acc, u, wr, wc, fr, fq);
    }
};
struct EpiGates {
    static constexpr bool PERM = true, AFTER_DRAIN = false; static constexpr int NSEG = 1; static constexpr bool HALFB = false;
    int row_base; const float* ss; bf16_t* O;
    DI void operator()(const f32x4 (&acc)[2][2][4][2], const Unit& u, int wr, int wc, int fr, int fq) const {
#pragma unroll
        for (int ai = 0; ai < 2; ++ai)
#pragma unroll
            for (int m = 0; m < 4; ++m) {
                const int lr = u.pm * 256 + ai * 128 + wr * 64 + m * 16 + fr;
                const float r = rstd_of(ss[row_base + lr], 1.f / 1024.f);
#pragma unroll
                for (int bj = 0; bj < 2; ++bj) { f32x4 a, b;
#pragma unroll
                    for (int e = 0; e < 4; ++e) { a[e] = sigm(acc[ai][bj][m][0][e] * r); b[e] = sigm(acc[ai][bj][m][1][e] * r); }
                    *(u32x4*)(O + (size_t)lr * GATE_LD + u.pn * 256 + bj * 128 + wc * 32 + 8 * fq) = pack8(a, b); }
            }
    }
};
struct EpiMerge {
    static constexpr bool PERM = true, AFTER_DRAIN = false, HALFB = true; static constexpr int NSEG = 3;
    const bf16_t* gates; bf16_t* run; bf16_t* O;
    static DI int seg_koff(int s) { return s == 0 ? 0 : (s == 1 ? 2048 : 3072); }
    static DI int seg_nt(int s) { return s == 0 ? 32 : (s == 1 ? 16 : 4); }
    DI void seg(const f32x4 (&acc)[2][2][4][2], const Unit& u, int wr, int wc, int fr, int fq) const {
        const int row0 = u.pm * 256 + wr * 64 + fr, cw = u.pn * 128 + wc * 32 + 8 * fq, s = u.seg;
#pragma unroll
        for (int ai = 0; ai < 2; ++ai)
#pragma unroll
            for (int m = 0; m < 4; ++m) {
                const int row = row0 + ai * 128 + m * 16;
                const u32x4 G = *(const u32x4*)(gates + (size_t)row * GATE_LD + s * 1024 + cw);
                bf16_t* rp = run + (size_t)row * DM + cw;
                f32x4 a = (f32x4){0.f, 0.f, 0.f, 0.f}, b = a;
                if (s > 0) { const u32x4 rv = *(const u32x4*)rp; a = (f32x4){bflo(rv[0]), bfhi(rv[0]), bflo(rv[1]), bfhi(rv[1])}; b = (f32x4){bflo(rv[2]), bfhi(rv[2]), bflo(rv[3]), bfhi(rv[3])}; }
                a[0] += acc[ai][0][m][0][0] * bflo(G[0]); a[1] += acc[ai][0][m][0][1] * bfhi(G[0]); a[2] += acc[ai][0][m][0][2] * bflo(G[1]); a[3] += acc[ai][0][m][0][3] * bfhi(G[1]);
                b[0] += acc[ai][0][m][1][0] * bflo(G[2]); b[1] += acc[ai][0][m][1][1] * bfhi(G[2]); b[2] += acc[ai][0][m][1][2] * bflo(G[3]); b[3] += acc[ai][0][m][1][3] * bfhi(G[3]);
                *(u32x4*)rp = pack8(a, b);
            }
    }
    DI void operator()(const f32x4 (&acc)[2][2][4][2], const Unit& u, int wr, int wc, int fr, int fq) const {
        const int row0 = u.pm * 256 + wr * 64 + fr, cw = u.pn * 128 + wc * 32 + 8 * fq;
#pragma unroll
        for (int ai = 0; ai < 2; ++ai)
#pragma unroll
            for (int m = 0; m < 4; ++m) {
                const int row = row0 + ai * 128 + m * 16;
                const u32x4 G = *(const u32x4*)(gates + (size_t)row * GATE_LD + 2048 + cw);
                const u32x4 rv = *(const u32x4*)(run + (size_t)row * DM + cw);
                f32x4 a = (f32x4){bflo(rv[0]), bfhi(rv[0]), bflo(rv[1]), bfhi(rv[1])}, b = (f32x4){bflo(rv[2]), bfhi(rv[2]), bflo(rv[3]), bfhi(rv[3])};
                a[0] += acc[ai][0][m][0][0] * bflo(G[0]); a[1] += acc[ai][0][m][0][1] * bfhi(G[0]); a[2] += acc[ai][0][m][0][2] * bflo(G[1]); a[3] += acc[ai][0][m][0][3] * bfhi(G[1]);
                b[0] += acc[ai][0][m][1][0] * bflo(G[2]); b[1] += acc[ai][0][m][1][1] * bfhi(G[2]); b[2] += acc[ai][0][m][1][2] * bflo(G[3]); b[3] += acc[ai][0][m][1][3] * bfhi(G[3]);
                *(u32x4*)(O + (size_t)row * DM + cw) = pack8(a, b);
            }
    }
};

struct Frame {
    lptr lds; unsigned char* ws; const float* const* in; float* out;
    int tid, lane, wave, G, bid;
};
struct Args { const float* in[28]; float* out; unsigned char* ws; int ph_lo, ph_hi; };
enum { I_X = 0, I_MEM, I_F1N, I_F1G, I_F1U, I_F1D, I_MIXN, I_MEMN, I_WIN, I_CONVW, I_CONVB, I_DTB, I_ALOG, I_SSDD, I_SSDN, I_GVN, I_GWS, I_GBS, I_WKV, I_WBS, I_WBG, I_WBM, I_WOUT, I_F2N, I_F2G, I_F2U, I_F2D, I_FINN };

#define LDS_WAIT() asm volatile("s_waitcnt lgkmcnt(0)" ::: "memory")

#define XB_TMO      128
#define XB_XCNT(j)  (256  + 64 * (j))
#define XB_XSUB(j)  (1280 + 64 * (j))
#define XB_XGEN(j)  (2304 + 64 * (j))
#define XB_TOP      3328
#define XB_TOPGEN   3392
#define XCD_BAR_WORDS 3456
#define XB_SPIN_CAP (1u << 18)

__device__ __forceinline__ unsigned xb_ld(unsigned* p)              { return __hip_atomic_load(p, __ATOMIC_RELAXED, __HIP_MEMORY_SCOPE_AGENT); }
__device__ __forceinline__ unsigned xb_add(unsigned* p, unsigned v) { return __hip_atomic_fetch_add(p, v, __ATOMIC_RELAXED, __HIP_MEMORY_SCOPE_AGENT); }
__device__ __forceinline__ unsigned xb_xcc_id() { return (unsigned)__builtin_amdgcn_s_getreg((3 << 11) | 20) & 0xFu; }
#define XB_SPIN(cond, bar) do { unsigned _sp = 0; while (cond) { __builtin_amdgcn_s_sleep(1); \
    if ((++_sp & 255u) == 0u) { if (xb_ld(&(bar)[XB_TMO])) break; if (_sp > XB_SPIN_CAP) { atomicAdd(&(bar)[XB_TMO], 1u); break; } } } } while (0)

struct XcdBarrier {
    unsigned* bar; unsigned x;
    volatile LAS unsigned* st;
};

__device__ __forceinline__ XcdBarrier xcd_barrier_post(unsigned* bar, volatile LAS unsigned* st) {
    XcdBarrier b; b.bar = bar; b.x = xb_xcc_id(); b.st = st;
    if (threadIdx.x == 0) (void)xb_add(&bar[XB_XCNT(b.x)], 1u);
    return b;
}
__device__ __forceinline__ void xcd_barrier_complete(unsigned* bar, unsigned x, unsigned& nloc, unsigned& nx) {
    const unsigned G = gridDim.x * gridDim.y * gridDim.z;
    unsigned sum, cnt, mine, sp = 0u;
    for (;;) {
        sum = 0u; cnt = 0u; mine = 0u;
#pragma unroll
        for (unsigned j = 0; j < 16; ++j) { const unsigned c = xb_ld(&bar[XB_XCNT(j)]); sum += c; cnt += (c > 0u) ? 1u : 0u; mine = (j == x) ? c : mine; }
        if (sum == G) break;
        __builtin_amdgcn_s_sleep(1);
        if ((++sp & 255u) == 0u) { if (xb_ld(&bar[XB_TMO])) break; if (sp > XB_SPIN_CAP) { atomicAdd(&bar[XB_TMO], 1u); break; } }
    }
    nloc = mine > 0u ? mine : 1u; nx = cnt > 0u ? cnt : 1u;
}

__device__ __forceinline__ void xcd_barrier(const XcdBarrier& b) {
    asm volatile("s_waitcnt vmcnt(0)" ::: "memory");
    __syncthreads();
    if (threadIdx.x == 0) {
        unsigned* bar = b.bar;
        __builtin_amdgcn_s_waitcnt(0);
        unsigned nloc = b.st[0], nx = b.st[1];
        if (nloc == 0u) { xcd_barrier_complete(bar, b.x, nloc, nx); b.st[0] = nloc; b.st[1] = nx; }
        const unsigned old = xb_add(&bar[XB_XSUB(b.x)], 1u);
        const unsigned gen = old / nloc;
        if (old + 1u == (gen + 1u) * nloc) {
            __builtin_amdgcn_fence(__ATOMIC_RELEASE, "agent");
            asm volatile("s_waitcnt vmcnt(0)" ::: "memory");
            const unsigned og = xb_add(&bar[XB_TOP], 1u);
            const unsigned tg = og / nx;
            if (og + 1u == (tg + 1u) * nx) xb_add(&bar[XB_TOPGEN], 1u);
            else XB_SPIN(xb_ld(&bar[XB_TOPGEN]) == tg, bar);
            __builtin_amdgcn_fence(__ATOMIC_ACQUIRE, "agent");
            xb_add(&bar[XB_XGEN(b.x)], 1u);
            asm volatile("s_waitcnt vmcnt(0)" ::: "memory");
        } else {
            XB_SPIN(xb_ld(&bar[XB_XGEN(b.x)]) == gen, bar);
            __builtin_amdgcn_fence(__ATOMIC_ACQUIRE, "agent");
            asm volatile("s_waitcnt vmcnt(0)" ::: "memory");
        }
    }
    __syncthreads();
}


DI void tr_item(const float* W, int ldw, int col0, bf16_t* WT, int ldt, int dcol0, int drow0, const float* gain, LAS float* scr, int kb, int lane) {
    const int k0 = 64 * kb;
    float tv[32];
    const float* wp = W + (size_t)(k0 + (lane >> 5)) * ldw + col0 + (lane & 31);
#pragma unroll
    for (int i = 0; i < 32; ++i) tv[i] = __builtin_nontemporal_load(wp + (size_t)(2 * i) * ldw);
    if (gain) {
#pragma unroll
        for (int i = 0; i < 32; ++i) tv[i] *= gain[k0 + 2 * i + (lane >> 5)];
    }
#pragma unroll
    for (int i = 0; i < 32; ++i) scr[(2 * i + (lane >> 5)) * 33 + (lane & 31)] = tv[i];
    LDS_WAIT();
    const int c = lane & 7;
#pragma unroll
    for (int j = 0; j < 4; ++j) { const int n = (lane >> 3) + 8 * j; const LAS float* s = scr + (8 * c) * 33 + n;
        u32x4 o; o.x = cvt_pk_bf16(s[0 * 33], s[1 * 33]); o.y = cvt_pk_bf16(s[2 * 33], s[3 * 33]); o.z = cvt_pk_bf16(s[4 * 33], s[5 * 33]); o.w = cvt_pk_bf16(s[6 * 33], s[7 * 33]);
        *(u32x4*)(WT + (size_t)(drow0 + n) * ldt + dcol0 + k0 + 8 * c) = o; }
    LDS_WAIT();
}
DI void kv_item(const Frame& F, int item) {
    const int rt = item >> 3, ct = item & 7, r0 = rt * 64, c0 = ct * 64, tid = F.tid, lane = F.lane, w = F.wave, fr = lane & 15, fq = lane >> 4;
    lptr As = F.lds, Bs = F.lds + 64 * PT; LAS float* rs = (LAS float*)(F.lds + 128 * PT);
    const float* mem = F.in[I_MEM]; const float* W = F.in[I_WKV]; const float* gain = F.in[I_MEMN];
    bf16_t* Kmem = (bf16_t*)(F.ws + WS_KMEM); bf16_t* VmemT = (bf16_t*)(F.ws + WS_VMEMT);
    const int ar = tid >> 3, ka = (tid & 7) * 16;
    const int kb = tid >> 2, nb = (tid & 3) * 16;
    const float* pa = mem + (size_t)(r0 + ar) * 1024 + ka; const float* pb = W + (size_t)kb * 512 + c0 + nb;
    float sq = 0.f;
    f32x4 acc[2]; acc[0] = (f32x4){0.f, 0.f, 0.f, 0.f}; acc[1] = acc[0];
    const bool ktype = ct < 4;
    f32x4 va[4], vb[4]; float gk;
#pragma unroll
    for (int i = 0; i < 4; ++i) { va[i] = *(const f32x4*)(pa + 4 * i); vb[i] = *(const f32x4*)(pb + 4 * i); }
    gk = gain[kb];
    for (int kc = 0; kc < 8; ++kc) {
#pragma unroll
        for (int i = 0; i < 4; ++i) sq += (va[i][0] * va[i][0] + va[i][1] * va[i][1]) + (va[i][2] * va[i][2] + va[i][3] * va[i][3]);
        *(LAS u32x4*)(As + ar * PT + ka * 2) = pack8(va[0], va[1]); *(LAS u32x4*)(As + ar * PT + ka * 2 + 16) = pack8(va[2], va[3]);
#pragma unroll
        for (int i = 0; i < 4; ++i) { const u32x2 pk = pack4(vb[i] * gk);
            *(LAS unsigned short*)(Bs + (nb + 4 * i + 0) * PT + kb * 2) = (unsigned short)(pk[0] & 0xffffu); *(LAS unsigned short*)(Bs + (nb + 4 * i + 1) * PT + kb * 2) = (unsigned short)(pk[0] >> 16);
            *(LAS unsigned short*)(Bs + (nb + 4 * i + 2) * PT + kb * 2) = (unsigned short)(pk[1] & 0xffffu); *(LAS unsigned short*)(Bs + (nb + 4 * i + 3) * PT + kb * 2) = (unsigned short)(pk[1] >> 16); }
        if (kc < 7) {
#pragma unroll
            for (int i = 0; i < 4; ++i) { va[i] = *(const f32x4*)(pa + (kc + 1) * 128 + 4 * i); vb[i] = *(const f32x4*)(pb + (size_t)(kc + 1) * 128 * 512 + 4 * i); }
            gk = gain[(kc + 1) * 128 + kb];
        }
        __syncthreads();
#pragma unroll
        for (int ks = 0; ks < 4; ++ks) {
            if (ktype) { const bf16x8 yf = *(const LAS bf16x8*)(As + (16 * (w >> 1) + fr) * PT + ks * 64 + fq * 16);
#pragma unroll
                for (int i = 0; i < 2; ++i) { const bf16x8 xf = *(const LAS bf16x8*)(Bs + (16 * ((w & 1) * 2 + i) + fr) * PT + ks * 64 + fq * 16); acc[i] = MFMA16(xf, yf, acc[i]); } }
            else { const bf16x8 yf = *(const LAS bf16x8*)(Bs + (16 * (w >> 1) + fr) * PT + ks * 64 + fq * 16);
#pragma unroll
                for (int i = 0; i < 2; ++i) { const bf16x8 xf = *(const LAS bf16x8*)(As + (16 * ((w & 1) * 2 + i) + fr) * PT + ks * 64 + fq * 16); acc[i] = MFMA16(xf, yf, acc[i]); } }
        }
        __syncthreads();
    }
    sq += __shfl_xor(sq, 1); sq += __shfl_xor(sq, 2); sq += __shfl_xor(sq, 4);
    if ((tid & 7) == 0) rs[ar] = rstd_of(sq, 1.f / 1024.f);
    __syncthreads();
    if (ktype) { const int tok = 16 * (w >> 1) + fr; const float r = rs[tok];
#pragma unroll
        for (int i = 0; i < 2; ++i) { const int ch = c0 + 16 * ((w & 1) * 2 + i) + 4 * fq; *(u32x2*)(Kmem + (size_t)(r0 + tok) * 256 + ch) = pack4(acc[i] * r); } }
    else { const int ch = c0 - 256 + 16 * (w >> 1) + fr;
#pragma unroll
        for (int i = 0; i < 2; ++i) { const int tok = 16 * ((w & 1) * 2 + i) + 4 * fq; f32x4 o;
#pragma unroll
            for (int e = 0; e < 4; ++e) o[e] = acc[i][e] * rs[tok + e];
            const int row = r0 + tok; *(u32x2*)(VmemT + (size_t)((row >> 8) * 256 + ch) * 256 + (row & 255)) = pack4(o); } }
    __syncthreads();
}
DI float wave_sum(float v) {
#pragma unroll
    for (int o = 1; o < 64; o <<= 1) v += __shfl_xor(v, o);
    return v;
}
#define SEG(Wp, ldw, c0, nc, Kk, WTp, ldt, dc0, gn, MAP) { const int nblk = (nc) / 32, cnt = ((Kk) / 64) * nblk; if (r < cnt) { const int kb = r / nblk, n0 = (r % nblk) * 32; \
        tr_item(Wp, ldw, (c0) + n0, WTp, ldt, dc0, (MAP), gn, scr, kb, lane); continue; } r -= cnt; }
DI void prologue(const Frame& F) {
    unsigned char* ws = F.ws;
    { u32x4* z = (u32x4*)(ws + WS_SS2); const int n = (int)((WS_CDEC - WS_SS2) / 16); for (int i = F.bid * 512 + F.tid; i < n; i += F.G * 512) z[i] = (u32x4){0u, 0u, 0u, 0u}; }
    LAS float* scr = (LAS float*)(F.lds + F.wave * 16384);
    const int gw = F.bid * 8 + F.wave, NGW = F.G * 8, lane = F.lane;
    bf16_t* W1GU = (bf16_t*)(ws + WS_W1GU);
    bf16_t* W1D = (bf16_t*)(ws + WS_W1D); bf16_t* WIN = (bf16_t*)(ws + WS_WIN);
    constexpr int NITEMS = 3 * 1408 + 16 * ((2048 + 1024 + 256 + 3072) / 32);
    for (int it = gw; it < NITEMS; it += NGW) {
        int r = it;
        SEG(F.in[I_F1G], FF, 0, FF, 1024, W1GU, 1024, 0, F.in[I_F1N], (n0 / 128) * 256 + (n0 % 128))
        SEG(F.in[I_F1U], FF, 0, FF, 1024, W1GU, 1024, 0, F.in[I_F1N], (n0 / 128) * 256 + 128 + (n0 % 128))
        SEG(F.in[I_F1D], 1024, 0, 1024, FF, W1D, FF, 0, (const float*)nullptr, n0)
        SEG(F.in[I_WIN], WIN_LD, 0, 2048, 1024, WIN, 1024, 0, F.in[I_MIXN], win_row(n0))
        SEG(F.in[I_WIN], WIN_LD, 5152, 1024, 1024, WIN, 1024, 0, F.in[I_MIXN], win_row(2048 + n0))
        SEG(F.in[I_WIN], WIN_LD, 7200, 256, 1024, WIN, 1024, 0, F.in[I_MIXN], win_row(3072 + n0))
        SEG(F.in[I_WIN], WIN_LD, 2048, 3072, 1024, WIN, 1024, 0, F.in[I_MIXN], win_row(3328 + n0))
    }
    const float* x = F.in[I_X]; bf16_t* hb = (bf16_t*)(ws + WS_HB); float* ss1 = (float*)(ws + WS_SS1);
    for (int m = 2 * gw; m < T; m += 2 * NGW) {
        const f32x4* xr = (const f32x4*)(x + (size_t)m * DM) + lane; float s0 = 0.f, s1 = 0.f; f32x4 v[8];
#pragma unroll
        for (int j = 0; j < 8; ++j) v[j] = __builtin_nontemporal_load(xr + 64 * j);
#pragma unroll
        for (int j = 0; j < 4; ++j) { s0 += (v[j][0] * v[j][0] + v[j][1] * v[j][1]) + (v[j][2] * v[j][2] + v[j][3] * v[j][3]); s1 += (v[4 + j][0] * v[4 + j][0] + v[4 + j][1] * v[4 + j][1]) + (v[4 + j][2] * v[4 + j][2] + v[4 + j][3] * v[4 + j][3]); }
        s0 = wave_sum(s0); s1 = wave_sum(s1); if (lane == 0) { ss1[m] = s0; ss1[m + 1] = s1; }
        u32x2* o = (u32x2*)(hb + (size_t)m * DM) + lane;
#pragma unroll
        for (int j = 0; j < 8; ++j) o[64 * j] = pack4(v[j]);
    }
}
DI void mid_convert(const Frame& F, int first_blk) {
    unsigned char* ws = F.ws;
    if (F.bid - first_blk < 64) kv_item(F, F.bid - first_blk);
    LAS float* scr = (LAS float*)(F.lds + F.wave * 16384); const int lane = F.lane;
    const int gw = (F.bid - first_blk) * 8 + F.wave, NGW = (F.G - first_blk) * 8;
    bf16_t* W1D = (bf16_t*)(ws + WS_W1D); bf16_t* WIN = (bf16_t*)(ws + WS_WIN); bf16_t* WG = (bf16_t*)(ws + WS_WG); bf16_t* WBR = (bf16_t*)(ws + WS_WBR);
    constexpr int NITEMS = 16 * ((1024 + 32) / 32) + 16 * 96 + (32 + 16 + 4) * 32;
    for (int it = gw; it < NITEMS; it += NGW) {
        int r = it;
        SEG(F.in[I_WIN], WIN_LD, 6176, 1024, 1024, WIN, 1024, 0, F.in[I_MIXN], win_row(6400 + n0))
        SEG(F.in[I_WIN], WIN_LD, 5120, 32, 1024, WIN, 1024, 0, F.in[I_MIXN], win_row(7424 + n0))
        SEG(F.in[I_WIN], WIN_LD, 7456, 3072, 1024, WG, 1024, 0, F.in[I_MIXN], n0)
        SEG(F.in[I_WBS], 1024, 0, 1024, 2048, WBR, KBR, 0, F.in[I_SSDN], n0)
        SEG(F.in[I_WBG], 1024, 0, 1024, 1024, WBR, KBR, 2048, (const float*)nullptr, n0)
        SEG(F.in[I_WBM], 1024, 0, 1024, 256, WBR, KBR, 3072, (const float*)nullptr, n0)
    }
}
DI void late_convert(const Frame& F, int first_blk) {
    unsigned char* ws = F.ws; LAS float* scr = (LAS float*)(F.lds + F.wave * 16384); const int lane = F.lane;
    const int gw = (F.bid - first_blk) * 8 + F.wave, NGW = (F.G - first_blk) * 8;
    bf16_t* W2GU = (bf16_t*)(ws + WS_W2GU); bf16_t* W2D = (bf16_t*)(ws + WS_W2D); bf16_t* WOUT = (bf16_t*)(ws + WS_WOUT);
    constexpr int NITEMS = (3 * 1408) + 512;
    for (int it = gw; it < NITEMS; it += NGW) {
        int r = it;
        SEG(F.in[I_F2G], FF, 0, FF, 1024, W2GU, 1024, 0, F.in[I_F2N], (n0 / 128) * 256 + (n0 % 128))
        SEG(F.in[I_F2U], FF, 0, FF, 1024, W2GU, 1024, 0, F.in[I_F2N], (n0 / 128) * 256 + 128 + (n0 % 128))
        SEG(F.in[I_F2D], 1024, 0, 1024, FF, W2D, FF, 0, (const float*)nullptr, n0)
        SEG(F.in[I_WOUT], 1024, 0, 1024, 1024, WOUT, 1024, 0, (const float*)nullptr, n0)
    }
}
DI void final_norm(const Frame& F) {
    const float* ss4 = (const float*)(F.ws + WS_SS4); const float* g = F.in[I_FINN];
    const int gw = F.bid * 8 + F.wave, NGW = F.G * 8, lane = F.lane;
    f32x4 gv[4];
#pragma unroll
    for (int j = 0; j < 4; ++j) gv[j] = ((const f32x4*)g)[lane + 64 * j];
    for (int m = gw; m < T; m += NGW) {
        f32x4* xr = (f32x4*)(F.out + (size_t)m * DM) + lane; const float r = rstd_of(ss4[m], 1.f / 1024.f);
#pragma unroll
        for (int j = 0; j < 4; ++j) xr[64 * j] = xr[64 * j] * r * gv[j];
    }
}

DI void ssd_scan_prep(const Frame& F, float d, int h0, LAS float* acs, LAS float* dts, LAS float* wtot) {
    const int hl = F.tid >> 7, l = F.tid & 127, h = h0 + hl;
    const float a = -__expf(F.in[I_ALOG][h]);
    float v = d * a;
#pragma unroll
    for (int o = 1; o < 64; o <<= 1) { const float t = __shfl_up(v, o); if (F.lane >= o) v += t; }
    if (F.lane == 63) wtot[F.wave] = v;
    __syncthreads();
    if (F.wave & 1) v += wtot[F.wave - 1];
    acs[hl * 128 + l] = v; dts[hl * 128 + l] = d;
    __syncthreads();
}
template <bool SCALED, int NCH> DI void stage_conv_T(lptr dst, const bf16_t* xbc, int t0, int chan0, const float* cw, const float* cb, const LAS float* scale, int tid) {
    constexpr int ncp = NCH >> 1, ntask = ncp * 16;
    static_assert(512 % ncp == 0, "a thread keeps its channel pair across tasks");
    const int cp = tid % ncp, ch = chan0 + 2 * cp;
    f32x2 w[4];
#pragma unroll
    for (int k = 0; k < 4; ++k) w[k] = *(const f32x2*)(cw + k * XBC_LD + ch);
    const f32x2 bias = *(const f32x2*)(cb + ch);
#pragma unroll 2
    for (int it_ = 0; it_ < ntask / 512; ++it_) { const int task = tid + 512 * it_;
        const int tb = task / ncp, l0 = tb * 8;
        f32x2 r[11];
#pragma unroll
        for (int i = 0; i < 11; ++i) { const int l = l0 - 3 + i; unsigned v = 0u; if (t0 + l >= 0) v = *(const unsigned*)(xbc + (long)(t0 + l) * XBC_LD + ch); r[i] = (f32x2){bflo(v), bfhi(v)}; }
        f32x4 o0[2], o1[2];
#pragma unroll
        for (int j = 0; j < 8; ++j) {
            f32x2 y = bias + w[0] * r[j] + w[1] * r[j + 1] + w[2] * r[j + 2] + w[3] * r[j + 3];
            f32x2 en = y * -1.4426950408889634f; en.x = __builtin_amdgcn_exp2f(en.x); en.y = __builtin_amdgcn_exp2f(en.y);
            f32x2 d = en + 1.0f; d.x = __builtin_amdgcn_rcpf(d.x); d.y = __builtin_amdgcn_rcpf(d.y);
            y = y * d;
            if (SCALED) { const float s = scale[((2 * cp) >> 6) * 128 + l0 + j]; y = y * s; }
            o0[j >> 2][j & 3] = y.x; o1[j >> 2][j & 3] = y.y;
        }
        *(LAS u32x4*)(dst + (2 * cp) * PT + l0 * 2) = pack8(o0[0], o0[1]);
        *(LAS u32x4*)(dst + (2 * cp + 1) * PT + l0 * 2) = pack8(o1[0], o1[1]);
    }
}
DI void stage_conv_N(lptr dst, const bf16_t* xbc, int t0, int chan0, const float* cw, const float* cb, int tid) {
    const int cg8 = (tid & 15) * 8, ch = chan0 + cg8;
    float w[4][8], b[8];
#pragma unroll
    for (int k = 0; k < 4; ++k) { const f32x4 a = *(const f32x4*)(cw + k * XBC_LD + ch), c = *(const f32x4*)(cw + k * XBC_LD + ch + 4);
#pragma unroll
        for (int e = 0; e < 4; ++e) { w[k][e] = a[e]; w[k][4 + e] = c[e]; } }
    { const f32x4 a = *(const f32x4*)(cb + ch), c = *(const f32x4*)(cb + ch + 4);
#pragma unroll
        for (int e = 0; e < 4; ++e) { b[e] = a[e]; b[4 + e] = c[e]; } }
#pragma unroll
    for (int i = 0; i < 4; ++i) {
        const int l = (tid >> 4) + 32 * i;
        float y[8];
#pragma unroll
        for (int e = 0; e < 8; ++e) y[e] = b[e];
#pragma unroll
        for (int k = 0; k < 4; ++k) { const int t = t0 + l - 3 + k; u32x4 v = (u32x4){0u, 0u, 0u, 0u}; if (t >= 0) v = *(const u32x4*)(xbc + (long)t * XBC_LD + ch);
#pragma unroll
            for (int q = 0; q < 4; ++q) { y[2 * q] += w[k][2 * q] * bflo(v[q]); y[2 * q + 1] += w[k][2 * q + 1] * bfhi(v[q]); } }
        f32x4 o0, o1;
#pragma unroll
        for (int e = 0; e < 4; ++e) { o0[e] = silu(y[e]); o1[e] = silu(y[4 + e]); }
        *(LAS u32x4*)(dst + l * PT + cg8 * 2) = pack8(o0, o1);
    }
}
struct Half { int b; bf16_t* zuq; bf16_t* xbc; bf16_t* gv; bf16_t* st; float* cdec; const float* dt; int row_base; };

#ifdef SPROBE
#define SECT(k) do { if (F.bid == 0 && threadIdx.x == 0) { volatile LAS unsigned long long* sp_ = (volatile LAS unsigned long long*)(F.lds + LDS_BYTES - 32); unsigned long long t_ = __builtin_amdgcn_s_memrealtime(); \
        if ((k) == SPROBE) { const unsigned long long d_ = (t_ - sp_[0]) * SPROBE_MULT; while (__builtin_amdgcn_s_memrealtime() - t_ < d_) __builtin_amdgcn_s_sleep(8); t_ = __builtin_amdgcn_s_memrealtime(); } sp_[0] = t_; } } while (0)
#else
#define SECT(k) do { } while (0)
#endif
DI void ssd_a_item(const Frame& F, const Half& H, int item) {
    const int c = item >> 3, g = (item >> 1) & 3, hh = item & 1, h0 = g * 8 + hh * 4, t0 = c * 128;
    lptr XT = F.lds, BT = F.lds + 69632; LAS float* acs = (LAS float*)(F.lds + 139264); LAS float* dts = acs + 512; LAS float* sc = dts + 512; LAS float* wtot = sc + 512;
    SECT(10);
    const float dpre = H.dt[(size_t)(H.row_base + t0 + (F.tid & 127)) * 32 + h0 + (F.tid >> 7)];
    stage_conv_T<false, 128>(BT, H.xbc, t0, 2048 + g * 128, F.in[I_CONVW], F.in[I_CONVB], nullptr, F.tid);
    ssd_scan_prep(F, dpre, h0, acs, dts, wtot);
    { const int hl = F.tid >> 7, l = F.tid & 127; const float last = acs[hl * 128 + 127]; sc[hl * 128 + l] = dts[hl * 128 + l] * __expf(last - acs[hl * 128 + l]);
      if (l == 127) H.cdec[c * 32 + h0 + hl] = __expf(last); }
    __syncthreads();
    SECT(11);
    stage_conv_T<true, 256>(XT, H.xbc, t0, g * 512 + hh * 256, F.in[I_CONVW], F.in[I_CONVB], sc, F.tid);
    __syncthreads();
    SECT(12);
    const int w = F.wave, hl = w >> 1, nh = w & 1, fr = F.lane & 15, fq = F.lane >> 4;
    f32x4 acc[4][4];
#pragma unroll
    for (int i = 0; i < 4; ++i)
#pragma unroll
        for (int j = 0; j < 4; ++j) acc[i][j] = (f32x4){0.f, 0.f, 0.f, 0.f};
#pragma unroll
    for (int ks = 0; ks < 4; ++ks) {
        bf16x8 xf[4], yf[4];
#pragma unroll
        for (int i = 0; i < 4; ++i) { xf[i] = *(const LAS bf16x8*)(BT + (nh * 64 + 16 * i + fr) * PT + ks * 64 + fq * 16); yf[i] = *(const LAS bf16x8*)(XT + (hl * 64 + 16 * i + fr) * PT + ks * 64 + fq * 16); }
#pragma unroll
        for (int i = 0; i < 4; ++i)
#pragma unroll
            for (int j = 0; j < 4; ++j) acc[i][j] = MFMA16(xf[i], yf[j], acc[i][j]);
    }
    bf16_t* dst = H.st + (size_t)(c * 32 + h0 + hl) * 8192;
    SECT(13);
#pragma unroll
    for (int i = 0; i < 4; ++i)
#pragma unroll
        for (int j = 0; j < 4; ++j) *(u32x2*)(dst + (16 * j + fr) * 128 + nh * 64 + 16 * i + 4 * fq) = pack4(acc[i][j]);
    __syncthreads();
    SECT(14);
}
template <int NP> DI void ssd_scan(const Frame& F, const Half& H, int nblk) {
    const int e0 = F.bid * 512 + F.tid;
    unsigned* p = (unsigned*)H.st + e0; float r0[NP], r1[NP];
#pragma unroll
    for (int q = 0; q < NP; ++q) { r0[q] = 0.f; r1[q] = 0.f; }
#pragma unroll 4
    for (int c = 0; c < 64; ++c) {
        unsigned wv[NP];
#pragma unroll
        for (int q = 0; q < NP; ++q) wv[q] = p[(size_t)c * 131072 + (size_t)q * nblk * 512];
#pragma unroll
        for (int q = 0; q < NP; ++q) { const int h = (e0 + q * nblk * 512) >> 12; const float dec = H.cdec[c * 32 + h];
            p[(size_t)c * 131072 + (size_t)q * nblk * 512] = cvt_pk_bf16(r0[q], r1[q]); r0[q] = r0[q] * dec + bflo(wv[q]); r1[q] = r1[q] * dec + bfhi(wv[q]); }
    }
}
DI void ssd_c_item(const Frame& F, const Half& H, int item) {
    const int c = item >> 2, g = item & 3, t0 = c * 128;
    lptr XT = F.lds, Cn = F.lds + 69632, Bn = F.lds + 104448; SECT(0); LAS float* acs = (LAS float*)(F.lds + 139264); LAS float* dts = acs + 512; LAS float* wtot = dts + 512; LAS float* tss = wtot + 16;
    float dpre[2];
#pragma unroll
    for (int q = 0; q < 2; ++q) dpre[q] = H.dt[(size_t)(H.row_base + t0 + (F.tid & 127)) * 32 + g * 8 + q * 4 + (F.tid >> 7)];
    stage_conv_N(Bn, H.xbc, t0, 2048 + g * 128, F.in[I_CONVW], F.in[I_CONVB], F.tid);
    stage_conv_N(Cn, H.xbc, t0, 2560 + g * 128, F.in[I_CONVW], F.in[I_CONVB], F.tid);
    __syncthreads();
    const int w = F.wave, fr = F.lane & 15, fq = F.lane >> 4;
    SECT(1);
    {
        const int lt0 = (w >> 1) * 2, st0 = (w & 1) * 4;
        f32x4 cb[4][2];
#pragma unroll
        for (int i = 0; i < 4; ++i) { cb[i][0] = (f32x4){0.f, 0.f, 0.f, 0.f}; cb[i][1] = cb[i][0]; }
#pragma unroll
        for (int ks = 0; ks < 4; ++ks) {
            bf16x8 xf[4], yf[2];
#pragma unroll
            for (int i = 0; i < 4; ++i) xf[i] = *(const LAS bf16x8*)(Bn + (16 * (st0 + i) + fr) * PT + ks * 64 + fq * 16);
#pragma unroll
            for (int j = 0; j < 2; ++j) yf[j] = *(const LAS bf16x8*)(Cn + (16 * (lt0 + j) + fr) * PT + ks * 64 + fq * 16);
#pragma unroll
            for (int i = 0; i < 4; ++i)
#pragma unroll
                for (int j = 0; j < 2; ++j) cb[i][j] = MFMA16(xf[i], yf[j], cb[i][j]);
        }
        __syncthreads();
#pragma unroll
        for (int i = 0; i < 4; ++i)
#pragma unroll
            for (int j = 0; j < 2; ++j) *(LAS u32x2*)(Bn + (16 * (lt0 + j) + fr) * PT + (16 * (st0 + i) + 4 * fq) * 2) = pack4(cb[i][j]);
    }
    SECT(2);
    const int hl = w >> 1, lh = w & 1;
#pragma unroll 1
    for (int hh = 0; hh < 2; ++hh) {
        const int h0 = g * 8 + hh * 4, h = h0 + hl;
        __syncthreads();
        ssd_scan_prep(F, hh ? dpre[1] : dpre[0], h0, acs, dts, wtot);
        SECT(3);
        stage_conv_T<false, 256>(XT, H.xbc, t0, g * 512 + hh * 256, F.in[I_CONVW], F.in[I_CONVB], nullptr, F.tid);
        __syncthreads();
        SECT(4);
        f32x4 accd[4][4];
#pragma unroll
        for (int i = 0; i < 4; ++i)
#pragma unroll
            for (int j = 0; j < 4; ++j) accd[i][j] = (f32x4){0.f, 0.f, 0.f, 0.f};
        const LAS float* ah = acs + hl * 128; const LAS float* dh = dts + hl * 128;
        const bf16_t* Sp = H.st + (size_t)(c * 32 + h) * 8192;
#pragma unroll
        for (int ks = 0; ks < 4; ++ks) {
            bf16x8 xf[4], yf[4];
#pragma unroll
            for (int i = 0; i < 4; ++i) { xf[i] = *(const bf16x8*)(Sp + (16 * i + fr) * 128 + ks * 32 + fq * 8); yf[i] = *(const LAS bf16x8*)(Cn + (lh * 64 + 16 * i + fr) * PT + ks * 64 + fq * 16); }
#pragma unroll
            for (int i = 0; i < 4; ++i)
#pragma unroll
                for (int j = 0; j < 4; ++j) accd[i][j] = MFMA16(xf[i], yf[j], accd[i][j]);
        }
#pragma unroll
        for (int j = 0; j < 4; ++j) { const float el = __expf(ah[lh * 64 + 16 * j + fr]);
#pragma unroll
            for (int i = 0; i < 4; ++i) accd[i][j] = accd[i][j] * el; }
        SECT(5);
        const int nks = lh ? 4 : 2;
        for (int ks = 0; ks < nks; ++ks) {
            bf16x8 xf[4], yf[4];
            const int s0 = ks * 32 + fq * 8;
            const f32x4 as0 = *(const LAS f32x4*)(ah + s0), as1 = *(const LAS f32x4*)(ah + s0 + 4), ds0 = *(const LAS f32x4*)(dh + s0), ds1 = *(const LAS f32x4*)(dh + s0 + 4);
#pragma unroll
            for (int j = 0; j < 4; ++j) {
                const int l = lh * 64 + 16 * j + fr; const float al = ah[l];
                const u32x4 cbv = *(const LAS u32x4*)(Bn + l * PT + s0 * 2);
                f32x4 o0, o1;
#pragma unroll
                for (int q = 0; q < 4; ++q) {
                    const int sa = s0 + 2 * q, sb = sa + 1;
                    const float asa = (q < 2) ? as0[2 * q] : as1[2 * q - 4], asb = (q < 2) ? as0[2 * q + 1] : as1[2 * q - 3];
                    const float dsa = (q < 2) ? ds0[2 * q] : ds1[2 * q - 4], dsb = (q < 2) ? ds0[2 * q + 1] : ds1[2 * q - 3];
                    const float va = (sa <= l) ? bflo(cbv[q]) * __expf(al - asa) * dsa : 0.f;
                    const float vb = (sb <= l) ? bfhi(cbv[q]) * __expf(al - asb) * dsb : 0.f;
                    if (q < 2) { o0[2 * q] = va; o0[2 * q + 1] = vb; } else { o1[2 * q - 4] = va; o1[2 * q - 3] = vb; }
                }
                yf[j] = __builtin_bit_cast(bf16x8, pack8(o0, o1));
            }
#pragma unroll
            for (int i = 0; i < 4; ++i) xf[i] = *(const LAS bf16x8*)(XT + (hl * 64 + 16 * i + fr) * PT + ks * 64 + fq * 16);
#pragma unroll
            for (int i = 0; i < 4; ++i)
#pragma unroll
                for (int j = 0; j < 4; ++j) accd[i][j] = MFMA16(xf[i], yf[j], accd[i][j]);
        }
        const float Dh = F.in[I_SSDD][h];
        SECT(6);
#pragma unroll
        for (int j = 0; j < 4; ++j) {
            const int l = lh * 64 + 16 * j + fr; float sq = 0.f;
            bf16_t* zr = H.zuq + (size_t)(t0 + l) * ZUQ_LD + h * 64;
#pragma unroll
            for (int i = 0; i < 4; ++i) {
                const int p = 16 * i + 4 * fq;
                const u32x2 zv = *(const u32x2*)(zr + p);
                f32x4 y;
#pragma unroll
                for (int e = 0; e < 4; ++e) { const float xv = __uint_as_float(((unsigned)*(const LAS unsigned short*)(XT + (hl * 64 + p + e) * PT + l * 2)) << 16); y[e] = accd[i][j][e] + Dh * xv; }
                y[0] *= bflo(zv[0]); y[1] *= bfhi(zv[0]); y[2] *= bflo(zv[1]); y[3] *= bfhi(zv[1]);
                sq += (y[0] * y[0] + y[1] * y[1]) + (y[2] * y[2] + y[3] * y[3]);
                *(u32x2*)(zr + p) = pack4(y);
            }
            sq += __shfl_xor(sq, 16); sq += __shfl_xor(sq, 32);
            if (fq == 0) tss[(hh * 4 + hl) * 128 + l] = sq;
        }
        SECT(7);
    }
    __syncthreads();
    {
        const int wv = F.wave, ln = F.lane;
        u32x4 v[16]; float r[16];
#pragma unroll
        for (int i = 0; i < 16; ++i) v[i] = *((const u32x4*)(H.zuq + (size_t)(t0 + wv * 16 + i) * ZUQ_LD + g * 512) + ln);
#pragma unroll
        for (int i = 0; i < 16; ++i) { float tsum = 0.f;
#pragma unroll
            for (int k = 0; k < 8; ++k) tsum += tss[k * 128 + wv * 16 + i];
            r[i] = rstd_of(tsum, 1.f / 512.f); }
#pragma unroll
        for (int i = 0; i < 16; ++i) { f32x4 a, b; a[0] = bflo(v[i][0]) * r[i]; a[1] = bfhi(v[i][0]) * r[i]; a[2] = bflo(v[i][1]) * r[i]; a[3] = bfhi(v[i][1]) * r[i]; b[0] = bflo(v[i][2]) * r[i]; b[1] = bfhi(v[i][2]) * r[i]; b[2] = bflo(v[i][3]) * r[i]; b[3] = bfhi(v[i][3]) * r[i];
            *((u32x4*)(H.zuq + (size_t)(t0 + wv * 16 + i) * ZUQ_LD + g * 512) + ln) = pack8(a, b); }
    }
    __syncthreads();
    SECT(8);
}


typedef short v4i16_t __attribute__((ext_vector_type(4)));
DI void gmlp_item(const Frame& F, const Half& H, int item) {
    const int c = item >> 3, g = item & 7, t0 = c * 128, d0 = g * 128, tid = F.tid;
    lptr VT = F.lds, WS = F.lds + 34816; LAS float* rv = (LAS float*)(F.lds + 69632);
    const float* ssv = (const float*)(F.ws + WS_SSV);
    SECT(20);
    u32x4 pk[4]; f32x4 w0[4], w1[4];
#pragma unroll
    for (int i = 0; i < 4; ++i) {
        const int v = tid + 512 * i, s = v >> 4, seg = v & 15;
        pk[i] = *(const u32x4*)(H.gv + (size_t)(t0 + s) * DM + d0 + seg * 8);
        const float* wp = F.in[I_GWS] + (size_t)(g * 128 + s) * 128 + seg * 8; w0[i] = *(const f32x4*)wp; w1[i] = *(const f32x4*)(wp + 4);
    }
    if (tid < 128) rv[tid] = rstd_of(ssv[H.row_base + t0 + tid], 1.f / 1024.f);
    __syncthreads();
#pragma unroll
    for (int i = 0; i < 4; ++i) {
        const int v = tid + 512 * i, s = v >> 4, seg = v & 15;
        *(LAS u32x4*)(VT + s * PT + seg * 16) = pk[i];
        const int t = s, s0 = seg * 8;
        f32x4 o0, o1;
#pragma unroll
        for (int e = 0; e < 4; ++e) { o0[e] = (s0 + e <= t) ? w0[i][e] * rv[s0 + e] : 0.f; o1[e] = (s0 + 4 + e <= t) ? w1[i][e] * rv[s0 + 4 + e] : 0.f; }
        *(LAS u32x4*)(WS + t * PT + s0 * 2) = pack8(o0, o1);
    }
    __syncthreads();
    SECT(21);
    const int w = F.wave, fr = F.lane & 15, fq = F.lane >> 4, mtb = (w & 3) * 2, ntb = (w >> 2) * 4;
    f32x4 acc[2][4];
#pragma unroll
    for (int i = 0; i < 2; ++i)
#pragma unroll
        for (int j = 0; j < 4; ++j) acc[i][j] = (f32x4){0.f, 0.f, 0.f, 0.f};
    const int nks = ntb ? 4 : 2;
    for (int ks = 0; ks < nks; ++ks) {
        bf16x8 xf[2], yf[4];
#pragma unroll
        for (int i = 0; i < 2; ++i) {
            const v4i16_t lo = __builtin_amdgcn_ds_read_tr16_b64_v4i16((LAS v4i16_t*)(VT + (ks * 32 + 8 * fq + (fr >> 2)) * PT + (16 * (mtb + i)) * 2 + 8 * (fr & 3)));
            const v4i16_t hi = __builtin_amdgcn_ds_read_tr16_b64_v4i16((LAS v4i16_t*)(VT + (ks * 32 + 8 * fq + 4 + (fr >> 2)) * PT + (16 * (mtb + i)) * 2 + 8 * (fr & 3)));
            xf[i] = __builtin_shufflevector(lo, hi, 0, 1, 2, 3, 4, 5, 6, 7); }
#pragma unroll
        for (int j = 0; j < 4; ++j) yf[j] = *(const LAS bf16x8*)(WS + (16 * (ntb + j) + fr) * PT + ks * 64 + fq * 16);
#pragma unroll
        for (int i = 0; i < 2; ++i)
#pragma unroll
            for (int j = 0; j < 4; ++j) acc[i][j] = MFMA16(xf[i], yf[j], acc[i][j]);
    }
    SECT(22);
#pragma unroll
    for (int j = 0; j < 4; ++j) {
        const int t = 16 * (ntb + j) + fr; const float bias = F.in[I_GBS][g * 128 + t];
#pragma unroll
        for (int i = 0; i < 2; ++i) {
            const int d = d0 + 16 * (mtb + i) + 4 * fq;
            const f32x4 gn = *(const f32x4*)(F.in[I_GVN] + d);
            bf16_t* up = H.zuq + (size_t)(t0 + t) * ZUQ_LD + 2048 + d;
            const u32x2 uv = *(const u32x2*)up;
            f32x4 y;
            y[0] = bflo(uv[0]) * (gn[0] * acc[i][j][0] + bias); y[1] = bfhi(uv[0]) * (gn[1] * acc[i][j][1] + bias);
            y[2] = bflo(uv[1]) * (gn[2] * acc[i][j][2] + bias); y[3] = bfhi(uv[1]) * (gn[3] * acc[i][j][3] + bias);
            *(u32x2*)up = pack4(y);
        }
    }
    __syncthreads();
    SECT(23);
}
DI void memattn_item(const Frame& F, const Half& H, int item) {
    const int h = item & 3, t0 = (item >> 2) * 128, tid = F.tid, w = F.wave, fr = F.lane & 15, fq = F.lane >> 4;
    lptr Ks = F.lds, VT = F.lds + 36864, Pw = F.lds + 70656 + w * 8448;
    const bf16_t* Kmem = (const bf16_t*)(F.ws + WS_KMEM) + (size_t)H.b * 256 * 256; const bf16_t* VmemT = (const bf16_t*)(F.ws + WS_VMEMT) + (size_t)H.b * 256 * 256;
#pragma unroll
    for (int i = 0; i < 4; ++i) {
        const int v = tid + 512 * i;
        { const int m = v >> 3, seg = v & 7; *(LAS u32x4*)(Ks + m * 144 + seg * 16) = *(const u32x4*)(Kmem + (size_t)m * 256 + h * 64 + seg * 8); }
        { const int d = v >> 5, seg = v & 31; *(LAS u32x4*)(VT + d * 528 + seg * 16) = *(const u32x4*)(VmemT + (size_t)(h * 64 + d) * 256 + seg * 8); }
    }
    __syncthreads();
    for (int sub = 0; sub < 1; ++sub) {
        const int tw = t0 + sub * 128 + w * 16;
        bf16_t* qrow = H.zuq + (size_t)(tw + fr) * ZUQ_LD + 3072 + h * 64;
        bf16x8 qf[2];
        qf[0] = *(const bf16x8*)(qrow + fq * 8); qf[1] = *(const bf16x8*)(qrow + 32 + fq * 8);
        f32x4 s[16];
#pragma unroll
        for (int i = 0; i < 16; ++i) { s[i] = (f32x4){0.f, 0.f, 0.f, 0.f};
#pragma unroll
            for (int ks = 0; ks < 2; ++ks) { const bf16x8 kf = *(const LAS bf16x8*)(Ks + (16 * i + fr) * 144 + ks * 64 + fq * 16); s[i] = MFMA16(kf, qf[ks], s[i]); } }
        float mx = -3.0e38f;
#pragma unroll
        for (int i = 0; i < 16; ++i) mx = fmaxf(mx, fmaxf(fmaxf(s[i][0], s[i][1]), fmaxf(s[i][2], s[i][3])));
        mx = fmaxf(mx, __shfl_xor(mx, 16)); mx = fmaxf(mx, __shfl_xor(mx, 32));
        float sum = 0.f;
#pragma unroll
        for (int i = 0; i < 16; ++i) { f32x4 p;
#pragma unroll
            for (int e = 0; e < 4; ++e) { p[e] = __builtin_amdgcn_exp2f(s[i][e] - mx); sum += p[e]; }
            *(LAS u32x2*)(Pw + fr * 528 + (16 * i + 4 * fq) * 2) = pack4(p); }
        sum += __shfl_xor(sum, 16); sum += __shfl_xor(sum, 32);
        LDS_WAIT(); __builtin_amdgcn_wave_barrier();
        f32x4 o[4];
#pragma unroll
        for (int i = 0; i < 4; ++i) o[i] = (f32x4){0.f, 0.f, 0.f, 0.f};
#pragma unroll
        for (int ks = 0; ks < 8; ++ks) { const bf16x8 pf = *(const LAS bf16x8*)(Pw + fr * 528 + ks * 64 + fq * 16);
#pragma unroll
            for (int i = 0; i < 4; ++i) { const bf16x8 vf = *(const LAS bf16x8*)(VT + (16 * i + fr) * 528 + ks * 64 + fq * 16); o[i] = MFMA16(vf, pf, o[i]); } }
        const float inv = __builtin_amdgcn_rcpf(sum);
#pragma unroll
        for (int i = 0; i < 4; ++i) *(u32x2*)(qrow + 16 * i + 4 * fq) = pack4(o[i] * inv);
        LDS_WAIT(); __builtin_amdgcn_wave_barrier();
    }
    __syncthreads();
}

#ifndef WGM_HALF
#define WGM_HALF 8
#endif
#define PH_GEMM(EpiT, Aptr, Bptr, Mm, Nn, Kk, Eobj) do { pg8::Gemm g_{(const bf16_t*)(Aptr), (const bf16_t*)(Bptr), Mm, Nn, Kk}; pg8::StaticOrder S_; S_.init(Mm, Nn, F.G, F.bid, (Mm) == TB ? WGM_HALF : 8); \
        pg8::gemm_phase<EpiT, pg8::StaticOrder, true, true>(F.lds, g_, S_, Eobj); } while (0)

__global__ void __launch_bounds__(512) mega_fwd(Args args) {
    extern __shared__ __attribute__((aligned(16))) unsigned char lds_raw[];
    cg::grid_group grid = cg::this_grid();
    Frame F; F.lds = (lptr)lds_raw; F.ws = args.ws; F.in = args.in; F.out = args.out;
    F.tid = threadIdx.x; F.lane = F.tid & 63; F.wave = __builtin_amdgcn_readfirstlane(F.tid >> 6); F.G = gridDim.x; F.bid = blockIdx.x;
    unsigned char* ws = args.ws;
    const int lo = args.ph_lo, hi = args.ph_hi;
    { volatile LAS unsigned* st_ = (volatile LAS unsigned*)(F.lds + LDS_BARST); if (F.tid < 2) st_[F.tid] = 0u; }
    __syncthreads();
    XcdBarrier xbar; xbar.bar = (unsigned*)(ws + WS_BAR); xbar.x = 0; xbar.st = nullptr;
    if (lo > hi) grid.sync();
    if (hi - lo > 1) xbar = xcd_barrier_post((unsigned*)(ws + WS_BAR), (volatile LAS unsigned*)(F.lds + LDS_BARST));
#define HB ((bf16_t*)(ws + WS_HB))
#define ACT ((bf16_t*)(ws + WS_ACT))
#define MG ((bf16_t*)(ws + WS_MG))
#define SS1 ((float*)(ws + WS_SS1))
#define SS2 ((float*)(ws + WS_SS2))
#define SS3 ((float*)(ws + WS_SS3))
#define SS4 ((float*)(ws + WS_SS4))
#ifndef PHMASK
#define PHMASK 0xFFFFFFFFu
#endif
#define RELAUNDER() do { int t_ = threadIdx.x; asm volatile("" : "+v"(t_)); F.tid = t_; F.lane = t_ & 63; F.wave = __builtin_amdgcn_readfirstlane(t_ >> 6); \
        unsigned long long w_ = (unsigned long long)args.ws; asm volatile("" : "+s"(w_)); ws = (unsigned char*)w_; F.ws = ws; } while (0)
#define IN(k) (((PHMASK >> ((k) > 8 ? (k) - 6 : (k))) & 1u) && lo <= (k) && (k) < hi)
#define SEAM(k) do { if ((k) + 1 < hi) { xcd_barrier(xbar); } } while (0)

    if (IN(0)) { RELAUNDER(); prologue(F); SEAM(0); }
    if (IN(1)) { RELAUNDER(); EpiGLU E{SS1, ACT}; PH_GEMM(EpiGLU, HB, ws + WS_W1GU, T, 2 * FF, DM, E);
        if (F.G >= 256) { if (F.bid >= 128) mid_convert(F, 128); } else mid_convert(F, 0);
        SEAM(1); }
    if (IN(2)) { RELAUNDER(); EpiRes<true> E{(const float*)nullptr, HB, HB, SS2, 0.5f}; PH_GEMM(EpiRes<true>, ACT, ws + WS_W1D, T, DM, FF, E); SEAM(2); }
#pragma unroll 1
    for (int b = 0; b < 2; ++b) {
        const int k0 = 3 + 6 * b;
#define MKHALF() Half H; H.b = b; H.zuq = (bf16_t*)(ws + WS_ZUQ); H.xbc = (bf16_t*)(ws + WS_XBC); H.gv = MG + (size_t)TB * DM; H.st = (bf16_t*)(ws + WS_ST); H.cdec = (float*)(ws + WS_CDEC) + b * 2048; H.dt = (const float*)(ws + WS_DT); H.row_base = b * TB;
        if (IN(k0)) { RELAUNDER(); MKHALF(); if (b == 1) { if (F.G >= 256) { if (F.bid >= 192) late_convert(F, 192); } else late_convert(F, 0); __syncthreads(); }
            EpiWin E{H.row_base, SS2, H.zuq, H.xbc, H.gv, (float*)(ws + WS_DT), F.in[I_DTB], (float*)(ws + WS_SSV)};
            PH_GEMM(EpiWin, HB + (size_t)H.row_base * DM, ws + WS_WIN, TB, NWIN, DM, E); SEAM(k0); }
        if (IN(k0 + 1)) { RELAUNDER(); MKHALF();
            for (int it = F.bid; it < 512; it += F.G) ssd_a_item(F, H, it);
            if (F.G != 256) { for (int it = F.bid; it < 512; it += F.G) gmlp_item(F, H, it); }
            if (F.G < 256) { for (int it = F.bid; it < 256; it += F.G) memattn_item(F, H, it); }
            SEAM(k0 + 1); }
        if (IN(k0 + 2)) { RELAUNDER(); MKHALF();
            if (F.G == 256) { if (F.bid < 64) ssd_scan<4>(F, H, 64); else for (int it = F.bid - 64; it < 512; it += F.G - 64) gmlp_item(F, H, it); }
            else { if (F.bid < 64) ssd_scan<4>(F, H, 64); }
            SEAM(k0 + 2); }
        if (IN(k0 + 3)) { RELAUNDER(); MKHALF(); for (int it = F.bid; it < 256; it += F.G) ssd_c_item(F, H, it); SEAM(k0 + 3); }
        if (IN(k0 + 4)) { RELAUNDER(); MKHALF(); if (F.G >= 256 && F.bid >= 128) { for (int it = F.bid - 128; it < 256; it += F.G - 128) memattn_item(F, H, it); }
            EpiGates E{H.row_base, SS2, H.xbc}; PH_GEMM(EpiGates, HB + (size_t)H.row_base * DM, ws + WS_WG, TB, GATE_LD, DM, E); SEAM(k0 + 4); }
        if (IN(k0 + 5)) { RELAUNDER(); MKHALF(); EpiMerge E{H.xbc, (bf16_t*)(ws + WS_ST), MG + (size_t)b * TB * DM};
            { pg8::Gemm g_{(const bf16_t*)H.zuq, (const bf16_t*)(ws + WS_WBR), TB, DM, KBR}; pg8::SegOrder<3> S_; S_.init(TB, 2 * DM, F.G, F.bid);     pg8::gemm_phase<EpiMerge, pg8::SegOrder<3>, true, true>(F.lds, g_, S_, E); } SEAM(k0 + 5); }
    }
    if (IN(15)) { RELAUNDER(); EpiRes<true> E{(const float*)nullptr, HB, HB, SS3, 1.0f}; PH_GEMM(EpiRes<true>, MG, ws + WS_WOUT, T, DM, DM, E); SEAM(15); }
    if (IN(16)) { RELAUNDER(); EpiGLU E{SS3, ACT}; PH_GEMM(EpiGLU, HB, ws + WS_W2GU, T, 2 * FF, DM, E); SEAM(16); }
    if (IN(17)) { RELAUNDER(); EpiResNorm E{HB, F.out, SS4, (unsigned*)(ws + WS_PCNT), F.in[I_FINN], 0.5f}; PH_GEMM(EpiResNorm, ACT, ws + WS_W2D, T, DM, FF, E); }
}

#ifndef N_PHASES
#define N_PHASES 18
#endif
#ifndef ONE_LAUNCH
#define ONE_LAUNCH 1
#endif
extern "C" void kernel_launch(void* const* d_in, const int* in_sizes, int n_in, void* d_out, int out_size, void* d_ws, size_t ws_size, hipStream_t stream) {
    static int grid = 0;
    if (grid == 0) {
        int dev = 0, cus = 0, per_cu = 0;
        hipGetDevice(&dev); hipDeviceGetAttribute(&cus, hipDeviceAttributeMultiprocessorCount, dev);
        if (hipFuncSetAttribute((const void*)mega_fwd, hipFuncAttributeMaxDynamicSharedMemorySize, LDS_BYTES) != hipSuccess) { fprintf(stderr, "kernel_launch: hipFuncSetAttribute failed\n"); grid = -1; return; }
        if (hipOccupancyMaxActiveBlocksPerMultiprocessor(&per_cu, (const void*)mega_fwd, 512, LDS_BYTES) != hipSuccess || per_cu < 1) { fprintf(stderr, "kernel_launch: occupancy query says %d\n", per_cu); per_cu = 1; }
        (void)hipGetLastError();
        grid = cus;
        if (n_in != 28 || ws_size < WS_END) { fprintf(stderr, "kernel_launch: unexpected n_in %d / ws %zu\n", n_in, ws_size); grid = -1; return; }
    }
    if (grid < 0) return;
    if (hipMemsetAsync((char*)d_ws + WS_BAR, 0, BAR_BYTES, stream) != hipSuccess) { fprintf(stderr, "kernel_launch: memset failed\n"); return; }
    Args a{};
    for (int i = 0; i < 28; ++i) a.in[i] = (const float*)d_in[i];
    a.out = (float*)d_out; a.ws = (unsigned char*)d_ws;
#if ONE_LAUNCH
    a.ph_lo = 0; a.ph_hi = N_PHASES;
    void* kargs[] = {&a};
    hipError_t e = hipLaunchCooperativeKernel((const void*)mega_fwd, dim3(grid), dim3(512), kargs, LDS_BYTES, stream);
    if (e != hipSuccess) fprintf(stderr, "cooperative launch failed: %s (grid %d)\n", hipGetErrorString(e), grid);
#else
    for (int k = 0; k < N_PHASES; ++k) { a.ph_lo = k; a.ph_hi = k + 1; hipLaunchKernelGGL(mega_fwd, dim3(grid), dim3(512), LDS_BYTES, stream, a); }
#endif
}
```

```cpp
#include <hip/hip_runtime.h>
#include <hip/hip_cooperative_groups.h>
#include <cstdio>
#include <cstdint>
namespace cg = cooperative_groups;
namespace pg8 {
#define PG8_LAS __attribute__((address_space(3)))
typedef unsigned short bf16_t;
typedef short bf16x8 __attribute__((ext_vector_type(8)));
typedef float f32x4 __attribute__((ext_vector_type(4)));
typedef unsigned u32x4 __attribute__((ext_vector_type(4)));
constexpr int BM = 256, BK = 64, HALF = 128, HTB = HALF * BK * 2  , STAGE_BYTES = 8 * HTB, NXCD = 8, WGM = 8;

__host__ __device__ __forceinline__ int lds_byte(int r, int c) { const int st = (r >> 4) * 2 + (c >> 5), rr = r & 15, cc = c & 31, ob = rr * 64 + cc * 2; return st * 1024 + (ob ^ (((ob >> 9) & 1) << 5)); }
__host__ __device__ __forceinline__ void stage_rc(int b, int& R, int& C) { const int st = b / 1024, sb = b % 1024, swz = sb ^ (((sb >> 9) & 1) << 5); R = (st >> 1) * 16 + swz / 64; C = (st & 1) * 32 + (swz % 64) / 2; }
__host__ __device__ __forceinline__ int perm32(int rho) { const int n = rho >> 4, i = rho & 15; return 8 * (i >> 2) + 4 * n + (i & 3); }

struct Unit { int pm, pn, seg; };
struct Gemm { const bf16_t* A; const bf16_t* Bt; int M, N, K; };

struct StaticOrder {
    int nM, nN, nwg, G, c, wgm;
    __host__ __device__ void init(int M, int N, int G_, int c_, int wgm_ = WGM) { nM = M / BM; nN = N / BM; nwg = nM * nN; G = G_; c = c_; wgm = wgm_; }
    __host__ __device__ bool next(int i, Unit& u) const {
        const long L = (long)i * G + c; if (L >= nwg) return false;
        int wgid = (int)L; { const int q = nwg / NXCD, r = nwg % NXCD, xcd = wgid % NXCD, off = wgid / NXCD; wgid = (xcd < r ? xcd * (q + 1) : r * (q + 1) + (xcd - r) * q) + off; }
        const int nig = wgm * nN, gid = wgid / nig, fm = gid * wgm, gsz = (nM - fm) < wgm ? (nM - fm) : wgm;
        u.pm = fm + ((wgid % nig) % gsz); u.pn = (wgid % nig) / gsz; u.seg = 0; return true;
    }
    __device__ __forceinline__ void a_ready(const Unit&) const {}
    __device__ __forceinline__ void done(const Unit&) const {}
};

template <int NSEG> struct SegOrder {
    StaticOrder base;
    __host__ __device__ void init(int M, int N, int G_, int c_) { base.init(M, N, G_, c_); }
    __host__ __device__ bool next(int i, Unit& u) const { if (!base.next(i / NSEG, u)) return false; u.seg = i % NSEG; return true; }
    __device__ __forceinline__ void a_ready(const Unit&) const {}
    __device__ __forceinline__ void done(const Unit&) const {}
};
__device__ __forceinline__ unsigned cvt_pk_bf16(float lo, float hi) { unsigned r; asm volatile("v_cvt_pk_bf16_f32 %0, %1, %2" : "=v"(r) : "v"(lo), "v"(hi)); return r; }
typedef float f32x2 __attribute__((ext_vector_type(2)));
__device__ __forceinline__ f32x2 gelu_pk(f32x2 v) {
    const f32x2 av = __builtin_elementwise_abs(v), d = av * 0.2316418882f + 1.0f;
    f32x2 t; t.x = __builtin_amdgcn_rcpf(d.x); t.y = __builtin_amdgcn_rcpf(d.y);
    f32x2 q = t * 0.5307027145f + (-0.7265760135f); q = q * t + 0.7107068705f; q = q * t + (-0.142248368f); q = q * t + 0.127414796f; q = q * t;
    const f32x2 s = (v * v) * (-0.72134752044f);
    f32x2 e; e.x = __builtin_amdgcn_exp2f(s.x); e.y = __builtin_amdgcn_exp2f(s.y);
    const f32x2 m = v * (q * e), r = v - m;
    f32x2 o; o.x = v.x < 0.f ? m.x : r.x; o.y = v.y < 0.f ? m.y : r.y; return o;
}
template <class Epi, class Sched, bool ALIGN_EPI = false, bool SP2 = false>
__device__ __forceinline__ void gemm_phase(PG8_LAS unsigned char* lds, const Gemm g, const Sched& S, const Epi& E) {
    int tid_ = threadIdx.x; asm volatile("" : "+v"(tid_)); const int tid = tid_, wid = __builtin_amdgcn_readfirstlane(tid >> 6), lane = tid & 63, wr = wid >> 2, wc = wid & 3, fr = lane & 15, fq = lane >> 4;
    const int K = g.K; int nt = K / BK;
    unsigned voffA[2], voffB[2];
#pragma unroll
    for (int i = 0; i < 2; ++i) { int R, C; stage_rc(tid * 16 + i * 8192, R, C); const int Rb = Epi::PERM ? ((R & ~31) + perm32(R & 31)) : R;
        voffA[i] = (unsigned)(R * K + C) * 2u; voffB[i] = (unsigned)(Rb * K + C) * 2u; }
    const size_t kstep = (size_t)(BK * 2);
    const size_t hstep = (size_t)HALF * K * 2;
    const size_t tstep = 2 * hstep;
    const unsigned ldsw = (unsigned)wid * 1024u;
    const int aoff = lds_byte(wr * 64 + fr, fq * 8), boff = lds_byte(wc * 32 + fr, fq * 8);
#define PG8_SA(b, h) (((b) * 2 + (h)) * HTB)
#define PG8_SB(b, h) ((4 + (b) * 2 + (h)) * HTB)
#define PG8_STAGE(bufoff, gbase, voff) do { _Pragma("unroll") for (int _i = 0; _i < 2; ++_i) \
        __builtin_amdgcn_global_load_lds((const unsigned*)((const char*)(gbase) + (voff)[_i]), (PG8_LAS unsigned*)(lds + (bufoff) + ldsw + _i * 8192), 16, 0, 0); } while (0)
#define PG8_LDA(dst, b, h) do { _Pragma("unroll") for (int m = 0; m < 4; ++m) _Pragma("unroll") for (int k = 0; k < 2; ++k) dst[m][k] = *(const PG8_LAS bf16x8*)(lds + PG8_SA(b, h) + aoff + m * 2048 + k * 1024); } while (0)
#define PG8_LDB(dst, b, h) do { _Pragma("unroll") for (int n = 0; n < 2; ++n) _Pragma("unroll") for (int k = 0; k < 2; ++k) dst[n][k] = *(const PG8_LAS bf16x8*)(lds + PG8_SB(b, h) + boff + n * 2048 + k * 1024); } while (0)
#define PG8_MMA(ai, bj, At, Bt) do { __builtin_amdgcn_s_setprio(1); _Pragma("unroll") for (int m = 0; m < 4; ++m) _Pragma("unroll") for (int n = 0; n < 2; ++n) _Pragma("unroll") for (int k = 0; k < 2; ++k) \
        acc[ai][bj][m][n] = __builtin_amdgcn_mfma_f32_16x16x32_bf16(Bt[n][k], At[m][k], acc[ai][bj][m][n], 0, 0, 0); __builtin_amdgcn_s_setprio(0); } while (0)
#define PG8_WAIT_V(n) asm volatile("s_waitcnt vmcnt(" #n ")" ::: "memory")
#define PG8_WAIT_L(n) asm volatile("s_waitcnt lgkmcnt(" #n ")" ::: "memory")
#define PG8_BAR __builtin_amdgcn_s_barrier()
#define PG8_SCHED __builtin_amdgcn_sched_barrier(0)
    Unit cur, nxt; int ui = 0;
    if (!S.next(0, cur)) return;
    f32x4 acc[2][2][4][2];
#pragma unroll
    for (int a = 0; a < 2; ++a)
#pragma unroll
        for (int b = 0; b < 2; ++b)
#pragma unroll
            for (int m = 0; m < 4; ++m)
#pragma unroll
                for (int n = 0; n < 2; ++n) acc[a][b][m][n] = (f32x4){0.f, 0.f, 0.f, 0.f};
    bf16x8 At[4][2], B0[2][2], B1[2][2];
    const char* cA = (const char*)g.A + (size_t)cur.pm * tstep; const char* cB = (const char*)g.Bt + (size_t)cur.pn * (Epi::HALFB ? hstep : tstep);
    if constexpr (Epi::NSEG > 1) { cA += (size_t)Epi::seg_koff(cur.seg) * 2; cB += (size_t)Epi::seg_koff(cur.seg) * 2; nt = Epi::seg_nt(cur.seg); }
    S.a_ready(cur);
    if constexpr (SP2) {
        PG8_STAGE(PG8_SB(0, 0), cB, voffB); PG8_STAGE(PG8_SB(0, 1), cB + hstep, voffB); PG8_STAGE(PG8_SA(0, 0), cA, voffA); PG8_STAGE(PG8_SA(0, 1), cA + hstep, voffA);
        if (wr == 1) PG8_BAR;
        PG8_WAIT_V(2); PG8_BAR;
        PG8_STAGE(PG8_SB(1, 0), cB + kstep, voffB); PG8_STAGE(PG8_SA(1, 0), cA + kstep, voffA); PG8_STAGE(PG8_SB(1, 1), cB + hstep + kstep, voffB);
        PG8_WAIT_V(6); PG8_BAR;
    } else {
        PG8_STAGE(PG8_SB(0, 0), cB, voffB); PG8_STAGE(PG8_SA(0, 0), cA, voffA); PG8_STAGE(PG8_SB(0, 1), cB + hstep, voffB); PG8_STAGE(PG8_SA(0, 1), cA + hstep, voffA);
        if (wr == 1) PG8_BAR;
        PG8_WAIT_V(4); PG8_BAR;
        PG8_STAGE(PG8_SB(1, 0), cB + kstep, voffB); PG8_STAGE(PG8_SA(1, 0), cA + kstep, voffA); PG8_STAGE(PG8_SB(1, 1), cB + hstep + kstep, voffB);
        PG8_WAIT_V(6); PG8_BAR;
    }
    for (;;) {
        const bool has_next = S.next(ui + 1, nxt);
        const char* nA = has_next ? (const char*)g.A + (size_t)nxt.pm * tstep : cA; const char* nB = has_next ? (const char*)g.Bt + (size_t)nxt.pn * (Epi::HALFB ? hstep : tstep) : cB;
        if constexpr (Epi::NSEG > 1) { if (has_next) { nA += (size_t)Epi::seg_koff(nxt.seg) * 2; nB += (size_t)Epi::seg_koff(nxt.seg) * 2; } }
        for (int t = 0; t < nt; t += 2) {
            const bool last = (t == nt - 2);
            const char* a1 = cA + (size_t)(t + 1) * kstep;
            const char* a2 = last ? nA : cA + (size_t)(t + 2) * kstep; const char* b2 = last ? nB : cB + (size_t)(t + 2) * kstep;
            const char* a3 = a2 + kstep; const char* b3 = b2 + kstep;
            if (last && has_next) S.a_ready(nxt);
            if constexpr (SP2) {
            PG8_LDB(B0, 0, 0); if constexpr (!Epi::HALFB) PG8_LDB(B1, 0, 1); PG8_SCHED; PG8_LDA(At, 0, 0); PG8_STAGE(PG8_SA(1, 1), a1 + hstep, voffA);
            PG8_WAIT_V(8); PG8_WAIT_L(0); PG8_BAR; PG8_MMA(0, 0, At, B0); if constexpr (!Epi::HALFB) PG8_MMA(0, 1, At, B1); PG8_BAR; PG8_SCHED;
            PG8_LDA(At, 0, 1); PG8_STAGE(PG8_SB(0, 0), b2, voffB); PG8_STAGE(PG8_SB(0, 1), b2 + hstep, voffB); PG8_STAGE(PG8_SA(0, 0), a2, voffA);
            PG8_WAIT_V(8); PG8_WAIT_L(0); PG8_BAR; PG8_MMA(1, 0, At, B0); if constexpr (!Epi::HALFB) PG8_MMA(1, 1, At, B1); PG8_BAR; PG8_SCHED;
            PG8_LDB(B0, 1, 0); if constexpr (!Epi::HALFB) PG8_LDB(B1, 1, 1); PG8_SCHED; PG8_LDA(At, 1, 0); PG8_STAGE(PG8_SA(0, 1), a2 + hstep, voffA);
            PG8_WAIT_V(8); PG8_WAIT_L(0); PG8_BAR; PG8_MMA(0, 0, At, B0); if constexpr (!Epi::HALFB) PG8_MMA(0, 1, At, B1); PG8_BAR; PG8_SCHED;
            PG8_LDA(At, 1, 1); PG8_STAGE(PG8_SB(1, 0), b3, voffB); PG8_STAGE(PG8_SB(1, 1), b3 + hstep, voffB); PG8_STAGE(PG8_SA(1, 0), a3, voffA);
            PG8_WAIT_V(8); PG8_WAIT_L(0); PG8_BAR; PG8_MMA(1, 0, At, B0); if constexpr (!Epi::HALFB) PG8_MMA(1, 1, At, B1); PG8_BAR; PG8_SCHED;
            } else {
            PG8_LDB(B0, 0, 0); PG8_SCHED; PG8_LDA(At, 0, 0); PG8_STAGE(PG8_SA(1, 1), a1 + hstep, voffA);
            PG8_WAIT_L(8); PG8_BAR; PG8_WAIT_L(0); PG8_MMA(0, 0, At, B0); PG8_BAR; PG8_SCHED;
            PG8_LDB(B1, 0, 1); PG8_STAGE(PG8_SB(0, 0), b2, voffB);
            PG8_BAR; PG8_WAIT_L(0); PG8_MMA(0, 1, At, B1); PG8_BAR;
            PG8_LDA(At, 0, 1); PG8_STAGE(PG8_SA(0, 0), a2, voffA);
            PG8_BAR; PG8_WAIT_L(0); PG8_MMA(1, 0, At, B0); PG8_BAR; PG8_SCHED;
            PG8_STAGE(PG8_SB(0, 1), b2 + hstep, voffB);
            PG8_WAIT_V(6); PG8_BAR; PG8_MMA(1, 1, At, B1); PG8_BAR;
            PG8_LDB(B0, 1, 0); PG8_SCHED; PG8_LDA(At, 1, 0); PG8_STAGE(PG8_SA(0, 1), a2 + hstep, voffA);
            PG8_WAIT_L(8); PG8_BAR; PG8_WAIT_L(0); PG8_MMA(0, 0, At, B0); PG8_BAR; PG8_SCHED;
            PG8_LDB(B1, 1, 1); PG8_STAGE(PG8_SB(1, 0), b3, voffB);
            PG8_BAR; PG8_WAIT_L(0); PG8_MMA(0, 1, At, B1); PG8_BAR;
            PG8_LDA(At, 1, 1); PG8_STAGE(PG8_SA(1, 0), a3, voffA);
            PG8_BAR; PG8_WAIT_L(0); PG8_MMA(1, 0, At, B0); PG8_BAR; PG8_SCHED;
            PG8_STAGE(PG8_SB(1, 1), b3 + hstep, voffB);
            PG8_WAIT_V(6); PG8_BAR; PG8_MMA(1, 1, At, B1); PG8_BAR;
            }
        }
        if constexpr (ALIGN_EPI) { if (wr == 0) PG8_BAR; }
        bool lastseg = true; if constexpr (Epi::NSEG > 1) lastseg = (cur.seg == Epi::NSEG - 1);
        if constexpr (!Epi::AFTER_DRAIN) { if (lastseg) { E(acc, cur, wr, wc, fr, fq); S.done(cur); } else { if constexpr (Epi::NSEG > 1) E.seg(acc, cur, wr, wc, fr, fq); } }
        if (!has_next) break;
#pragma unroll
        for (int a = 0; a < 2; ++a)
#pragma unroll
            for (int b = 0; b < 2; ++b)
#pragma unroll
                for (int m = 0; m < 4; ++m)
#pragma unroll
                    for (int n = 0; n < 2; ++n) acc[a][b][m][n] = (f32x4){0.f, 0.f, 0.f, 0.f};
        cur = nxt; cA = nA; cB = nB; ++ui; if constexpr (Epi::NSEG > 1) nt = Epi::seg_nt(cur.seg);
        if constexpr (ALIGN_EPI) { if (wr == 1) PG8_BAR; }
    }
    PG8_WAIT_V(0);
    if constexpr (!ALIGN_EPI) { if (wr == 0) PG8_BAR; }
    PG8_BAR;
    if constexpr (Epi::AFTER_DRAIN) { E.fused(acc, cur, wr, wc, fr, fq, lds, wid, lane); S.done(cur); }
#undef PG8_SA
#undef PG8_SB
#undef PG8_STAGE
#undef PG8_LDA
#undef PG8_LDB
#undef PG8_MMA
#undef PG8_WAIT_V
#undef PG8_WAIT_L
#undef PG8_BAR
#undef PG8_SCHED
}
}

#define DI __device__ __forceinline__
#define LAS __attribute__((address_space(3)))
using pg8::bf16_t; using pg8::bf16x8; using pg8::f32x4; using pg8::u32x4; using pg8::Unit; using pg8::f32x2; using pg8::gelu_pk;
typedef __bf16 bf16x2_t __attribute__((ext_vector_type(2)));
__device__ __forceinline__ unsigned cvt_pk_bf16(float lo, float hi) { f32x2 v = {lo, hi}; bf16x2_t b = __builtin_convertvector(v, bf16x2_t); return __builtin_bit_cast(unsigned, b); }
typedef LAS unsigned char* lptr;
typedef unsigned u32x2 __attribute__((ext_vector_type(2)));
#define MFMA16(a, b, c) __builtin_amdgcn_mfma_f32_16x16x32_bf16((a), (b), (c), 0, 0, 0)

constexpr int T = 16384, TB = 8192, DM = 1024, FF = 2816;
constexpr float EPS = 1e-6f;
constexpr int ZUQ_LD = 3328, XBC_LD = 3072, NWIN = 7680, GATE_LD = 3072, KBR = 3328, WIN_LD = 10528;
constexpr float QSCALE = 0.125f * 1.4426950408889634f;
constexpr int PT = 272;
constexpr int LDS_BYTES = 155648;

constexpr size_t KiB = 1024, MiB = 1u << 20;
constexpr size_t WS_SS1 = 0, WS_SS2 = 64 * KiB, WS_SS3 = 128 * KiB, WS_SS4 = 192 * KiB, WS_SSV = 256 * KiB, WS_SSG = 320 * KiB  , WS_CDEC = 576 * KiB  ;
constexpr size_t WS_KMEM = 640 * KiB, WS_VMEMT = 896 * KiB, WS_DT = 2 * MiB;
constexpr size_t WS_BAR = 4 * MiB, BAR_BYTES = 65536, WS_PCNT = WS_BAR + 32768;
constexpr int LDS_BARST = LDS_BYTES - 64;
constexpr size_t WS_W2GU = 6 * MiB, WS_W2D = 17 * MiB, WS_WIN = 22 * MiB + 512 * KiB, WS_WG = 37 * MiB + 512 * KiB, WS_WBR = 43 * MiB + 512 * KiB, WS_WOUT = 50 * MiB;
constexpr size_t WS_HB = 52 * MiB, WS_MG = 84 * MiB, WS_W1GU = 116 * MiB, WS_W1D = 127 * MiB, WS_ACT = 132 * MiB + 512 * KiB;
constexpr size_t WS_ZUQ = 116 * MiB, WS_XBC = 168 * MiB, WS_ST = 216 * MiB, WS_END = 256 * MiB;
static_assert(WS_ACT + (size_t)T * FF * 2 <= WS_END && WS_ST + (size_t)64 * 32 * 8192 * 2 <= WS_END && WS_ZUQ + (size_t)TB * ZUQ_LD * 2 <= WS_XBC && WS_XBC + (size_t)TB * XBC_LD * 2 <= WS_ST, "ws map");

DI float bflo(unsigned w) { return __uint_as_float(w << 16); }
DI float bfhi(unsigned w) { return __uint_as_float(w & 0xffff0000u); }
DI float sigm(float x) { return __builtin_amdgcn_rcpf(1.f + __expf(-x)); }
DI float silu(float x) { return x * sigm(x); }
DI u32x4 pack8(f32x4 a, f32x4 b) { u32x4 w; w.x = cvt_pk_bf16(a[0], a[1]); w.y = cvt_pk_bf16(a[2], a[3]); w.z = cvt_pk_bf16(b[0], b[1]); w.w = cvt_pk_bf16(b[2], b[3]); return w; }
DI u32x2 pack4(f32x4 a) { u32x2 w; w.x = cvt_pk_bf16(a[0], a[1]); w.y = cvt_pk_bf16(a[2], a[3]); return w; }
DI f32x4 gelu4(f32x4 v) { f32x2 a = gelu_pk((f32x2){v[0], v[1]}), b = gelu_pk((f32x2){v[2], v[3]}); return (f32x4){a.x, a.y, b.x, b.y}; }
DI float rstd_of(float ss, float inv_n) { return __builtin_amdgcn_rsqf(ss * inv_n + EPS); }
DI float softplus(float v) { return v > 20.f ? v : log1pf(__expf(v)); }

struct EpiGLU {
    static constexpr bool PERM = true, AFTER_DRAIN = false; static constexpr int NSEG = 1; static constexpr bool HALFB = false;
    const float* ss; bf16_t* O;
    DI void operator()(const f32x4 (&acc)[2][2][4][2], const Unit& u, int wr, int wc, int fr, int fq) const {
        const int col = u.pn * 128 + wc * 32 + 8 * fq;
#pragma unroll
        for (int ai = 0; ai < 2; ++ai)
#pragma unroll
            for (int m = 0; m < 4; ++m) {
                const int row = u.pm * 256 + ai * 128 + wr * 64 + m * 16 + fr;
                const float r = rstd_of(ss[row], 1.f / 1024.f);
                f32x4 o[2];
#pragma unroll
                for (int n = 0; n < 2; ++n)
#pragma unroll
                    for (int e = 0; e < 4; ++e) o[n][e] = silu(acc[ai][0][m][n][e] * r) * (acc[ai][1][m][n][e] * r);
                *(u32x4*)(O + (size_t)row * FF + col) = pack8(o[0], o[1]);
            }
    }
};
template <bool RES_BF16> struct EpiRes {
    static constexpr bool PERM = true, AFTER_DRAIN = false, HALFB = false; static constexpr int NSEG = 1;
    const float* resid; const bf16_t* residb; bf16_t* hb; float* ssout; float alpha;
    DI void operator()(const f32x4 (&acc)[2][2][4][2], const Unit& u, int wr, int wc, int fr, int fq) const {
#pragma unroll
        for (int ai = 0; ai < 2; ++ai)
#pragma unroll
            for (int m = 0; m < 4; ++m) {
                const int row = u.pm * 256 + ai * 128 + wr * 64 + m * 16 + fr;
                float sq = 0.f;
#pragma unroll
                for (int bj = 0; bj < 2; ++bj) {
                    const size_t off = (size_t)row * DM + u.pn * 256 + bj * 128 + wc * 32 + 8 * fq;
                    f32x4 r0, r1;
                    if (RES_BF16) { const u32x4 rb = *(const u32x4*)(residb + off); r0 = (f32x4){bflo(rb[0]), bfhi(rb[0]), bflo(rb[1]), bfhi(rb[1])}; r1 = (f32x4){bflo(rb[2]), bfhi(rb[2]), bflo(rb[3]), bfhi(rb[3])}; }
                    else { r0 = __builtin_nontemporal_load((const f32x4*)(resid + off)); r1 = __builtin_nontemporal_load((const f32x4*)(resid + off + 4)); }
                    const f32x4 v0 = r0 + acc[ai][bj][m][0] * alpha, v1 = r1 + acc[ai][bj][m][1] * alpha;
                    *(u32x4*)(hb + off) = pack8(v0, v1);
                    sq += (v0[0] * v0[0] + v0[1] * v0[1]) + (v0[2] * v0[2] + v0[3] * v0[3]) + (v1[0] * v1[0] + v1[1] * v1[1]) + (v1[2] * v1[2] + v1[3] * v1[3]);
                }
                sq += __shfl_xor(sq, 16); sq += __shfl_xor(sq, 32);
                if (fq == 0) atomicAdd(ssout + row, sq);
            }
    }
};
struct EpiResNorm {
    static constexpr bool PERM = true, AFTER_DRAIN = false, HALFB = false; static constexpr int NSEG = 1;
    const bf16_t* residb; float* out; float* ss; unsigned* cnt; const float* gain; float alpha;
    DI void operator()(f32x4 (&acc)[2][2][4][2], const Unit& u, int wr, int wc, int fr, int fq) const {
#pragma unroll
        for (int ai = 0; ai < 2; ++ai)
#pragma unroll
            for (int m = 0; m < 4; ++m) {
                const int row = u.pm * 256 + ai * 128 + wr * 64 + m * 16 + fr;
                float sq = 0.f;
#pragma unroll
                for (int bj = 0; bj < 2; ++bj) {
                    const size_t off = (size_t)row * DM + u.pn * 256 + bj * 128 + wc * 32 + 8 * fq;
                    const u32x4 rb = __builtin_nontemporal_load((const u32x4*)(residb + off));
                    const f32x4 v0 = (f32x4){bflo(rb[0]), bfhi(rb[0]), bflo(rb[1]), bfhi(rb[1])} + acc[ai][bj][m][0] * alpha, v1 = (f32x4){bflo(rb[2]), bfhi(rb[2]), bflo(rb[3]), bfhi(rb[3])} + acc[ai][bj][m][1] * alpha;
                    acc[ai][bj][m][0] = v0; acc[ai][bj][m][1] = v1;
                    sq += (v0[0] * v0[0] + v0[1] * v0[1]) + (v0[2] * v0[2] + v0[3] * v0[3]) + (v1[0] * v1[0] + v1[1] * v1[1]) + (v1[2] * v1[2] + v1[3] * v1[3]);
                }
                sq += __shfl_xor(sq, 16); sq += __shfl_xor(sq, 32);
                if (fq == 0) atomicAdd(ss + row, sq);
            }
        asm volatile("s_waitcnt vmcnt(0)" ::: "memory");
        __syncthreads();
        if (threadIdx.x == 0) {
            unsigned* c = cnt + 64 * u.pm;
            (void)__hip_atomic_fetch_add(c, 1u, __ATOMIC_RELAXED, __HIP_MEMORY_SCOPE_AGENT);
            unsigned sp = 0;
            while (__hip_atomic_load(c, __ATOMIC_RELAXED, __HIP_MEMORY_SCOPE_AGENT) < 4u) { __builtin_amdgcn_s_sleep(1); if (++sp > (1u << 20)) break; }
        }
        __syncthreads();
#pragma unroll
        for (int ai = 0; ai < 2; ++ai)
#pragma unroll
            for (int m = 0; m < 4; ++m) {
                const int row = u.pm * 256 + ai * 128 + wr * 64 + m * 16 + fr;
                const float r = rstd_of(__hip_atomic_load(ss + row, __ATOMIC_RELAXED, __HIP_MEMORY_SCOPE_AGENT), 1.f / 1024.f);
#pragma unroll
                for (int bj = 0; bj < 2; ++bj) {
                    const int col = u.pn * 256 + bj * 128 + wc * 32 + 8 * fq;
                    const f32x4 g0 = *(const f32x4*)(gain + col), g1 = *(const f32x4*)(gain + col + 4);
                    __builtin_nontemporal_store(acc[ai][bj][m][0] * r * g0, (f32x4*)(out + (size_t)row * DM + col)); __builtin_nontemporal_store(acc[ai][bj][m][1] * r * g1, (f32x4*)(out + (size_t)row * DM + col + 4));
                }
            }
    }
};
struct EpiWin {
    static constexpr bool PERM = true, AFTER_DRAIN = false; static constexpr int NSEG = 1; static constexpr bool HALFB = false;
    int row_base; const float* ss; bf16_t* zuq; bf16_t* xbc; bf16_t* gv; float* dt; const float* dt_bias; float* ssv;
    template <int KIND> DI void body(const f32x4 (&acc)[2][2][4][2], const Unit& u, int wr, int wc, int fr, int fq) const {
        const int pn = u.pn, cw = wc * 32 + 8 * fq;
#pragma unroll
        for (int ai = 0; ai < 2; ++ai)
#pragma unroll
            for (int m = 0; m < 4; ++m) {
                const int lr = u.pm * 256 + ai * 128 + wr * 64 + m * 16 + fr, gr = row_base + lr;
                const float r = rstd_of(ss[gr], 1.f / 1024.f);
                if (KIND == 0) {
#pragma unroll
                    for (int bj = 0; bj < 2; ++bj) { f32x4 a, b;
#pragma unroll
                        for (int e = 0; e < 4; ++e) { a[e] = silu(acc[ai][bj][m][0][e] * r); b[e] = silu(acc[ai][bj][m][1][e] * r); }
                        *(u32x4*)(zuq + (size_t)lr * ZUQ_LD + pn * 256 + bj * 128 + cw) = pack8(a, b); }
                } else if (KIND == 1) {
#pragma unroll
                    for (int bj = 0; bj < 2; ++bj) { f32x4 a = gelu4(acc[ai][bj][m][0] * r), b = gelu4(acc[ai][bj][m][1] * r);
                        *(u32x4*)(zuq + (size_t)lr * ZUQ_LD + pn * 256 + bj * 128 + cw) = pack8(a, b); }
                } else if (KIND == 2) {
#pragma unroll
                    for (int bj = 0; bj < 2; ++bj) { f32x4 a = acc[ai][bj][m][0] * (r * QSCALE), b = acc[ai][bj][m][1] * (r * QSCALE);
                        *(u32x4*)(zuq + (size_t)lr * ZUQ_LD + pn * 256 + bj * 128 + cw) = pack8(a, b); }
                } else if (KIND == 3) {
#pragma unroll
                    for (int bj = 0; bj < 2; ++bj) { f32x4 a = acc[ai][bj][m][0] * r, b = acc[ai][bj][m][1] * r;
                        *(u32x4*)(xbc + (size_t)lr * XBC_LD + (pn - 13) * 256 + bj * 128 + cw) = pack8(a, b); }
                } else if (KIND == 4) {
                    float sq = 0.f;
#pragma unroll
                    for (int bj = 0; bj < 2; ++bj) { f32x4 a = gelu4(acc[ai][bj][m][0] * r), b = gelu4(acc[ai][bj][m][1] * r);
                        sq += (a[0] * a[0] + a[1] * a[1]) + (a[2] * a[2] + a[3] * a[3]) + (b[0] * b[0] + b[1] * b[1]) + (b[2] * b[2] + b[3] * b[3]);
                        *(u32x4*)(gv + (size_t)lr * DM + (pn - 25) * 256 + bj * 128 + cw) = pack8(a, b); }
                    sq += __shfl_xor(sq, 16); sq += __shfl_xor(sq, 32);
                    if (fq == 0) atomicAdd(ssv + gr, sq);
                } else {
                    if (wc == 0) {
#pragma unroll
                        for (int n = 0; n < 2; ++n) { f32x4 o;
#pragma unroll
                            for (int e = 0; e < 4; ++e) o[e] = softplus(acc[ai][0][m][n][e] * r + dt_bias[8 * fq + 4 * n + e]);
                            *(f32x4*)(dt + (size_t)gr * 32 + 8 * fq + 4 * n) = o; }
                    }
                }
            }
    }
    DI void operator()(const f32x4 (&acc)[2][2][4][2], const Unit& u, int wr, int wc, int fr, int fq) const {
        const int pn = u.pn;
        if (pn < 8) body<0>(acc, u, wr, wc, fr, fq); else if (pn < 12) body<1>(acc, u, wr, wc, fr, fq); else if (pn == 12) body<2>(acc, u, wr, wc, fr, fq);
        else if (pn < 25) body<3>(acc, u, wr, wc, fr, fq); else if (pn < 29) body<4>(acc, u, wr, wc, fr, fq); else body<5>(acc, u, wr, wc, fr, fq);
    }
};
struct EpiGates {
    static constexpr bool PERM = true, AFTER_DRAIN = false; static constexpr int NSEG = 1; static constexpr bool HALFB = false;
    int row_base; const float* ss; bf16_t* O;
    DI void operator()(const f32x4 (&acc)[2][2][4][2], const Unit& u, int wr, int wc, int fr, int fq) const {
#pragma unroll
        for (int ai = 0; ai < 2; ++ai)
#pragma unroll
            for (int m = 0; m < 4; ++m) {
                const int lr = u.pm * 256 + ai * 128 + wr * 64 + m * 16 + fr;
                const float r = rstd_of(ss[row_base + lr], 1.f / 1024.f);
#pragma unroll
                for (int bj = 0; bj < 2; ++bj) { f32x4 a, b;
#pragma unroll
                    for (int e = 0; e < 4; ++e) { a[e] = sigm(acc[ai][bj][m][0][e] * r); b[e] = sigm(acc[ai][bj][m][1][e] * r); }
                    *(u32x4*)(O + (size_t)lr * GATE_LD + u.pn * 256 + bj * 128 + wc * 32 + 8 * fq) = pack8(a, b); }
            }
    }
};
struct EpiMerge {
    static constexpr bool PERM = true, AFTER_DRAIN = false, HALFB = true; static constexpr int NSEG = 3;
    const bf16_t* gates; bf16_t* run; bf16_t* O;
    static DI int seg_koff(int s) { return s == 0 ? 0 : (s == 1 ? 2048 : 3072); }
    static DI int seg_nt(int s) { return s == 0 ? 32 : (s == 1 ? 16 : 4); }
    DI void seg(const f32x4 (&acc)[2][2][4][2], const Unit& u, int wr, int wc, int fr, int fq) const {
        const int row0 = u.pm * 256 + wr * 64 + fr, cw = u.pn * 128 + wc * 32 + 8 * fq, s = u.seg;
#pragma unroll
        for (int ai = 0; ai < 2; ++ai)
#pragma unroll
            for (int m = 0; m < 4; ++m) {
                const int row = row0 + ai * 128 + m * 16;
                const u32x4 G = *(const u32x4*)(gates + (size_t)row * GATE_LD + s * 1024 + cw);
                bf16_t* rp = run + (size_t)row * DM + cw;
                f32x4 a = (f32x4){0.f, 0.f, 0.f, 0.f}, b = a;
                if (s > 0) { const u32x4 rv = *(const u32x4*)rp; a = (f32x4){bflo(rv[0]), bfhi(rv[0]), bflo(rv[1]), bfhi(rv[1])}; b = (f32x4){bflo(rv[2]), bfhi(rv[2]), bflo(rv[3]), bfhi(rv[3])}; }
                a[0] += acc[ai][0][m][0][0] * bflo(G[0]); a[1] += acc[ai][0][m][0][1] * bfhi(G[0]); a[2] += acc[ai][0][m][0][2] * bflo(G[1]); a[3] += acc[ai][0][m][0][3] * bfhi(G[1]);
                b[0] += acc[ai][0][m][1][0] * bflo(G[2]); b[1] += acc[ai][0][m][1][1] * bfhi(G[2]); b[2] += acc[ai][0][m][1][2] * bflo(G[3]); b[3] += acc[ai][0][m][1][3] * bfhi(G[3]);
                *(u32x4*)rp = pack8(a, b);
            }
    }
    DI void operator()(const f32x4 (&acc)[2][2][4][2], const Unit& u, int wr, int wc, int fr, int fq) const {
        const int row0 = u.pm * 256 + wr * 64 + fr, cw = u.pn * 128 + wc * 32 + 8 * fq;
#pragma unroll
        for (int ai = 0; ai < 2; ++ai)
#pragma unroll
            for (int m = 0; m < 4; ++m) {
                const int row = row0 + ai * 128 + m * 16;
                const u32x4 G = *(const u32x4*)(gates + (size_t)row * GATE_LD + 2048 + cw);
                const u32x4 rv = *(const u32x4*)(run + (size_t)row * DM + cw);
                f32x4 a = (f32x4){bflo(rv[0]), bfhi(rv[0]), bflo(rv[1]), bfhi(rv[1])}, b = (f32x4){bflo(rv[2]), bfhi(rv[2]), bflo(rv[3]), bfhi(rv[3])};
                a[0] += acc[ai][0][m][0][0] * bflo(G[0]); a[1] += acc[ai][0][m][0][1] * bfhi(G[0]); a[2] += acc[ai][0][m][0][2] * bflo(G[1]); a[3] += acc[ai][0][m][0][3] * bfhi(G[1]);
                b[0] += acc[ai][0][m][1][0] * bflo(G[2]); b[1] += acc[ai][0][m][1][1] * bfhi(G[2]); b[2] += acc[ai][0][m][1][2] * bflo(G[3]); b[3] += acc[ai][0][m][1][3] * bfhi(G[3]);
                *(u32x4*)(O + (size_t)row * DM + cw) = pack8(a, b);
            }
    }
};

struct Frame {
    lptr lds; unsigned char* ws; const float* const* in; float* out;
    int tid, lane, wave, G, bid;
};
struct Args { const float* in[28]; float* out; unsigned char* ws; int ph_lo, ph_hi; };
enum { I_X = 0, I_MEM, I_F1N, I_F1G, I_F1U, I_F1D, I_MIXN, I_MEMN, I_WIN, I_CONVW, I_CONVB, I_DTB, I_ALOG, I_SSDD, I_SSDN, I_GVN, I_GWS, I_GBS, I_WKV, I_WBS, I_WBG, I_WBM, I_WOUT, I_F2N, I_F2G, I_F2U, I_F2D, I_FINN };

#define LDS_WAIT() asm volatile("s_waitcnt lgkmcnt(0)" ::: "memory")

#define XB_TMO      128
#define XB_XCNT(j)  (256  + 64 * (j))
#define XB_XSUB(j)  (1280 + 64 * (j))
#define XB_XGEN(j)  (2304 + 64 * (j))
#define XB_TOP      3328
#define XB_TOPGEN   3392
#define XCD_BAR_WORDS 3456
#define XB_SPIN_CAP (1u << 18)

__device__ __forceinline__ unsigned xb_ld(unsigned* p)              { return __hip_atomic_load(p, __ATOMIC_RELAXED, __HIP_MEMORY_SCOPE_AGENT); }
__device__ __forceinline__ unsigned xb_add(unsigned* p, unsigned v) { return __hip_atomic_fetch_add(p, v, __ATOMIC_RELAXED, __HIP_MEMORY_SCOPE_AGENT); }
__device__ __forceinline__ unsigned xb_xcc_id() { return (unsigned)__builtin_amdgcn_s_getreg((3 << 11) | 20) & 0xFu; }
#define XB_SPIN(cond, bar) do { unsigned _sp = 0; while (cond) { __builtin_amdgcn_s_sleep(1); \
    if ((++_sp & 255u) == 0u) { if (xb_ld(&(bar)[XB_TMO])) break; if (_sp > XB_SPIN_CAP) { atomicAdd(&(bar)[XB_TMO], 1u); break; } } } } while (0)

struct XcdBarrier {
    unsigned* bar; unsigned x;
    volatile LAS unsigned* st;
};

__device__ __forceinline__ XcdBarrier xcd_barrier_post(unsigned* bar, volatile LAS unsigned* st) {
    XcdBarrier b; b.bar = bar; b.x = xb_xcc_id(); b.st = st;
    if (threadIdx.x == 0) (void)xb_add(&bar[XB_XCNT(b.x)], 1u);
    return b;
}
__device__ __forceinline__ void xcd_barrier_complete(unsigned* bar, unsigned x, unsigned& nloc, unsigned& nx) {
    const unsigned G = gridDim.x * gridDim.y * gridDim.z;
    unsigned sum, cnt, mine, sp = 0u;
    for (;;) {
        sum = 0u; cnt = 0u; mine = 0u;
#pragma unroll
        for (unsigned j = 0; j < 16; ++j) { const unsigned c = xb_ld(&bar[XB_XCNT(j)]); sum += c; cnt += (c > 0u) ? 1u : 0u; mine = (j == x) ? c : mine; }
        if (sum == G) break;
        __builtin_amdgcn_s_sleep(1);
        if ((++sp & 255u) == 0u) { if (xb_ld(&bar[XB_TMO])) break; if (sp > XB_SPIN_CAP) { atomicAdd(&bar[XB_TMO], 1u); break; } }
    }
    nloc = mine > 0u ? mine : 1u; nx = cnt > 0u ? cnt : 1u;
}

__device__ __forceinline__ void xcd_barrier(const XcdBarrier& b) {
    asm volatile("s_waitcnt vmcnt(0)" ::: "memory");
    __syncthreads();
    if (threadIdx.x == 0) {
        unsigned* bar = b.bar;
        __builtin_amdgcn_s_waitcnt(0);
        unsigned nloc = b.st[0], nx = b.st[1];
        if (nloc == 0u) { xcd_barrier_complete(bar, b.x, nloc, nx); b.st[0] = nloc; b.st[1] = nx; }
        const unsigned old = xb_add(&bar[XB_XSUB(b.x)], 1u);
        const unsigned gen = old / nloc;
        if (old + 1u == (gen + 1u) * nloc) {
            __builtin_amdgcn_fence(__ATOMIC_RELEASE, "agent");
            asm volatile("s_waitcnt vmcnt(0)" ::: "memory");
            const unsigned og = xb_add(&bar[XB_TOP], 1u);
            const unsigned tg = og / nx;
            if (og + 1u == (tg + 1u) * nx) xb_add(&bar[XB_TOPGEN], 1u);
            else XB_SPIN(xb_ld(&bar[XB_TOPGEN]) == tg, bar);
            __builtin_amdgcn_fence(__ATOMIC_ACQUIRE, "agent");
            xb_add(&bar[XB_XGEN(b.x)], 1u);
            asm volatile("s_waitcnt vmcnt(0)" ::: "memory");
        } else {
            XB_SPIN(xb_ld(&bar[XB_XGEN(b.x)]) == gen, bar);
            __builtin_amdgcn_fence(__ATOMIC_ACQUIRE, "agent");
            asm volatile("s_waitcnt vmcnt(0)" ::: "memory");
        }
    }
    __syncthreads();
}


DI void tr_item(const float* W, int ldw, int col0, bf16_t* WT, int ldt, int dcol0, int drow0, const float* gain, LAS float* scr, int kb, int lane) {
    const int k0 = 64 * kb;
    float tv[32];
    const float* wp = W + (size_t)(k0 + (lane >> 5)) * ldw + col0 + (lane & 31);
#pragma unroll
    for (int i = 0; i < 32; ++i) tv[i] = __builtin_nontemporal_load(wp + (size_t)(2 * i) * ldw);
    if (gain) {
#pragma unroll
        for (int i = 0; i < 32; ++i) tv[i] *= gain[k0 + 2 * i + (lane >> 5)];
    }
#pragma unroll
    for (int i = 0; i < 32; ++i) scr[(2 * i + (lane >> 5)) * 33 + (lane & 31)] = tv[i];
    LDS_WAIT();
    const int c = lane & 7;
#pragma unroll
    for (int j = 0; j < 4; ++j) { const int n = (lane >> 3) + 8 * j; const LAS float* s = scr + (8 * c) * 33 + n;
        u32x4 o; o.x = cvt_pk_bf16(s[0 * 33], s[1 * 33]); o.y = cvt_pk_bf16(s[2 * 33], s[3 * 33]); o.z = cvt_pk_bf16(s[4 * 33], s[5 * 33]); o.w = cvt_pk_bf16(s[6 * 33], s[7 * 33]);
        *(u32x4*)(WT + (size_t)(drow0 + n) * ldt + dcol0 + k0 + 8 * c) = o; }
    LDS_WAIT();
}
DI void kv_item(const Frame& F, int item) {
    const int rt = item >> 3, ct = item & 7, r0 = rt * 64, c0 = ct * 64, tid = F.tid, lane = F.lane, w = F.wave, fr = lane & 15, fq = lane >> 4;
    lptr As = F.lds, Bs = F.lds + 64 * PT; LAS float* rs = (LAS float*)(F.lds + 128 * PT);
    const float* mem = F.in[I_MEM]; const float* W = F.in[I_WKV]; const float* gain = F.in[I_MEMN];
    bf16_t* Kmem = (bf16_t*)(F.ws + WS_KMEM); bf16_t* VmemT = (bf16_t*)(F.ws + WS_VMEMT);
    const int ar = tid >> 3, ka = (tid & 7) * 16;
    const int kb = tid >> 2, nb = (tid & 3) * 16;
    const float* pa = mem + (size_t)(r0 + ar) * 1024 + ka; const float* pb = W + (size_t)kb * 512 + c0 + nb;
    float sq = 0.f;
    f32x4 acc[2]; acc[0] = (f32x4){0.f, 0.f, 0.f, 0.f}; acc[1] = acc[0];
    const bool ktype = ct < 4;
    f32x4 va[4], vb[4]; float gk;
#pragma unroll
    for (int i = 0; i < 4; ++i) { va[i] = *(const f32x4*)(pa + 4 * i); vb[i] = *(const f32x4*)(pb + 4 * i); }
    gk = gain[kb];
    for (int kc = 0; kc < 8; ++kc) {
#pragma unroll
        for (int i = 0; i < 4; ++i) sq += (va[i][0] * va[i][0] + va[i][1] * va[i][1]) + (va[i][2] * va[i][2] + va[i][3] * va[i][3]);
        *(LAS u32x4*)(As + ar * PT + ka * 2) = pack8(va[0], va[1]); *(LAS u32x4*)(As + ar * PT + ka * 2 + 16) = pack8(va[2], va[3]);
#pragma unroll
        for (int i = 0; i < 4; ++i) { const u32x2 pk = pack4(vb[i] * gk);
            *(LAS unsigned short*)(Bs + (nb + 4 * i + 0) * PT + kb * 2) = (unsigned short)(pk[0] & 0xffffu); *(LAS unsigned short*)(Bs + (nb + 4 * i + 1) * PT + kb * 2) = (unsigned short)(pk[0] >> 16);
            *(LAS unsigned short*)(Bs + (nb + 4 * i + 2) * PT + kb * 2) = (unsigned short)(pk[1] & 0xffffu); *(LAS unsigned short*)(Bs + (nb + 4 * i + 3) * PT + kb * 2) = (unsigned short)(pk[1] >> 16); }
        if (kc < 7) {
#pragma unroll
            for (int i = 0; i < 4; ++i) { va[i] = *(const f32x4*)(pa + (kc + 1) * 128 + 4 * i); vb[i] = *(const f32x4*)(pb + (size_t)(kc + 1) * 128 * 512 + 4 * i); }
            gk = gain[(kc + 1) * 128 + kb];
        }
        __syncthreads();
#pragma unroll
        for (int ks = 0; ks < 4; ++ks) {
            if (ktype) { const bf16x8 yf = *(const LAS bf16x8*)(As + (16 * (w >> 1) + fr) * PT + ks * 64 + fq * 16);
#pragma unroll
                for (int i = 0; i < 2; ++i) { const bf16x8 xf = *(const LAS bf16x8*)(Bs + (16 * ((w & 1) * 2 + i) + fr) * PT + ks * 64 + fq * 16); acc[i] = MFMA16(xf, yf, acc[i]); } }
            else { const bf16x8 yf = *(const LAS bf16x8*)(Bs + (16 * (w >> 1) + fr) * PT + ks * 64 + fq * 16);
#pragma unroll
                for (int i = 0; i < 2; ++i) { const bf16x8 xf = *(const LAS bf16x8*)(As + (16 * ((w & 1) * 2 + i) + fr) * PT + ks * 64 + fq * 16); acc[i] = MFMA16(xf, yf, acc[i]); } }
        }
        __syncthreads();
    }
    sq += __shfl_xor(sq, 1); sq += __shfl_xor(sq, 2); sq += __shfl_xor(sq, 4);
    if ((tid & 7) == 0) rs[ar] = rstd_of(sq, 1.f / 1024.f);
    __syncthreads();
    if (ktype) { const int tok = 16 * (w >> 1) + fr; const float r = rs[tok];
#pragma unroll
        for (int i = 0; i < 2; ++i) { const int ch = c0 + 16 * ((w & 1) * 2 + i) + 4 * fq; *(u32x2*)(Kmem + (size_t)(r0 + tok) * 256 + ch) = pack4(acc[i] * r); } }
    else { const int ch = c0 - 256 + 16 * (w >> 1) + fr;
#pragma unroll
        for (int i = 0; i < 2; ++i) { const int tok = 16 * ((w & 1) * 2 + i) + 4 * fq; f32x4 o;
#pragma unroll
            for (int e = 0; e < 4; ++e) o[e] = acc[i][e] * rs[tok + e];
            const int row = r0 + tok; *(u32x2*)(VmemT + (size_t)((row >> 8) * 256 + ch) * 256 + (row & 255)) = pack4(o); } }
    __syncthreads();
}
DI float wave_sum(float v) {
#pragma unroll
    for (int o = 1; o < 64; o <<= 1) v += __shfl_xor(v, o);
    return v;
}
#define SEG(Wp, ldw, c0, nc, Kk, WTp, ldt, dc0, gn, MAP) { const int nblk = (nc) / 32, cnt = ((Kk) / 64) * nblk; if (r < cnt) { const int kb = r / nblk, n0 = (r % nblk) * 32; \
        tr_item(Wp, ldw, (c0) + n0, WTp, ldt, dc0, (MAP), gn, scr, kb, lane); continue; } r -= cnt; }
DI void prologue(const Frame& F) {
    unsigned char* ws = F.ws;
    { u32x4* z = (u32x4*)(ws + WS_SS2); const int n = (int)((WS_CDEC - WS_SS2) / 16); for (int i = F.bid * 512 + F.tid; i < n; i += F.G * 512) z[i] = (u32x4){0u, 0u, 0u, 0u}; }
    LAS float* scr = (LAS float*)(F.lds + F.wave * 16384);
    const int gw = F.bid * 8 + F.wave, NGW = F.G * 8, lane = F.lane;
    bf16_t* W1GU = (bf16_t*)(ws + WS_W1GU);
    bf16_t* W1D = (bf16_t*)(ws + WS_W1D); bf16_t* WIN = (bf16_t*)(ws + WS_WIN);
    constexpr int NITEMS = 3 * 1408 + 16 * ((2048 + 1024 + 256 + 3072) / 32);
    for (int it = gw; it < NITEMS; it += NGW) {
        int r = it;
        SEG(F.in[I_F1G], FF, 0, FF, 1024, W1GU, 1024, 0, F.in[I_F1N], (n0 / 128) * 256 + (n0 % 128))
        SEG(F.in[I_F1U], FF, 0, FF, 1024, W1GU, 1024, 0, F.in[I_F1N], (n0 / 128) * 256 + 128 + (n0 % 128))
        SEG(F.in[I_F1D], 1024, 0, 1024, FF, W1D, FF, 0, (const float*)nullptr, n0)
        SEG(F.in[I_WIN], WIN_LD, 0, 2048, 1024, WIN, 1024, 0, F.in[I_MIXN], n0)
        SEG(F.in[I_WIN], WIN_LD, 5152, 1024, 1024, WIN, 1024, 0, F.in[I_MIXN], 2048 + n0)
        SEG(F.in[I_WIN], WIN_LD, 7200, 256, 1024, WIN, 1024, 0, F.in[I_MIXN], 3072 + n0)
        SEG(F.in[I_WIN], WIN_LD, 2048, 3072, 1024, WIN, 1024, 0, F.in[I_MIXN], 3328 + n0)
    }
    const float* x = F.in[I_X]; bf16_t* hb = (bf16_t*)(ws + WS_HB); float* ss1 = (float*)(ws + WS_SS1);
    for (int m = 4 * gw; m < T; m += 4 * NGW) {
        const f32x4* xr = (const f32x4*)(x + (size_t)m * DM) + lane; f32x4 v[16]; float s[4];
#pragma unroll
        for (int j = 0; j < 16; ++j) v[j] = __builtin_nontemporal_load(xr + 64 * j);
#pragma unroll
        for (int r = 0; r < 4; ++r) { s[r] = 0.f;
#pragma unroll
            for (int j = 0; j < 4; ++j) { const f32x4 t = v[4 * r + j]; s[r] += (t[0] * t[0] + t[1] * t[1]) + (t[2] * t[2] + t[3] * t[3]); }
            s[r] = wave_sum(s[r]); }
        if (lane == 0) { ss1[m] = s[0]; ss1[m + 1] = s[1]; ss1[m + 2] = s[2]; ss1[m + 3] = s[3]; }
        u32x2* o = (u32x2*)(hb + (size_t)m * DM) + lane;
#pragma unroll
        for (int j = 0; j < 16; ++j) o[64 * j] = pack4(v[j]);
    }
}
DI void mid_convert(const Frame& F, int first_blk) {
    unsigned char* ws = F.ws;
    if (F.bid - first_blk < 64) kv_item(F, F.bid - first_blk);
    LAS float* scr = (LAS float*)(F.lds + F.wave * 16384); const int lane = F.lane;
    const int gw = (F.bid - first_blk) * 8 + F.wave, NGW = (F.G - first_blk) * 8;
    bf16_t* W1D = (bf16_t*)(ws + WS_W1D); bf16_t* WIN = (bf16_t*)(ws + WS_WIN); bf16_t* WG = (bf16_t*)(ws + WS_WG); bf16_t* WBR = (bf16_t*)(ws + WS_WBR);
    constexpr int NITEMS = 16 * ((1024 + 32) / 32) + 16 * 96 + (32 + 16 + 4) * 32;
    for (int it = gw; it < NITEMS; it += NGW) {
        int r = it;
        SEG(F.in[I_WIN], WIN_LD, 6176, 1024, 1024, WIN, 1024, 0, F.in[I_MIXN], 6400 + n0)
        SEG(F.in[I_WIN], WIN_LD, 5120, 32, 1024, WIN, 1024, 0, F.in[I_MIXN], 7424 + n0)
        SEG(F.in[I_WIN], WIN_LD, 7456, 3072, 1024, WG, 1024, 0, F.in[I_MIXN], n0)
        SEG(F.in[I_WBS], 1024, 0, 1024, 2048, WBR, KBR, 0, F.in[I_SSDN], n0)
        SEG(F.in[I_WBG], 1024, 0, 1024, 1024, WBR, KBR, 2048, (const float*)nullptr, n0)
        SEG(F.in[I_WBM], 1024, 0, 1024, 256, WBR, KBR, 3072, (const float*)nullptr, n0)
    }
}
DI void late_convert(const Frame& F, int first_blk) {
    unsigned char* ws = F.ws; LAS float* scr = (LAS float*)(F.lds + F.wave * 16384); const int lane = F.lane;
    const int gw = (F.bid - first_blk) * 8 + F.wave, NGW = (F.G - first_blk) * 8;
    bf16_t* W2GU = (bf16_t*)(ws + WS_W2GU); bf16_t* W2D = (bf16_t*)(ws + WS_W2D); bf16_t* WOUT = (bf16_t*)(ws + WS_WOUT);
    constexpr int NITEMS = (3 * 1408) + 512;
    for (int it = gw; it < NITEMS; it += NGW) {
        int r = it;
        SEG(F.in[I_F2G], FF, 0, FF, 1024, W2GU, 1024, 0, F.in[I_F2N], (n0 / 128) * 256 + (n0 % 128))
        SEG(F.in[I_F2U], FF, 0, FF, 1024, W2GU, 1024, 0, F.in[I_F2N], (n0 / 128) * 256 + 128 + (n0 % 128))
        SEG(F.in[I_F2D], 1024, 0, 1024, FF, W2D, FF, 0, (const float*)nullptr, n0)
        SEG(F.in[I_WOUT], 1024, 0, 1024, 1024, WOUT, 1024, 0, (const float*)nullptr, n0)
    }
}
DI void final_norm(const Frame& F) {
    const float* ss4 = (const float*)(F.ws + WS_SS4); const float* g = F.in[I_FINN];
    const int gw = F.bid * 8 + F.wave, NGW = F.G * 8, lane = F.lane;
    f32x4 gv[4];
#pragma unroll
    for (int j = 0; j < 4; ++j) gv[j] = ((const f32x4*)g)[lane + 64 * j];
    for (int m = gw; m < T; m += NGW) {
        f32x4* xr = (f32x4*)(F.out + (size_t)m * DM) + lane; const float r = rstd_of(ss4[m], 1.f / 1024.f);
#pragma unroll
        for (int j = 0; j < 4; ++j) xr[64 * j] = xr[64 * j] * r * gv[j];
    }
}

DI void ssd_scan_prep(const Frame& F, float d, int h0, LAS float* acs, LAS float* dts, LAS float* wtot) {
    const int hl = F.tid >> 7, l = F.tid & 127, h = h0 + hl;
    const float a = -__expf(F.in[I_ALOG][h]);
    float v = d * a;
#pragma unroll
    for (int o = 1; o < 64; o <<= 1) { const float t = __shfl_up(v, o); if (F.lane >= o) v += t; }
    if (F.lane == 63) wtot[F.wave] = v;
    __syncthreads();
    if (F.wave & 1) v += wtot[F.wave - 1];
    acs[hl * 128 + l] = v; dts[hl * 128 + l] = d;
    __syncthreads();
}
template <bool SCALED, int NCH> DI void stage_conv_T(lptr dst, const bf16_t* xbc, int t0, int chan0, const float* cw, const float* cb, const LAS float* scale, int tid) {
    constexpr int ncp = NCH >> 1, ntask = ncp * 16;
    static_assert(512 % ncp == 0, "a thread keeps its channel pair across tasks");
    const int cp = tid % ncp, ch = chan0 + 2 * cp;
    f32x2 w[4];
#pragma unroll
    for (int k = 0; k < 4; ++k) w[k] = *(const f32x2*)(cw + k * XBC_LD + ch);
    const f32x2 bias = *(const f32x2*)(cb + ch);
#pragma unroll 2
    for (int it_ = 0; it_ < ntask / 512; ++it_) { const int task = tid + 512 * it_;
        const int tb = task / ncp, l0 = tb * 8;
        f32x2 r[11];
#pragma unroll
        for (int i = 0; i < 11; ++i) { const int l = l0 - 3 + i; unsigned v = 0u; if (t0 + l >= 0) v = *(const unsigned*)(xbc + (long)(t0 + l) * XBC_LD + ch); r[i] = (f32x2){bflo(v), bfhi(v)}; }
        f32x4 o0[2], o1[2];
#pragma unroll
        for (int j = 0; j < 8; ++j) {
            f32x2 y = bias + w[0] * r[j] + w[1] * r[j + 1] + w[2] * r[j + 2] + w[3] * r[j + 3];
            f32x2 en = y * -1.4426950408889634f; en.x = __builtin_amdgcn_exp2f(en.x); en.y = __builtin_amdgcn_exp2f(en.y);
            f32x2 d = en + 1.0f; d.x = __builtin_amdgcn_rcpf(d.x); d.y = __builtin_amdgcn_rcpf(d.y);
            y = y * d;
            if (SCALED) { const float s = scale[((2 * cp) >> 6) * 128 + l0 + j]; y = y * s; }
            o0[j >> 2][j & 3] = y.x; o1[j >> 2][j & 3] = y.y;
        }
        *(LAS u32x4*)(dst + (2 * cp) * PT + l0 * 2) = pack8(o0[0], o0[1]);
        *(LAS u32x4*)(dst + (2 * cp + 1) * PT + l0 * 2) = pack8(o1[0], o1[1]);
    }
}
DI void stage_conv_N(lptr dst, const bf16_t* xbc, int t0, int chan0, const float* cw, const float* cb, int tid) {
    const int cg8 = (tid & 15) * 8, ch = chan0 + cg8;
    float w[4][8], b[8];
#pragma unroll
    for (int k = 0; k < 4; ++k) { const f32x4 a = *(const f32x4*)(cw + k * XBC_LD + ch), c = *(const f32x4*)(cw + k * XBC_LD + ch + 4);
#pragma unroll
        for (int e = 0; e < 4; ++e) { w[k][e] = a[e]; w[k][4 + e] = c[e]; } }
    { const f32x4 a = *(const f32x4*)(cb + ch), c = *(const f32x4*)(cb + ch + 4);
#pragma unroll
        for (int e = 0; e < 4; ++e) { b[e] = a[e]; b[4 + e] = c[e]; } }
#pragma unroll
    for (int i = 0; i < 4; ++i) {
        const int l = (tid >> 4) + 32 * i;
        float y[8];
#pragma unroll
        for (int e = 0; e < 8; ++e) y[e] = b[e];
#pragma unroll
        for (int k = 0; k < 4; ++k) { const int t = t0 + l - 3 + k; u32x4 v = (u32x4){0u, 0u, 0u, 0u}; if (t >= 0) v = *(const u32x4*)(xbc + (long)t * XBC_LD + ch);
#pragma unroll
            for (int q = 0; q < 4; ++q) { y[2 * q] += w[k][2 * q] * bflo(v[q]); y[2 * q + 1] += w[k][2 * q + 1] * bfhi(v[q]); } }
        f32x4 o0, o1;
#pragma unroll
        for (int e = 0; e < 4; ++e) { o0[e] = silu(y[e]); o1[e] = silu(y[4 + e]); }
        *(LAS u32x4*)(dst + l * PT + cg8 * 2) = pack8(o0, o1);
    }
}
struct Half { int b; bf16_t* zuq; bf16_t* xbc; bf16_t* gv; bf16_t* st; float* cdec; const float* dt; int row_base; };

#ifdef SPROBE
#define SECT(k) do { if (F.bid == 0 && threadIdx.x == 0) { volatile LAS unsigned long long* sp_ = (volatile LAS unsigned long long*)(F.lds + LDS_BYTES - 32); unsigned long long t_ = __builtin_amdgcn_s_memrealtime(); \
        if ((k) == SPROBE) { const unsigned long long d_ = (t_ - sp_[0]) * SPROBE_MULT; while (__builtin_amdgcn_s_memrealtime() - t_ < d_) __builtin_amdgcn_s_sleep(8); t_ = __builtin_amdgcn_s_memrealtime(); } sp_[0] = t_; } } while (0)
#else
#define SECT(k) do { } while (0)
#endif
DI void ssd_a_item(const Frame& F, const Half& H, int item) {
    const int c = item >> 3, g = (item >> 1) & 3, hh = item & 1, h0 = g * 8 + hh * 4, t0 = c * 128;
    lptr XT = F.lds, BT = F.lds + 69632; LAS float* acs = (LAS float*)(F.lds + 139264); LAS float* dts = acs + 512; LAS float* sc = dts + 512; LAS float* wtot = sc + 512;
    SECT(10);
    const float dpre = H.dt[(size_t)(H.row_base + t0 + (F.tid & 127)) * 32 + h0 + (F.tid >> 7)];
    stage_conv_T<false, 128>(BT, H.xbc, t0, 2048 + g * 128, F.in[I_CONVW], F.in[I_CONVB], nullptr, F.tid);
    ssd_scan_prep(F, dpre, h0, acs, dts, wtot);
    { const int hl = F.tid >> 7, l = F.tid & 127; const float last = acs[hl * 128 + 127]; sc[hl * 128 + l] = dts[hl * 128 + l] * __expf(last - acs[hl * 128 + l]);
      if (l == 127) H.cdec[c * 32 + h0 + hl] = __expf(last); }
    __syncthreads();
    SECT(11);
    stage_conv_T<true, 256>(XT, H.xbc, t0, g * 512 + hh * 256, F.in[I_CONVW], F.in[I_CONVB], sc, F.tid);
    __syncthreads();
    SECT(12);
    const int w = F.wave, hl = w >> 1, nh = w & 1, fr = F.lane & 15, fq = F.lane >> 4;
    f32x4 acc[4][4];
#pragma unroll
    for (int i = 0; i < 4; ++i)
#pragma unroll
        for (int j = 0; j < 4; ++j) acc[i][j] = (f32x4){0.f, 0.f, 0.f, 0.f};
#pragma unroll
    for (int ks = 0; ks < 4; ++ks) {
        bf16x8 xf[4], yf[4];
#pragma unroll
        for (int i = 0; i < 4; ++i) { xf[i] = *(const LAS bf16x8*)(BT + (nh * 64 + 16 * i + fr) * PT + ks * 64 + fq * 16); yf[i] = *(const LAS bf16x8*)(XT + (hl * 64 + 16 * i + fr) * PT + ks * 64 + fq * 16); }
#pragma unroll
        for (int i = 0; i < 4; ++i)
#pragma unroll
            for (int j = 0; j < 4; ++j) acc[i][j] = MFMA16(xf[i], yf[j], acc[i][j]);
    }
    bf16_t* dst = H.st + (size_t)(c * 32 + h0 + hl) * 8192;
    SECT(13);
#pragma unroll
    for (int i = 0; i < 4; ++i)
#pragma unroll
        for (int j = 0; j < 4; ++j) *(u32x2*)(dst + (16 * j + fr) * 128 + nh * 64 + 16 * i + 4 * fq) = pack4(acc[i][j]);
    __syncthreads();
    SECT(14);
}
template <int NP> DI void ssd_scan(const Frame& F, const Half& H, int nblk) {
    const int e0 = F.bid * 512 + F.tid;
    unsigned* p = (unsigned*)H.st + e0; float r0[NP], r1[NP];
#pragma unroll
    for (int q = 0; q < NP; ++q) { r0[q] = 0.f; r1[q] = 0.f; }
#pragma unroll 4
    for (int c = 0; c < 64; ++c) {
        unsigned wv[NP];
#pragma unroll
        for (int q = 0; q < NP; ++q) wv[q] = p[(size_t)c * 131072 + (size_t)q * nblk * 512];
#pragma unroll
        for (int q = 0; q < NP; ++q) { const int h = (e0 + q * nblk * 512) >> 12; const float dec = H.cdec[c * 32 + h];
            p[(size_t)c * 131072 + (size_t)q * nblk * 512] = cvt_pk_bf16(r0[q], r1[q]); r0[q] = r0[q] * dec + bflo(wv[q]); r1[q] = r1[q] * dec + bfhi(wv[q]); }
    }
}
DI void ssd_c_item(const Frame& F, const Half& H, int item) {
    const int c = item >> 2, g = item & 3, t0 = c * 128;
    lptr XT = F.lds, Cn = F.lds + 69632, Bn = F.lds + 104448; SECT(0); LAS float* acs = (LAS float*)(F.lds + 139264); LAS float* dts = acs + 512; LAS float* wtot = dts + 512; LAS float* tss = wtot + 16;
    float dpre[2];
#pragma unroll
    for (int q = 0; q < 2; ++q) dpre[q] = H.dt[(size_t)(H.row_base + t0 + (F.tid & 127)) * 32 + g * 8 + q * 4 + (F.tid >> 7)];
    stage_conv_N(Bn, H.xbc, t0, 2048 + g * 128, F.in[I_CONVW], F.in[I_CONVB], F.tid);
    stage_conv_N(Cn, H.xbc, t0, 2560 + g * 128, F.in[I_CONVW], F.in[I_CONVB], F.tid);
    __syncthreads();
    const int w = F.wave, fr = F.lane & 15, fq = F.lane >> 4;
    SECT(1);
    {
        const int lt0 = (w >> 1) * 2, st0 = (w & 1) * 4;
        f32x4 cb[4][2];
#pragma unroll
        for (int i = 0; i < 4; ++i) { cb[i][0] = (f32x4){0.f, 0.f, 0.f, 0.f}; cb[i][1] = cb[i][0]; }
#pragma unroll
        for (int ks = 0; ks < 4; ++ks) {
            bf16x8 xf[4], yf[2];
#pragma unroll
            for (int i = 0; i < 4; ++i) xf[i] = *(const LAS bf16x8*)(Bn + (16 * (st0 + i) + fr) * PT + ks * 64 + fq * 16);
#pragma unroll
            for (int j = 0; j < 2; ++j) yf[j] = *(const LAS bf16x8*)(Cn + (16 * (lt0 + j) + fr) * PT + ks * 64 + fq * 16);
#pragma unroll
            for (int i = 0; i < 4; ++i)
#pragma unroll
                for (int j = 0; j < 2; ++j) cb[i][j] = MFMA16(xf[i], yf[j], cb[i][j]);
        }
        __syncthreads();
#pragma unroll
        for (int i = 0; i < 4; ++i)
#pragma unroll
            for (int j = 0; j < 2; ++j) *(LAS u32x2*)(Bn + (16 * (lt0 + j) + fr) * PT + (16 * (st0 + i) + 4 * fq) * 2) = pack4(cb[i][j]);
    }
    SECT(2);
    const int hl = w >> 1, lh = w & 1;
#pragma unroll 1
    for (int hh = 0; hh < 2; ++hh) {
        const int h0 = g * 8 + hh * 4, h = h0 + hl;
        __syncthreads();
        ssd_scan_prep(F, hh ? dpre[1] : dpre[0], h0, acs, dts, wtot);
        SECT(3);
        stage_conv_T<false, 256>(XT, H.xbc, t0, g * 512 + hh * 256, F.in[I_CONVW], F.in[I_CONVB], nullptr, F.tid);
        __syncthreads();
        SECT(4);
        f32x4 accd[4][4];
#pragma unroll
        for (int i = 0; i < 4; ++i)
#pragma unroll
            for (int j = 0; j < 4; ++j) accd[i][j] = (f32x4){0.f, 0.f, 0.f, 0.f};
        const LAS float* ah = acs + hl * 128; const LAS float* dh = dts + hl * 128;
        const bf16_t* Sp = H.st + (size_t)(c * 32 + h) * 8192;
#pragma unroll
        for (int ks = 0; ks < 4; ++ks) {
            bf16x8 xf[4], yf[4];
#pragma unroll
            for (int i = 0; i < 4; ++i) { xf[i] = *(const bf16x8*)(Sp + (16 * i + fr) * 128 + ks * 32 + fq * 8); yf[i] = *(const LAS bf16x8*)(Cn + (lh * 64 + 16 * i + fr) * PT + ks * 64 + fq * 16); }
#pragma unroll
            for (int i = 0; i < 4; ++i)
#pragma unroll
                for (int j = 0; j < 4; ++j) accd[i][j] = MFMA16(xf[i], yf[j], accd[i][j]);
        }
#pragma unroll
        for (int j = 0; j < 4; ++j) { const float el = __expf(ah[lh * 64 + 16 * j + fr]);
#pragma unroll
            for (int i = 0; i < 4; ++i) accd[i][j] = accd[i][j] * el; }
        SECT(5);
        const int nks = lh ? 4 : 2;
        for (int ks = 0; ks < nks; ++ks) {
            bf16x8 xf[4], yf[4];
            const int s0 = ks * 32 + fq * 8;
            const f32x4 as0 = *(const LAS f32x4*)(ah + s0), as1 = *(const LAS f32x4*)(ah + s0 + 4), ds0 = *(const LAS f32x4*)(dh + s0), ds1 = *(const LAS f32x4*)(dh + s0 + 4);
#pragma unroll
            for (int j = 0; j < 4; ++j) {
                const int l = lh * 64 + 16 * j + fr; const float al = ah[l];
                const u32x4 cbv = *(const LAS u32x4*)(Bn + l * PT + s0 * 2);
                f32x4 o0, o1;
#pragma unroll
                for (int q = 0; q < 4; ++q) {
                    const int sa = s0 + 2 * q, sb = sa + 1;
                    const float asa = (q < 2) ? as0[2 * q] : as1[2 * q - 4], asb = (q < 2) ? as0[2 * q + 1] : as1[2 * q - 3];
                    const float dsa = (q < 2) ? ds0[2 * q] : ds1[2 * q - 4], dsb = (q < 2) ? ds0[2 * q + 1] : ds1[2 * q - 3];
                    const float va = (sa <= l) ? bflo(cbv[q]) * __expf(al - asa) * dsa : 0.f;
                    const float vb = (sb <= l) ? bfhi(cbv[q]) * __expf(al - asb) * dsb : 0.f;
                    if (q < 2) { o0[2 * q] = va; o0[2 * q + 1] = vb; } else { o1[2 * q - 4] = va; o1[2 * q - 3] = vb; }
                }
                yf[j] = __builtin_bit_cast(bf16x8, pack8(o0, o1));
            }
#pragma unroll
            for (int i = 0; i < 4; ++i) xf[i] = *(const LAS bf16x8*)(XT + (hl * 64 + 16 * i + fr) * PT + ks * 64 + fq * 16);
#pragma unroll
            for (int i = 0; i < 4; ++i)
#pragma unroll
                for (int j = 0; j < 4; ++j) accd[i][j] = MFMA16(xf[i], yf[j], accd[i][j]);
        }
        const float Dh = F.in[I_SSDD][h];
        SECT(6);
#pragma unroll
        for (int j = 0; j < 4; ++j) {
            const int l = lh * 64 + 16 * j + fr; float sq = 0.f;
            bf16_t* zr = H.zuq + (size_t)(t0 + l) * ZUQ_LD + h * 64;
#pragma unroll
            for (int i = 0; i < 4; ++i) {
                const int p = 16 * i + 4 * fq;
                const u32x2 zv = *(const u32x2*)(zr + p);
                f32x4 y;
#pragma unroll
                for (int e = 0; e < 4; ++e) { const float xv = __uint_as_float(((unsigned)*(const LAS unsigned short*)(XT + (hl * 64 + p + e) * PT + l * 2)) << 16); y[e] = accd[i][j][e] + Dh * xv; }
                y[0] *= bflo(zv[0]); y[1] *= bfhi(zv[0]); y[2] *= bflo(zv[1]); y[3] *= bfhi(zv[1]);
                sq += (y[0] * y[0] + y[1] * y[1]) + (y[2] * y[2] + y[3] * y[3]);
                *(u32x2*)(zr + p) = pack4(y);
            }
            sq += __shfl_xor(sq, 16); sq += __shfl_xor(sq, 32);
            if (fq == 0) tss[(hh * 4 + hl) * 128 + l] = sq;
        }
        SECT(7);
    }
    __syncthreads();
    {
        const int wv = F.wave, ln = F.lane;
        u32x4 v[16]; float r[16];
#pragma unroll
        for (int i = 0; i < 16; ++i) v[i] = *((const u32x4*)(H.zuq + (size_t)(t0 + wv * 16 + i) * ZUQ_LD + g * 512) + ln);
#pragma unroll
        for (int i = 0; i < 16; ++i) { float tsum = 0.f;
#pragma unroll
            for (int k = 0; k < 8; ++k) tsum += tss[k * 128 + wv * 16 + i];
            r[i] = rstd_of(tsum, 1.f / 512.f); }
#pragma unroll
        for (int i = 0; i < 16; ++i) { f32x4 a, b; a[0] = bflo(v[i][0]) * r[i]; a[1] = bfhi(v[i][0]) * r[i]; a[2] = bflo(v[i][1]) * r[i]; a[3] = bfhi(v[i][1]) * r[i]; b[0] = bflo(v[i][2]) * r[i]; b[1] = bfhi(v[i][2]) * r[i]; b[2] = bflo(v[i][3]) * r[i]; b[3] = bfhi(v[i][3]) * r[i];
            *((u32x4*)(H.zuq + (size_t)(t0 + wv * 16 + i) * ZUQ_LD + g * 512) + ln) = pack8(a, b); }
    }
    __syncthreads();
    SECT(8);
}


typedef short v4i16_t __attribute__((ext_vector_type(4)));
DI void gmlp_item(const Frame& F, const Half& H, int item) {
    const int c = item >> 3, g = item & 7, t0 = c * 128, d0 = g * 128, tid = F.tid;
    lptr VT = F.lds, WS = F.lds + 34816; LAS float* rv = (LAS float*)(F.lds + 69632);
    const float* ssv = (const float*)(F.ws + WS_SSV);
    SECT(20);
    u32x4 pk[4]; f32x4 w0[4], w1[4];
#pragma unroll
    for (int i = 0; i < 4; ++i) {
        const int v = tid + 512 * i, s = v >> 4, seg = v & 15;
        pk[i] = *(const u32x4*)(H.gv + (size_t)(t0 + s) * DM + d0 + seg * 8);
        const float* wp = F.in[I_GWS] + (size_t)(g * 128 + s) * 128 + seg * 8; w0[i] = *(const f32x4*)wp; w1[i] = *(const f32x4*)(wp + 4);
    }
    if (tid < 128) rv[tid] = rstd_of(ssv[H.row_base + t0 + tid], 1.f / 1024.f);
    __syncthreads();
#pragma unroll
    for (int i = 0; i < 4; ++i) {
        const int v = tid + 512 * i, s = v >> 4, seg = v & 15;
        *(LAS u32x4*)(VT + s * PT + seg * 16) = pk[i];
        const int t = s, s0 = seg * 8;
        f32x4 o0, o1;
#pragma unroll
        for (int e = 0; e < 4; ++e) { o0[e] = (s0 + e <= t) ? w0[i][e] * rv[s0 + e] : 0.f; o1[e] = (s0 + 4 + e <= t) ? w1[i][e] * rv[s0 + 4 + e] : 0.f; }
        *(LAS u32x4*)(WS + t * PT + s0 * 2) = pack8(o0, o1);
    }
    __syncthreads();
    SECT(21);
    const int w = F.wave, fr = F.lane & 15, fq = F.lane >> 4, mtb = (w & 3) * 2, ntb = (w >> 2) * 4;
    f32x4 acc[2][4];
#pragma unroll
    for (int i = 0; i < 2; ++i)
#pragma unroll
        for (int j = 0; j < 4; ++j) acc[i][j] = (f32x4){0.f, 0.f, 0.f, 0.f};
    const int nks = ntb ? 4 : 2;
    for (int ks = 0; ks < nks; ++ks) {
        bf16x8 xf[2], yf[4];
#pragma unroll
        for (int i = 0; i < 2; ++i) {
            const v4i16_t lo = __builtin_amdgcn_ds_read_tr16_b64_v4i16((LAS v4i16_t*)(VT + (ks * 32 + 8 * fq + (fr >> 2)) * PT + (16 * (mtb + i)) * 2 + 8 * (fr & 3)));
            const v4i16_t hi = __builtin_amdgcn_ds_read_tr16_b64_v4i16((LAS v4i16_t*)(VT + (ks * 32 + 8 * fq + 4 + (fr >> 2)) * PT + (16 * (mtb + i)) * 2 + 8 * (fr & 3)));
            xf[i] = __builtin_shufflevector(lo, hi, 0, 1, 2, 3, 4, 5, 6, 7); }
#pragma unroll
        for (int j = 0; j < 4; ++j) yf[j] = *(const LAS bf16x8*)(WS + (16 * (ntb + j) + fr) * PT + ks * 64 + fq * 16);
#pragma unroll
        for (int i = 0; i < 2; ++i)
#pragma unroll
            for (int j = 0; j < 4; ++j) acc[i][j] = MFMA16(xf[i], yf[j], acc[i][j]);
    }
    SECT(22);
#pragma unroll
    for (int j = 0; j < 4; ++j) {
        const int t = 16 * (ntb + j) + fr; const float bias = F.in[I_GBS][g * 128 + t];
#pragma unroll
        for (int i = 0; i < 2; ++i) {
            const int d = d0 + 16 * (mtb + i) + 4 * fq;
            const f32x4 gn = *(const f32x4*)(F.in[I_GVN] + d);
            bf16_t* up = H.zuq + (size_t)(t0 + t) * ZUQ_LD + 2048 + d;
            const u32x2 uv = *(const u32x2*)up;
            f32x4 y;
            y[0] = bflo(uv[0]) * (gn[0] * acc[i][j][0] + bias); y[1] = bfhi(uv[0]) * (gn[1] * acc[i][j][1] + bias);
            y[2] = bflo(uv[1]) * (gn[2] * acc[i][j][2] + bias); y[3] = bfhi(uv[1]) * (gn[3] * acc[i][j][3] + bias);
            *(u32x2*)up = pack4(y);
        }
    }
    __syncthreads();
    SECT(23);
}
DI void memattn_item(const Frame& F, const Half& H, int item) {
    const int h = item & 3, t0 = (item >> 2) * 128, tid = F.tid, w = F.wave, fr = F.lane & 15, fq = F.lane >> 4;
    lptr Ks = F.lds, VT = F.lds + 36864, Pw = F.lds + 70656 + w * 8448;
    const bf16_t* Kmem = (const bf16_t*)(F.ws + WS_KMEM) + (size_t)H.b * 256 * 256; const bf16_t* VmemT = (const bf16_t*)(F.ws + WS_VMEMT) + (size_t)H.b * 256 * 256;
#pragma unroll
    for (int i = 0; i < 4; ++i) {
        const int v = tid + 512 * i;
        { const int m = v >> 3, seg = v & 7; *(LAS u32x4*)(Ks + m * 144 + seg * 16) = *(const u32x4*)(Kmem + (size_t)m * 256 + h * 64 + seg * 8); }
        { const int d = v >> 5, seg = v & 31; *(LAS u32x4*)(VT + d * 528 + seg * 16) = *(const u32x4*)(VmemT + (size_t)(h * 64 + d) * 256 + seg * 8); }
    }
    __syncthreads();
    for (int sub = 0; sub < 1; ++sub) {
        const int tw = t0 + sub * 128 + w * 16;
        bf16_t* qrow = H.zuq + (size_t)(tw + fr) * ZUQ_LD + 3072 + h * 64;
        bf16x8 qf[2];
        qf[0] = *(const bf16x8*)(qrow + fq * 8); qf[1] = *(const bf16x8*)(qrow + 32 + fq * 8);
        f32x4 s[16];
#pragma unroll
        for (int i = 0; i < 16; ++i) { s[i] = (f32x4){0.f, 0.f, 0.f, 0.f};
#pragma unroll
            for (int ks = 0; ks < 2; ++ks) { const bf16x8 kf = *(const LAS bf16x8*)(Ks + (16 * i + fr) * 144 + ks * 64 + fq * 16); s[i] = MFMA16(kf, qf[ks], s[i]); } }
        float mx = -3.0e38f;
#pragma unroll
        for (int i = 0; i < 16; ++i) mx = fmaxf(mx, fmaxf(fmaxf(s[i][0], s[i][1]), fmaxf(s[i][2], s[i][3])));
        mx = fmaxf(mx, __shfl_xor(mx, 16)); mx = fmaxf(mx, __shfl_xor(mx, 32));
        float sum = 0.f;
#pragma unroll
        for (int i = 0; i < 16; ++i) { f32x4 p;
#pragma unroll
            for (int e = 0; e < 4; ++e) { p[e] = __builtin_amdgcn_exp2f(s[i][e] - mx); sum += p[e]; }
            *(LAS u32x2*)(Pw + fr * 528 + (16 * i + 4 * fq) * 2) = pack4(p); }
        sum += __shfl_xor(sum, 16); sum += __shfl_xor(sum, 32);
        LDS_WAIT(); __builtin_amdgcn_wave_barrier();
        f32x4 o[4];
#pragma unroll
        for (int i = 0; i < 4; ++i) o[i] = (f32x4){0.f, 0.f, 0.f, 0.f};
#pragma unroll
        for (int ks = 0; ks < 8; ++ks) { const bf16x8 pf = *(const LAS bf16x8*)(Pw + fr * 528 + ks * 64 + fq * 16);
#pragma unroll
            for (int i = 0; i < 4; ++i) { const bf16x8 vf = *(const LAS bf16x8*)(VT + (16 * i + fr) * 528 + ks * 64 + fq * 16); o[i] = MFMA16(vf, pf, o[i]); } }
        const float inv = __builtin_amdgcn_rcpf(sum);
#pragma unroll
        for (int i = 0; i < 4; ++i) *(u32x2*)(qrow + 16 * i + 4 * fq) = pack4(o[i] * inv);
        LDS_WAIT(); __builtin_amdgcn_wave_barrier();
    }
    __syncthreads();
}

#ifndef WGM_HALF
#define WGM_HALF 8
#endif
#define PH_GEMM(EpiT, Aptr, Bptr, Mm, Nn, Kk, Eobj) do { pg8::Gemm g_{(const bf16_t*)(Aptr), (const bf16_t*)(Bptr), Mm, Nn, Kk}; pg8::StaticOrder S_; S_.init(Mm, Nn, F.G, F.bid, (Mm) == TB ? WGM_HALF : 8); \
        pg8::gemm_phase<EpiT, pg8::StaticOrder, true, true>(F.lds, g_, S_, Eobj); } while (0)

__global__ void __launch_bounds__(512) mega_fwd(Args args) {
    extern __shared__ __attribute__((aligned(16))) unsigned char lds_raw[];
    cg::grid_group grid = cg::this_grid();
    Frame F; F.lds = (lptr)lds_raw; F.ws = args.ws; F.in = args.in; F.out = args.out;
    F.tid = threadIdx.x; F.lane = F.tid & 63; F.wave = __builtin_amdgcn_readfirstlane(F.tid >> 6); F.G = gridDim.x; F.bid = blockIdx.x;
    unsigned char* ws = args.ws;
    const int lo = args.ph_lo, hi = args.ph_hi;
    { volatile LAS unsigned* st_ = (volatile LAS unsigned*)(F.lds + LDS_BARST); if (F.tid < 2) st_[F.tid] = 0u; }
    __syncthreads();
    XcdBarrier xbar; xbar.bar = (unsigned*)(ws + WS_BAR); xbar.x = 0; xbar.st = nullptr;
    if (lo > hi) grid.sync();
    if (hi - lo > 1) xbar = xcd_barrier_post((unsigned*)(ws + WS_BAR), (volatile LAS unsigned*)(F.lds + LDS_BARST));
#define HB ((bf16_t*)(ws + WS_HB))
#define ACT ((bf16_t*)(ws + WS_ACT))
#define MG ((bf16_t*)(ws + WS_MG))
#define SS1 ((float*)(ws + WS_SS1))
#define SS2 ((float*)(ws + WS_SS2))
#define SS3 ((float*)(ws + WS_SS3))
#define SS4 ((float*)(ws + WS_SS4))
#ifndef PHMASK
#define PHMASK 0xFFFFFFFFu
#endif
#define RELAUNDER() do { int t_ = threadIdx.x; asm volatile("" : "+v"(t_)); F.tid = t_; F.lane = t_ & 63; F.wave = __builtin_amdgcn_readfirstlane(t_ >> 6); \
        unsigned long long w_ = (unsigned long long)args.ws; asm volatile("" : "+s"(w_)); ws = (unsigned char*)w_; F.ws = ws; } while (0)
#define IN(k) (((PHMASK >> ((k) > 8 ? (k) - 6 : (k))) & 1u) && lo <= (k) && (k) < hi)
#define SEAM(k) do { if ((k) + 1 < hi) { xcd_barrier(xbar); } } while (0)

    if (IN(0)) { RELAUNDER(); prologue(F); SEAM(0); }
    if (IN(1)) { RELAUNDER(); EpiGLU E{SS1, ACT}; PH_GEMM(EpiGLU, HB, ws + WS_W1GU, T, 2 * FF, DM, E);
        if (F.G >= 256) { if (F.bid >= 128) mid_convert(F, 128); } else mid_convert(F, 0);
        SEAM(1); }
    if (IN(2)) { RELAUNDER(); EpiRes<true> E{(const float*)nullptr, HB, HB, SS2, 0.5f}; PH_GEMM(EpiRes<true>, ACT, ws + WS_W1D, T, DM, FF, E); SEAM(2); }
#pragma unroll 1
    for (int b = 0; b < 2; ++b) {
        const int k0 = 3 + 6 * b;
#define MKHALF() Half H; H.b = b; H.zuq = (bf16_t*)(ws + WS_ZUQ); H.xbc = (bf16_t*)(ws + WS_XBC); H.gv = MG + (size_t)TB * DM; H.st = (bf16_t*)(ws + WS_ST); H.cdec = (float*)(ws + WS_CDEC) + b * 2048; H.dt = (const float*)(ws + WS_DT); H.row_base = b * TB;
        if (IN(k0)) { RELAUNDER(); MKHALF(); if (b == 1) { if (F.G >= 256) { if (F.bid >= 192) late_convert(F, 192); } else late_convert(F, 0); __syncthreads(); }
            EpiWin E{H.row_base, SS2, H.zuq, H.xbc, H.gv, (float*)(ws + WS_DT), F.in[I_DTB], (float*)(ws + WS_SSV)};
            PH_GEMM(EpiWin, HB + (size_t)H.row_base * DM, ws + WS_WIN, TB, NWIN, DM, E); SEAM(k0); }
        if (IN(k0 + 1)) { RELAUNDER(); MKHALF();
            for (int it = F.bid; it < 512; it += F.G) ssd_a_item(F, H, it);
            if (F.G != 256) { for (int it = F.bid; it < 512; it += F.G) gmlp_item(F, H, it); }
            if (F.G < 256) { for (int it = F.bid; it < 256; it += F.G) memattn_item(F, H, it); }
            SEAM(k0 + 1); }
        if (IN(k0 + 2)) { RELAUNDER(); MKHALF();
            if (F.G == 256) { if (F.bid < 64) ssd_scan<4>(F, H, 64); else for (int it = F.bid - 64; it < 512; it += F.G - 64) gmlp_item(F, H, it); }
            else { if (F.bid < 64) ssd_scan<4>(F, H, 64); }
            SEAM(k0 + 2); }
        if (IN(k0 + 3)) { RELAUNDER(); MKHALF(); for (int it = F.bid; it < 256; it += F.G) ssd_c_item(F, H, it); SEAM(k0 + 3); }
        if (IN(k0 + 4)) { RELAUNDER(); MKHALF(); if (F.G >= 256 && F.bid >= 128) { for (int it = F.bid - 128; it < 256; it += F.G - 128) memattn_item(F, H, it); }
            EpiGates E{H.row_base, SS2, H.xbc}; PH_GEMM(EpiGates, HB + (size_t)H.row_base * DM, ws + WS_WG, TB, GATE_LD, DM, E); SEAM(k0 + 4); }
        if (IN(k0 + 5)) { RELAUNDER(); MKHALF(); EpiMerge E{H.xbc, (bf16_t*)(ws + WS_ST), MG + (size_t)b * TB * DM};
            { pg8::Gemm g_{(const bf16_t*)H.zuq, (const bf16_t*)(ws + WS_WBR), TB, DM, KBR}; pg8::SegOrder<3> S_; S_.init(TB, 2 * DM, F.G, F.bid);     pg8::gemm_phase<EpiMerge, pg8::SegOrder<3>, true, true>(F.lds, g_, S_, E); } SEAM(k0 + 5); }
    }
    if (IN(15)) { RELAUNDER(); EpiRes<true> E{(const float*)nullptr, HB, HB, SS3, 1.0f}; PH_GEMM(EpiRes<true>, MG, ws + WS_WOUT, T, DM, DM, E); SEAM(15); }
    if (IN(16)) { RELAUNDER(); EpiGLU E{SS3, ACT}; PH_GEMM(EpiGLU, HB, ws + WS_W2GU, T, 2 * FF, DM, E); SEAM(16); }
    if (IN(17)) { RELAUNDER(); EpiResNorm E{HB, F.out, SS4, (unsigned*)(ws + WS_PCNT), F.in[I_FINN], 0.5f}; PH_GEMM(EpiResNorm, ACT, ws + WS_W2D, T, DM, FF, E); }
}

#ifndef N_PHASES
#define N_PHASES 18
#endif
#ifndef ONE_LAUNCH
#define ONE_LAUNCH 1
#endif
extern "C" void kernel_launch(void* const* d_in, const int* in_sizes, int n_in, void* d_out, int out_size, void* d_ws, size_t ws_size, hipStream_t stream) {
    static int grid = 0;
    if (grid == 0) {
        int dev = 0, cus = 0, per_cu = 0;
        hipGetDevice(&dev); hipDeviceGetAttribute(&cus, hipDeviceAttributeMultiprocessorCount, dev);
        if (hipFuncSetAttribute((const void*)mega_fwd, hipFuncAttributeMaxDynamicSharedMemorySize, LDS_BYTES) != hipSuccess) { fprintf(stderr, "kernel_launch: hipFuncSetAttribute failed\n"); grid = -1; return; }
        if (hipOccupancyMaxActiveBlocksPerMultiprocessor(&per_cu, (const void*)mega_fwd, 512, LDS_BYTES) != hipSuccess || per_cu < 1) { fprintf(stderr, "kernel_launch: occupancy query says %d\n", per_cu); per_cu = 1; }
        (void)hipGetLastError();
        grid = cus;
        if (n_in != 28 || ws_size < WS_END) { fprintf(stderr, "kernel_launch: unexpected n_in %d / ws %zu\n", n_in, ws_size); grid = -1; return; }
    }
    if (grid < 0) return;
    if (hipMemsetAsync((char*)d_ws + WS_BAR, 0, BAR_BYTES, stream) != hipSuccess) { fprintf(stderr, "kernel_launch: memset failed\n"); return; }
    Args a{};
    for (int i = 0; i < 28; ++i) a.in[i] = (const float*)d_in[i];
    a.out = (float*)d_out; a.ws = (unsigned char*)d_ws;
#if ONE_LAUNCH
    a.ph_lo = 0; a.ph_hi = N_PHASES;
    void* kargs[] = {&a};
    hipError_t e = hipLaunchCooperativeKernel((const void*)mega_fwd, dim3(grid), dim3(512), kargs, LDS_BYTES, stream);
    if (e != hipSuccess) fprintf(stderr, "cooperative launch failed: %s (grid %d)\n", hipGetErrorString(e), grid);
#else
    for (int k = 0; k < N_PHASES; ++k) { a.ph_lo = k; a.ph_hi = k + 1; hipLaunchKernelGGL(mega_fwd, dim3(grid), dim3(512), LDS_BYTES, stream, a); }
#endif
}
```

```cpp
#include <hip/hip_runtime.h>
#include <hip/hip_cooperative_groups.h>
#include <cstdio>
#include <cstdint>
namespace cg = cooperative_groups;
namespace pg8 {
#define PG8_LAS __attribute__((address_space(3)))
typedef unsigned short bf16_t;
typedef short bf16x8 __attribute__((ext_vector_type(8)));
typedef float f32x4 __attribute__((ext_vector_type(4)));
typedef unsigned u32x4 __attribute__((ext_vector_type(4)));
constexpr int BM = 256, BK = 64, HALF = 128, HTB = HALF * BK * 2  , STAGE_BYTES = 8 * HTB, NXCD = 8, WGM = 8;

__host__ __device__ __forceinline__ int lds_byte(int r, int c) { const int st = (r >> 4) * 2 + (c >> 5), rr = r & 15, cc = c & 31, ob = rr * 64 + cc * 2; return st * 1024 + (ob ^ (((ob >> 9) & 1) << 5)); }
__host__ __device__ __forceinline__ void stage_rc(int b, int& R, int& C) { const int st = b / 1024, sb = b % 1024, swz = sb ^ (((sb >> 9) & 1) << 5); R = (st >> 1) * 16 + swz / 64; C = (st & 1) * 32 + (swz % 64) / 2; }
__host__ __device__ __forceinline__ int perm32(int rho) { const int n = rho >> 4, i = rho & 15; return 8 * (i >> 2) + 4 * n + (i & 3); }

struct Unit { int pm, pn, seg; };
struct Gemm { const bf16_t* A; const bf16_t* Bt; int M, N, K; };

struct StaticOrder {
    int nM, nN, nwg, G, c, wgm;
    __host__ __device__ void init(int M, int N, int G_, int c_, int wgm_ = WGM) { nM = M / BM; nN = N / BM; nwg = nM * nN; G = G_; c = c_; wgm = wgm_; }
    __host__ __device__ bool next(int i, Unit& u) const {
        const long L = (long)i * G + c; if (L >= nwg) return false;
        int wgid = (int)L; { const int q = nwg / NXCD, r = nwg % NXCD, xcd = wgid % NXCD, off = wgid / NXCD; wgid = (xcd < r ? xcd * (q + 1) : r * (q + 1) + (xcd - r) * q) + off; }
        const int nig = wgm * nN, gid = wgid / nig, fm = gid * wgm, gsz = (nM - fm) < wgm ? (nM - fm) : wgm;
        u.pm = fm + ((wgid % nig) % gsz); u.pn = (wgid % nig) / gsz; u.seg = 0; return true;
    }
    __device__ __forceinline__ void a_ready(const Unit&) const {}
    __device__ __forceinline__ void done(const Unit&) const {}
};

template <int NSEG> struct SegOrder {
    StaticOrder base;
    __host__ __device__ void init(int M, int N, int G_, int c_) { base.init(M, N, G_, c_); }
    __host__ __device__ bool next(int i, Unit& u) const { if (!base.next(i / NSEG, u)) return false; u.seg = i % NSEG; return true; }
    __device__ __forceinline__ void a_ready(const Unit&) const {}
    __device__ __forceinline__ void done(const Unit&) const {}
};
__device__ __forceinline__ unsigned cvt_pk_bf16(float lo, float hi) { unsigned r; asm volatile("v_cvt_pk_bf16_f32 %0, %1, %2" : "=v"(r) : "v"(lo), "v"(hi)); return r; }
typedef float f32x2 __attribute__((ext_vector_type(2)));
__device__ __forceinline__ f32x2 gelu_pk(f32x2 v) {
    const f32x2 av = __builtin_elementwise_abs(v), d = av * 0.2316418882f + 1.0f;
    f32x2 t; t.x = __builtin_amdgcn_rcpf(d.x); t.y = __builtin_amdgcn_rcpf(d.y);
    f32x2 q = t * 0.5307027145f + (-0.7265760135f); q = q * t + 0.7107068705f; q = q * t + (-0.142248368f); q = q * t + 0.127414796f; q = q * t;
    const f32x2 s = (v * v) * (-0.72134752044f);
    f32x2 e; e.x = __builtin_amdgcn_exp2f(s.x); e.y = __builtin_amdgcn_exp2f(s.y);
    const f32x2 m = v * (q * e), r = v - m;
    f32x2 o; o.x = v.x < 0.f ? m.x : r.x; o.y = v.y < 0.f ? m.y : r.y; return o;
}
template <class Epi, class Sched, bool ALIGN_EPI = false, bool SP2 = false>
__device__ __forceinline__ void gemm_phase(PG8_LAS unsigned char* lds, const Gemm g, const Sched& S, const Epi& E) {
    int tid_ = threadIdx.x; asm volatile("" : "+v"(tid_)); const int tid = tid_, wid = __builtin_amdgcn_readfirstlane(tid >> 6), lane = tid & 63, wr = wid >> 2, wc = wid & 3, fr = lane & 15, fq = lane >> 4;
    const int K = g.K; int nt = K / BK;
    unsigned voffA[2], voffB[2];
#pragma unroll
    for (int i = 0; i < 2; ++i) { int R, C; stage_rc(tid * 16 + i * 8192, R, C); const int Rb = Epi::PERM ? ((R & ~31) + perm32(R & 31)) : R;
        voffA[i] = (unsigned)(R * K + C) * 2u; voffB[i] = (unsigned)(Rb * K + C) * 2u; }
    const size_t kstep = (size_t)(BK * 2);
    const size_t hstep = (size_t)HALF * K * 2;
    const size_t tstep = 2 * hstep;
    const unsigned ldsw = (unsigned)wid * 1024u;
    const int aoff = lds_byte(wr * 64 + fr, fq * 8), boff = lds_byte(wc * 32 + fr, fq * 8);
#define PG8_SA(b, h) (((b) * 2 + (h)) * HTB)
#define PG8_SB(b, h) ((4 + (b) * 2 + (h)) * HTB)
#define PG8_STAGE(bufoff, gbase, voff) do { _Pragma("unroll") for (int _i = 0; _i < 2; ++_i) \
        __builtin_amdgcn_global_load_lds((const unsigned*)((const char*)(gbase) + (voff)[_i]), (PG8_LAS unsigned*)(lds + (bufoff) + ldsw + _i * 8192), 16, 0, 0); } while (0)
#define PG8_LDA(dst, b, h) do { _Pragma("unroll") for (int m = 0; m < 4; ++m) _Pragma("unroll") for (int k = 0; k < 2; ++k) dst[m][k] = *(const PG8_LAS bf16x8*)(lds + PG8_SA(b, h) + aoff + m * 2048 + k * 1024); } while (0)
#define PG8_LDB(dst, b, h) do { _Pragma("unroll") for (int n = 0; n < 2; ++n) _Pragma("unroll") for (int k = 0; k < 2; ++k) dst[n][k] = *(const PG8_LAS bf16x8*)(lds + PG8_SB(b, h) + boff + n * 2048 + k * 1024); } while (0)
#define PG8_MMA(ai, bj, At, Bt) do { __builtin_amdgcn_s_setprio(1); _Pragma("unroll") for (int m = 0; m < 4; ++m) _Pragma("unroll") for (int n = 0; n < 2; ++n) _Pragma("unroll") for (int k = 0; k < 2; ++k) \
        acc[ai][bj][m][n] = __builtin_amdgcn_mfma_f32_16x16x32_bf16(Bt[n][k], At[m][k], acc[ai][bj][m][n], 0, 0, 0); __builtin_amdgcn_s_setprio(0); } while (0)
#define PG8_WAIT_V(n) asm volatile("s_waitcnt vmcnt(" #n ")" ::: "memory")
#define PG8_WAIT_L(n) asm volatile("s_waitcnt lgkmcnt(" #n ")" ::: "memory")
#define PG8_BAR __builtin_amdgcn_s_barrier()
#define PG8_SCHED __builtin_amdgcn_sched_barrier(0)
    Unit cur, nxt; int ui = 0;
    if (!S.next(0, cur)) return;
    f32x4 acc[2][2][4][2];
#pragma unroll
    for (int a = 0; a < 2; ++a)
#pragma unroll
        for (int b = 0; b < 2; ++b)
#pragma unroll
            for (int m = 0; m < 4; ++m)
#pragma unroll
                for (int n = 0; n < 2; ++n) acc[a][b][m][n] = (f32x4){0.f, 0.f, 0.f, 0.f};
    bf16x8 At[4][2], B0[2][2], B1[2][2];
    const char* cA = (const char*)g.A + (size_t)cur.pm * tstep; const char* cB = (const char*)g.Bt + (size_t)cur.pn * (Epi::HALFB ? hstep : tstep);
    if constexpr (Epi::NSEG > 1) { cA += (size_t)Epi::seg_koff(cur.seg) * 2; cB += (size_t)Epi::seg_koff(cur.seg) * 2; nt = Epi::seg_nt(cur.seg); }
    S.a_ready(cur);
    if constexpr (SP2) {
        PG8_STAGE(PG8_SB(0, 0), cB, voffB); PG8_STAGE(PG8_SB(0, 1), cB + hstep, voffB); PG8_STAGE(PG8_SA(0, 0), cA, voffA); PG8_STAGE(PG8_SA(0, 1), cA + hstep, voffA);
        if (wr == 1) PG8_BAR;
        PG8_WAIT_V(2); PG8_BAR;
        PG8_STAGE(PG8_SB(1, 0), cB + kstep, voffB); PG8_STAGE(PG8_SA(1, 0), cA + kstep, voffA); PG8_STAGE(PG8_SB(1, 1), cB + hstep + kstep, voffB);
        PG8_WAIT_V(6); PG8_BAR;
    } else {
        PG8_STAGE(PG8_SB(0, 0), cB, voffB); PG8_STAGE(PG8_SA(0, 0), cA, voffA); PG8_STAGE(PG8_SB(0, 1), cB + hstep, voffB); PG8_STAGE(PG8_SA(0, 1), cA + hstep, voffA);
        if (wr == 1) PG8_BAR;
        PG8_WAIT_V(4); PG8_BAR;
        PG8_STAGE(PG8_SB(1, 0), cB + kstep, voffB); PG8_STAGE(PG8_SA(1, 0), cA + kstep, voffA); PG8_STAGE(PG8_SB(1, 1), cB + hstep + kstep, voffB);
        PG8_WAIT_V(6); PG8_BAR;
    }
    for (;;) {
        const bool has_next = S.next(ui + 1, nxt);
        const char* nA = has_next ? (const char*)g.A + (size_t)nxt.pm * tstep : cA; const char* nB = has_next ? (const char*)g.Bt + (size_t)nxt.pn * (Epi::HALFB ? hstep : tstep) : cB;
        if constexpr (Epi::NSEG > 1) { if (has_next) { nA += (size_t)Epi::seg_koff(nxt.seg) * 2; nB += (size_t)Epi::seg_koff(nxt.seg) * 2; } }
        for (int t = 0; t < nt; t += 2) {
            const bool last = (t == nt - 2);
            const char* a1 = cA + (size_t)(t + 1) * kstep;
            const char* a2 = last ? nA : cA + (size_t)(t + 2) * kstep; const char* b2 = last ? nB : cB + (size_t)(t + 2) * kstep;
            const char* a3 = a2 + kstep; const char* b3 = b2 + kstep;
            if (last && has_next) S.a_ready(nxt);
            if constexpr (SP2) {
            PG8_LDB(B0, 0, 0); if constexpr (!Epi::HALFB) PG8_LDB(B1, 0, 1); PG8_SCHED; PG8_LDA(At, 0, 0); PG8_STAGE(PG8_SA(1, 1), a1 + hstep, voffA);
            PG8_WAIT_V(8); PG8_WAIT_L(0); PG8_BAR; PG8_MMA(0, 0, At, B0); if constexpr (!Epi::HALFB) PG8_MMA(0, 1, At, B1); PG8_BAR; PG8_SCHED;
            PG8_LDA(At, 0, 1); PG8_STAGE(PG8_SB(0, 0), b2, voffB); PG8_STAGE(PG8_SB(0, 1), b2 + hstep, voffB); PG8_STAGE(PG8_SA(0, 0), a2, voffA);
            PG8_WAIT_V(8); PG8_WAIT_L(0); PG8_BAR; PG8_MMA(1, 0, At, B0); if constexpr (!Epi::HALFB) PG8_MMA(1, 1, At, B1); PG8_BAR; PG8_SCHED;
            PG8_LDB(B0, 1, 0); if constexpr (!Epi::HALFB) PG8_LDB(B1, 1, 1); PG8_SCHED; PG8_LDA(At, 1, 0); PG8_STAGE(PG8_SA(0, 1), a2 + hstep, voffA);
            PG8_WAIT_V(8); PG8_WAIT_L(0); PG8_BAR; PG8_MMA(0, 0, At, B0); if constexpr (!Epi::HALFB) PG8_MMA(0, 1, At, B1); PG8_BAR; PG8_SCHED;
            PG8_LDA(At, 1, 1); PG8_STAGE(PG8_SB(1, 0), b3, voffB); PG8_STAGE(PG8_SB(1, 1), b3 + hstep, voffB); PG8_STAGE(PG8_SA(1, 0), a3, voffA);
            PG8_WAIT_V(8); PG8_WAIT_L(0); PG8_BAR; PG8_MMA(1, 0, At, B0); if constexpr (!Epi::HALFB) PG8_MMA(1, 1, At, B1); PG8_BAR; PG8_SCHED;
            } else {
            PG8_LDB(B0, 0, 0); PG8_SCHED; PG8_LDA(At, 0, 0); PG8_STAGE(PG8_SA(1, 1), a1 + hstep, voffA);
            PG8_WAIT_L(8); PG8_BAR; PG8_WAIT_L(0); PG8_MMA(0, 0, At, B0); PG8_BAR; PG8_SCHED;
            PG8_LDB(B1, 0, 1); PG8_STAGE(PG8_SB(0, 0), b2, voffB);
            PG8_BAR; PG8_WAIT_L(0); PG8_MMA(0, 1, At, B1); PG8_BAR;
            PG8_LDA(At, 0, 1); PG8_STAGE(PG8_SA(0, 0), a2, voffA);
            PG8_BAR; PG8_WAIT_L(0); PG8_MMA(1, 0, At, B0); PG8_BAR; PG8_SCHED;
            PG8_STAGE(PG8_SB(0, 1), b2 + hstep, voffB);
            PG8_WAIT_V(6); PG8_BAR; PG8_MMA(1, 1, At, B1); PG8_BAR;
            PG8_LDB(B0, 1, 0); PG8_SCHED; PG8_LDA(At, 1, 0); PG8_STAGE(PG8_SA(0, 1), a2 + hstep, voffA);
            PG8_WAIT_L(8); PG8_BAR; PG8_WAIT_L(0); PG8_MMA(0, 0, At, B0); PG8_BAR; PG8_SCHED;
            PG8_LDB(B1, 1, 1); PG8_STAGE(PG8_SB(1, 0), b3, voffB);
            PG8_BAR; PG8_WAIT_L(0); PG8_MMA(0, 1, At, B1); PG8_BAR;
            PG8_LDA(At, 1, 1); PG8_STAGE(PG8_SA(1, 0), a3, voffA);
            PG8_BAR; PG8_WAIT_L(0); PG8_MMA(1, 0, At, B0); PG8_BAR; PG8_SCHED;
            PG8_STAGE(PG8_SB(1, 1), b3 + hstep, voffB);
            PG8_WAIT_V(6); PG8_BAR; PG8_MMA(1, 1, At, B1); PG8_BAR;
            }
        }
        if constexpr (ALIGN_EPI) { if (wr == 0) PG8_BAR; }
        bool lastseg = true; if constexpr (Epi::NSEG > 1) lastseg = (cur.seg == Epi::NSEG - 1);
        if constexpr (!Epi::AFTER_DRAIN) { if (lastseg) { E(acc, cur, wr, wc, fr, fq); S.done(cur); } else { if constexpr (Epi::NSEG > 1) E.seg(acc, cur, wr, wc, fr, fq); } }
        if (!has_next) break;
#pragma unroll
        for (int a = 0; a < 2; ++a)
#pragma unroll
            for (int b = 0; b < 2; ++b)
#pragma unroll
                for (int m = 0; m < 4; ++m)
#pragma unroll
                    for (int n = 0; n < 2; ++n) acc[a][b][m][n] = (f32x4){0.f, 0.f, 0.f, 0.f};
        cur = nxt; cA = nA; cB = nB; ++ui; if constexpr (Epi::NSEG > 1) nt = Epi::seg_nt(cur.seg);
        if constexpr (ALIGN_EPI) { if (wr == 1) PG8_BAR; }
    }
    PG8_WAIT_V(0);
    if constexpr (!ALIGN_EPI) { if (wr == 0) PG8_BAR; }
    PG8_BAR;
    if constexpr (Epi::AFTER_DRAIN) { E.fused(acc, cur, wr, wc, fr, fq, lds, wid, lane); S.done(cur); }
#undef PG8_SA
#undef PG8_SB
#undef PG8_STAGE
#undef PG8_LDA
#undef PG8_LDB
#undef PG8_MMA
#undef PG8_WAIT_V
#undef PG8_WAIT_L
#undef PG8_BAR
#undef PG8_SCHED
}
}

#define DI __device__ __forceinline__
#define LAS __attribute__((address_space(3)))
using pg8::bf16_t; using pg8::bf16x8; using pg8::f32x4; using pg8::u32x4; using pg8::Unit; using pg8::f32x2; using pg8::gelu_pk;
typedef __bf16 bf16x2_t __attribute__((ext_vector_type(2)));
__device__ __forceinline__ unsigned cvt_pk_bf16(float lo, float hi) { f32x2 v = {lo, hi}; bf16x2_t b = __builtin_convertvector(v, bf16x2_t); return __builtin_bit_cast(unsigned, b); }
typedef LAS unsigned char* lptr;
typedef unsigned u32x2 __attribute__((ext_vector_type(2)));
#define MFMA16(a, b, c) __builtin_amdgcn_mfma_f32_16x16x32_bf16((a), (b), (c), 0, 0, 0)

constexpr int T = 16384, TB = 8192, DM = 1024, FF = 2816;
constexpr float EPS = 1e-6f;
constexpr int ZUQ_LD = 3328, XBC_LD = 3072, NWIN = 7680, GATE_LD = 3072, KBR = 3328, WIN_LD = 10528;
constexpr float QSCALE = 0.125f * 1.4426950408889634f;
constexpr int PT = 272;
constexpr int LDS_BYTES = 155648;

constexpr size_t KiB = 1024, MiB = 1u << 20;
constexpr size_t WS_SS1 = 0, WS_SS2 = 64 * KiB, WS_SS3 = 128 * KiB, WS_SS4 = 192 * KiB, WS_SSV = 256 * KiB, WS_SSG = 320 * KiB  , WS_CDEC = 576 * KiB  ;
constexpr size_t WS_KMEM = 640 * KiB, WS_VMEMT = 896 * KiB, WS_DT = 2 * MiB;
constexpr size_t WS_BAR = 4 * MiB, BAR_BYTES = 65536, WS_PCNT = WS_BAR + 32768;
constexpr int LDS_BARST = LDS_BYTES - 64;
constexpr size_t WS_W2GU = 6 * MiB, WS_W2D = 17 * MiB, WS_WIN = 22 * MiB + 512 * KiB, WS_WG = 37 * MiB + 512 * KiB, WS_WBR = 43 * MiB + 512 * KiB, WS_WOUT = 50 * MiB;
constexpr size_t WS_HB = 52 * MiB, WS_MG = 84 * MiB, WS_W1GU = 116 * MiB, WS_W1D = 127 * MiB, WS_ACT = 132 * MiB + 512 * KiB;
constexpr size_t WS_ZUQ = 116 * MiB, WS_XBC = 168 * MiB, WS_ST = 216 * MiB, WS_END = 256 * MiB;
static_assert(WS_ACT + (size_t)T * FF * 2 <= WS_END && WS_ST + (size_t)64 * 32 * 8192 * 2 <= WS_END && WS_ZUQ + (size_t)TB * ZUQ_LD * 2 <= WS_XBC && WS_XBC + (size_t)TB * XBC_LD * 2 <= WS_ST, "ws map");

DI float bflo(unsigned w) { return __uint_as_float(w << 16); }
DI float bfhi(unsigned w) { return __uint_as_float(w & 0xffff0000u); }
DI float sigm(float x) { return __builtin_amdgcn_rcpf(1.f + __expf(-x)); }
DI float silu(float x) { return x * sigm(x); }
DI u32x4 pack8(f32x4 a, f32x4 b) { u32x4 w; w.x = cvt_pk_bf16(a[0], a[1]); w.y = cvt_pk_bf16(a[2], a[3]); w.z = cvt_pk_bf16(b[0], b[1]); w.w = cvt_pk_bf16(b[2], b[3]); return w; }
DI u32x2 pack4(f32x4 a) { u32x2 w; w.x = cvt_pk_bf16(a[0], a[1]); w.y = cvt_pk_bf16(a[2], a[3]); return w; }
DI f32x4 gelu4(f32x4 v) { f32x2 a = gelu_pk((f32x2){v[0], v[1]}), b = gelu_pk((f32x2){v[2], v[3]}); return (f32x4){a.x, a.y, b.x, b.y}; }
DI float rstd_of(float ss, float inv_n) { return __builtin_amdgcn_rsqf(ss * inv_n + EPS); }
DI float softplus(float v) { return v > 20.f ? v : log1pf(__expf(v)); }

struct EpiGLU {
    static constexpr bool PERM = true, AFTER_DRAIN = false; static constexpr int NSEG = 1; static constexpr bool HALFB = false;
    const float* ss; bf16_t* O;
    DI void operator()(const f32x4 (&acc)[2][2][4][2], const Unit& u, int wr, int wc, int fr, int fq) const {
        const int col = u.pn * 128 + wc * 32 + 8 * fq;
#pragma unroll
        for (int ai = 0; ai < 2; ++ai)
#pragma unroll
            for (int m = 0; m < 4; ++m) {
                const int row = u.pm * 256 + ai * 128 + wr * 64 + m * 16 + fr;
                const float r = rstd_of(ss[row], 1.f / 1024.f);
                f32x4 o[2];
#pragma unroll
                for (int n = 0; n < 2; ++n)
#pragma unroll
                    for (int e = 0; e < 4; ++e) o[n][e] = silu(acc[ai][0][m][n][e] * r) * (acc[ai][1][m][n][e] * r);
                *(u32x4*)(O + (size_t)row * FF + col) = pack8(o[0], o[1]);
            }
    }
};
template <bool RES_BF16> struct EpiRes {
    static constexpr bool PERM = true, AFTER_DRAIN = false, HALFB = false; static constexpr int NSEG = 1;
    const float* resid; const bf16_t* residb; bf16_t* hb; float* ssout; float alpha;
    DI void operator()(const f32x4 (&acc)[2][2][4][2], const Unit& u, int wr, int wc, int fr, int fq) const {
#pragma unroll
        for (int ai = 0; ai < 2; ++ai)
#pragma unroll
            for (int m = 0; m < 4; ++m) {
                const int row = u.pm * 256 + ai * 128 + wr * 64 + m * 16 + fr;
                float sq = 0.f;
#pragma unroll
                for (int bj = 0; bj < 2; ++bj) {
                    const size_t off = (size_t)row * DM + u.pn * 256 + bj * 128 + wc * 32 + 8 * fq;
                    f32x4 r0, r1;
                    if (RES_BF16) { const u32x4 rb = *(const u32x4*)(residb + off); r0 = (f32x4){bflo(rb[0]), bfhi(rb[0]), bflo(rb[1]), bfhi(rb[1])}; r1 = (f32x4){bflo(rb[2]), bfhi(rb[2]), bflo(rb[3]), bfhi(rb[3])}; }
                    else { r0 = __builtin_nontemporal_load((const f32x4*)(resid + off)); r1 = __builtin_nontemporal_load((const f32x4*)(resid + off + 4)); }
                    const f32x4 v0 = r0 + acc[ai][bj][m][0] * alpha, v1 = r1 + acc[ai][bj][m][1] * alpha;
                    *(u32x4*)(hb + off) = pack8(v0, v1);
                    sq += (v0[0] * v0[0] + v0[1] * v0[1]) + (v0[2] * v0[2] + v0[3] * v0[3]) + (v1[0] * v1[0] + v1[1] * v1[1]) + (v1[2] * v1[2] + v1[3] * v1[3]);
                }
                sq += __shfl_xor(sq, 16); sq += __shfl_xor(sq, 32);
                if (fq == 0) atomicAdd(ssout + row, sq);
            }
    }
};
struct EpiResNorm {
    static constexpr bool PERM = true, AFTER_DRAIN = false, HALFB = false; static constexpr int NSEG = 1;
    const bf16_t* residb; float* out; float* ss; unsigned* cnt; const float* gain; float alpha;
    DI void operator()(f32x4 (&acc)[2][2][4][2], const Unit& u, int wr, int wc, int fr, int fq) const {
#pragma unroll
        for (int ai = 0; ai < 2; ++ai)
#pragma unroll
            for (int m = 0; m < 4; ++m) {
                const int row = u.pm * 256 + ai * 128 + wr * 64 + m * 16 + fr;
                float sq = 0.f;
#pragma unroll
                for (int bj = 0; bj < 2; ++bj) {
                    const size_t off = (size_t)row * DM + u.pn * 256 + bj * 128 + wc * 32 + 8 * fq;
                    const u32x4 rb = __builtin_nontemporal_load((const u32x4*)(residb + off));
                    const f32x4 v0 = (f32x4){bflo(rb[0]), bfhi(rb[0]), bflo(rb[1]), bfhi(rb[1])} + acc[ai][bj][m][0] * alpha, v1 = (f32x4){bflo(rb[2]), bfhi(rb[2]), bflo(rb[3]), bfhi(rb[3])} + acc[ai][bj][m][1] * alpha;
                    acc[ai][bj][m][0] = v0; acc[ai][bj][m][1] = v1;
                    sq += (v0[0] * v0[0] + v0[1] * v0[1]) + (v0[2] * v0[2] + v0[3] * v0[3]) + (v1[0] * v1[0] + v1[1] * v1[1]) + (v1[2] * v1[2] + v1[3] * v1[3]);
                }
                sq += __shfl_xor(sq, 16); sq += __shfl_xor(sq, 32);
                if (fq == 0) atomicAdd(ss + row, sq);
            }
        asm volatile("s_waitcnt vmcnt(0)" ::: "memory");
        __syncthreads();
        if (threadIdx.x == 0) {
            unsigned* c = cnt + 64 * u.pm;
            (void)__hip_atomic_fetch_add(c, 1u, __ATOMIC_RELAXED, __HIP_MEMORY_SCOPE_AGENT);
            unsigned sp = 0;
            while (__hip_atomic_load(c, __ATOMIC_RELAXED, __HIP_MEMORY_SCOPE_AGENT) < 4u) { __builtin_amdgcn_s_sleep(1); if (++sp > (1u << 20)) break; }
        }
        __syncthreads();
#pragma unroll
        for (int ai = 0; ai < 2; ++ai)
#pragma unroll
            for (int m = 0; m < 4; ++m) {
                const int row = u.pm * 256 + ai * 128 + wr * 64 + m * 16 + fr;
                const float r = rstd_of(__hip_atomic_load(ss + row, __ATOMIC_RELAXED, __HIP_MEMORY_SCOPE_AGENT), 1.f / 1024.f);
#pragma unroll
                for (int bj = 0; bj < 2; ++bj) {
                    const int col = u.pn * 256 + bj * 128 + wc * 32 + 8 * fq;
                    const f32x4 g0 = *(const f32x4*)(gain + col), g1 = *(const f32x4*)(gain + col + 4);
                    __builtin_nontemporal_store(acc[ai][bj][m][0] * r * g0, (f32x4*)(out + (size_t)row * DM + col)); __builtin_nontemporal_store(acc[ai][bj][m][1] * r * g1, (f32x4*)(out + (size_t)row * DM + col + 4));
                }
            }
    }
};
struct EpiWin {
    static constexpr bool PERM = true, AFTER_DRAIN = false; static constexpr int NSEG = 1; static constexpr bool HALFB = false;
    int row_base; const float* ss; bf16_t* zuq; bf16_t* xbc; bf16_t* gv; float* dt; const float* dt_bias; float* ssv;
    template <int KIND> DI void body(const f32x4 (&acc)[2][2][4][2], const Unit& u, int wr, int wc, int fr, int fq) const {
        const int pn = u.pn, cw = wc * 32 + 8 * fq;
#pragma unroll
        for (int ai = 0; ai < 2; ++ai)
#pragma unroll
            for (int m = 0; m < 4; ++m) {
                const int lr = u.pm * 256 + ai * 128 + wr * 64 + m * 16 + fr, gr = row_base + lr;
                const float r = rstd_of(ss[gr], 1.f / 1024.f);
                if (KIND == 0) {
#pragma unroll
                    for (int bj = 0; bj < 2; ++bj) { f32x4 a, b;
#pragma unroll
                        for (int e = 0; e < 4; ++e) { a[e] = silu(acc[ai][bj][m][0][e] * r); b[e] = silu(acc[ai][bj][m][1][e] * r); }
                        *(u32x4*)(zuq + (size_t)lr * ZUQ_LD + pn * 256 + bj * 128 + cw) = pack8(a, b); }
                } else if (KIND == 1) {
#pragma unroll
                    for (int bj = 0; bj < 2; ++bj) { f32x4 a = gelu4(acc[ai][bj][m][0] * r), b = gelu4(acc[ai][bj][m][1] * r);
                        *(u32x4*)(zuq + (size_t)lr * ZUQ_LD + pn * 256 + bj * 128 + cw) = pack8(a, b); }
                } else if (KIND == 2) {
#pragma unroll
                    for (int bj = 0; bj < 2; ++bj) { f32x4 a = acc[ai][bj][m][0] * (r * QSCALE), b = acc[ai][bj][m][1] * (r * QSCALE);
                        *(u32x4*)(zuq + (size_t)lr * ZUQ_LD + pn * 256 + bj * 128 + cw) = pack8(a, b); }
                } else if (KIND == 3) {
#pragma unroll
                    for (int bj = 0; bj < 2; ++bj) { f32x4 a = acc[ai][bj][m][0] * r, b = acc[ai][bj][m][1] * r;
                        *(u32x4*)(xbc + (size_t)lr * XBC_LD + (pn - 13) * 256 + bj * 128 + cw) = pack8(a, b); }
                } else if (KIND == 4) {
                    float sq = 0.f;
#pragma unroll
                    for (int bj = 0; bj < 2; ++bj) { f32x4 a = gelu4(acc[ai][bj][m][0] * r), b = gelu4(acc[ai][bj][m][1] * r);
                        sq += (a[0] * a[0] + a[1] * a[1]) + (a[2] * a[2] + a[3] * a[3]) + (b[0] * b[0] + b[1] * b[1]) + (b[2] * b[2] + b[3] * b[3]);
                        *(u32x4*)(gv + (size_t)lr * DM + (pn - 25) * 256 + bj * 128 + cw) = pack8(a, b); }
                    sq += __shfl_xor(sq, 16); sq += __shfl_xor(sq, 32);
                    if (fq == 0) atomicAdd(ssv + gr, sq);
                } else {
                    if (wc == 0) {
#pragma unroll
                        for (int n = 0; n < 2; ++n) { f32x4 o;
#pragma unroll
                            for (int e = 0; e < 4; ++e) o[e] = softplus(acc[ai][0][m][n][e] * r + dt_bias[8 * fq + 4 * n + e]);
                            *(f32x4*)(dt + (size_t)gr * 32 + 8 * fq + 4 * n) = o; }
                    }
                }
            }
    }
    DI void operator()(const f32x4 (&acc)[2][2][4][2], const Unit& u, int wr, int wc, int fr, int fq) const {
        const int pn = u.pn;
        if (pn < 8) body<0>(acc, u, wr, wc, fr, fq); else if (pn < 12) body<1>(acc, u, wr, wc, fr, fq); else if (pn == 12) body<2>(acc, u, wr, wc, fr, fq);
        else if (pn < 25) body<3>(acc, u, wr, wc, fr, fq); else if (pn < 29) body<4>(acc, u, wr, wc, fr, fq); else body<5>(acc, u, wr, wc, fr, fq);
    }
};
struct EpiGates {
    static constexpr bool PERM = true, AFTER_DRAIN = false; static constexpr int NSEG = 1; static constexpr bool HALFB = false;
    int row_base; const float* ss; bf16_t* O;
    DI void operator()(const f32x4 (&acc)[2][2][4][2], const Unit& u, int wr, int wc, int fr, int fq) const {
#pragma unroll
        for (int ai = 0; ai < 2; ++ai)
#pragma unroll
            for (int m = 0; m < 4; ++m) {
                const int lr = u.pm * 256 + ai * 128 + wr * 64 + m * 16 + fr;
                const float r = rstd_of(ss[row_base + lr], 1.f / 1024.f);
#pragma unroll
                for (int bj = 0; bj < 2; ++bj) { f32x4 a, b;
#pragma unroll
                    for (int e = 0; e < 4; ++e) { a[e] = sigm(acc[ai][bj][m][0][e] * r); b[e] = sigm(acc[ai][bj][m][1][e] * r); }
                    *(u32x4*)(O + (size_t)lr * GATE_LD + u.pn * 256 + bj * 128 + wc * 32 + 8 * fq) = pack8(a, b); }
            }
    }
};
struct EpiMerge {
    static constexpr bool PERM = true, AFTER_DRAIN = false, HALFB = true; static constexpr int NSEG = 3;
    const bf16_t* gates; bf16_t* run; bf16_t* O;
    static DI int seg_koff(int s) { return s == 0 ? 0 : (s == 1 ? 2048 : 3072); }
    static DI int seg_nt(int s) { return s == 0 ? 32 : (s == 1 ? 16 : 4); }
    DI void seg(const f32x4 (&acc)[2][2][4][2], const Unit& u, int wr, int wc, int fr, int fq) const {
        const int row0 = u.pm * 256 + wr * 64 + fr, cw = u.pn * 128 + wc * 32 + 8 * fq, s = u.seg;
#pragma unroll
        for (int ai = 0; ai < 2; ++ai)
#pragma unroll
            for (int m = 0; m < 4; ++m) {
                const int row = row0 + ai * 128 + m * 16;
                const u32x4 G = *(const u32x4*)(gates + (size_t)row * GATE_LD + s * 1024 + cw);
                bf16_t* rp = run + (size_t)row * DM + cw;
                f32x4 a = (f32x4){0.f, 0.f, 0.f, 0.f}, b = a;
                if (s > 0) { const u32x4 rv = *(const u32x4*)rp; a = (f32x4){bflo(rv[0]), bfhi(rv[0]), bflo(rv[1]), bfhi(rv[1])}; b = (f32x4){bflo(rv[2]), bfhi(rv[2]), bflo(rv[3]), bfhi(rv[3])}; }
                a[0] += acc[ai][0][m][0][0] * bflo(G[0]); a[1] += acc[ai][0][m][0][1] * bfhi(G[0]); a[2] += acc[ai][0][m][0][2] * bflo(G[1]); a[3] += acc[ai][0][m][0][3] * bfhi(G[1]);
                b[0] += acc[ai][0][m][1][0] * bflo(G[2]); b[1] += acc[ai][0][m][1][1] * bfhi(G[2]); b[2] += acc[ai][0][m][1][2] * bflo(G[3]); b[3] += acc[ai][0][m][1][3] * bfhi(G[3]);
                *(u32x4*)rp = pack8(a, b);
            }
    }
    DI void operator()(const f32x4 (&acc)[2][2][4][2], const Unit& u, int wr, int wc, int fr, int fq) const {
        const int row0 = u.pm * 256 + wr * 64 + fr, cw = u.pn * 128 + wc * 32 + 8 * fq;
#pragma unroll
        for (int ai = 0; ai < 2; ++ai)
#pragma unroll
            for (int m = 0; m < 4; ++m) {
                const int row = row0 + ai * 128 + m * 16;
                const u32x4 G = *(const u32x4*)(gates + (size_t)row * GATE_LD + 2048 + cw);
                const u32x4 rv = *(const u32x4*)(run + (size_t)row * DM + cw);
                f32x4 a = (f32x4){bflo(rv[0]), bfhi(rv[0]), bflo(rv[1]), bfhi(rv[1])}, b = (f32x4){bflo(rv[2]), bfhi(rv[2]), bflo(rv[3]), bfhi(rv[3])};
                a[0] += acc[ai][0][m][0][0] * bflo(G[0]); a[1] += acc[ai][0][m][0][1] * bfhi(G[0]); a[2] += acc[ai][0][m][0][2] * bflo(G[1]); a[3] += acc[ai][0][m][0][3] * bfhi(G[1]);
                b[0] += acc[ai][0][m][1][0] * bflo(G[2]); b[1] += acc[ai][0][m][1][1] * bfhi(G[2]); b[2] += acc[ai][0][m][1][2] * bflo(G[3]); b[3] += acc[ai][0][m][1][3] * bfhi(G[3]);
                *(u32x4*)(O + (size_t)row * DM + cw) = pack8(a, b);
            }
    }
};

struct Frame {
    lptr lds; unsigned char* ws; const float* const* in; float* out;
    int tid, lane, wave, G, bid;
};
struct Args { const float* in[28]; float* out; unsigned char* ws; int ph_lo, ph_hi; };
enum { I_X = 0, I_MEM, I_F1N, I_F1G, I_F1U, I_F1D, I_MIXN, I_MEMN, I_WIN, I_CONVW, I_CONVB, I_DTB, I_ALOG, I_SSDD, I_SSDN, I_GVN, I_GWS, I_GBS, I_WKV, I_WBS, I_WBG, I_WBM, I_WOUT, I_F2N, I_F2G, I_F2U, I_F2D, I_FINN };

#define LDS_WAIT() asm volatile("s_waitcnt lgkmcnt(0)" ::: "memory")

#define XB_TMO      128
#define XB_XCNT(j)  (256  + 64 * (j))
#define XB_XSUB(j)  (1280 + 64 * (j))
#define XB_XGEN(j)  (2304 + 64 * (j))
#define XB_TOP      3328
#define XB_TOPGEN   3392
#define XCD_BAR_WORDS 3456
#define XB_SPIN_CAP (1u << 18)

__device__ __forceinline__ unsigned xb_ld(unsigned* p)              { return __hip_atomic_load(p, __ATOMIC_RELAXED, __HIP_MEMORY_SCOPE_AGENT); }
__device__ __forceinline__ unsigned xb_add(unsigned* p, unsigned v) { return __hip_atomic_fetch_add(p, v, __ATOMIC_RELAXED, __HIP_MEMORY_SCOPE_AGENT); }
__device__ __forceinline__ unsigned xb_xcc_id() { return (unsigned)__builtin_amdgcn_s_getreg((3 << 11) | 20) & 0xFu; }
#define XB_SPIN(cond, bar) do { unsigned _sp = 0; while (cond) { __builtin_amdgcn_s_sleep(1); \
    if ((++_sp & 255u) == 0u) { if (xb_ld(&(bar)[XB_TMO])) break; if (_sp > XB_SPIN_CAP) { atomicAdd(&(bar)[XB_TMO], 1u); break; } } } } while (0)

struct XcdBarrier {
    unsigned* bar; unsigned x;
    volatile LAS unsigned* st;
};

__device__ __forceinline__ XcdBarrier xcd_barrier_post(unsigned* bar, volatile LAS unsigned* st) {
    XcdBarrier b; b.bar = bar; b.x = xb_xcc_id(); b.st = st;
    if (threadIdx.x == 0) (void)xb_add(&bar[XB_XCNT(b.x)], 1u);
    return b;
}
__device__ __forceinline__ void xcd_barrier_complete(unsigned* bar, unsigned x, unsigned& nloc, unsigned& nx) {
    const unsigned G = gridDim.x * gridDim.y * gridDim.z;
    unsigned sum, cnt, mine, sp = 0u;
    for (;;) {
        sum = 0u; cnt = 0u; mine = 0u;
#pragma unroll
        for (unsigned j = 0; j < 16; ++j) { const unsigned c = xb_ld(&bar[XB_XCNT(j)]); sum += c; cnt += (c > 0u) ? 1u : 0u; mine = (j == x) ? c : mine; }
        if (sum == G) break;
        __builtin_amdgcn_s_sleep(1);
        if ((++sp & 255u) == 0u) { if (xb_ld(&bar[XB_TMO])) break; if (sp > XB_SPIN_CAP) { atomicAdd(&bar[XB_TMO], 1u); break; } }
    }
    nloc = mine > 0u ? mine : 1u; nx = cnt > 0u ? cnt : 1u;
}

__device__ __forceinline__ void xcd_barrier(const XcdBarrier& b) {
    asm volatile("s_waitcnt vmcnt(0)" ::: "memory");
    __syncthreads();
    if (threadIdx.x == 0) {
        unsigned* bar = b.bar;
        __builtin_amdgcn_s_waitcnt(0);
        unsigned nloc = b.st[0], nx = b.st[1];
        if (nloc == 0u) { xcd_barrier_complete(bar, b.x, nloc, nx); b.st[0] = nloc; b.st[1] = nx; }
        const unsigned old = xb_add(&bar[XB_XSUB(b.x)], 1u);
        const unsigned gen = old / nloc;
        if (old + 1u == (gen + 1u) * nloc) {
            __builtin_amdgcn_fence(__ATOMIC_RELEASE, "agent");
            asm volatile("s_waitcnt vmcnt(0)" ::: "memory");
            const unsigned og = xb_add(&bar[XB_TOP], 1u);
            const unsigned tg = og / nx;
            if (og + 1u == (tg + 1u) * nx) xb_add(&bar[XB_TOPGEN], 1u);
            else XB_SPIN(xb_ld(&bar[XB_TOPGEN]) == tg, bar);
            __builtin_amdgcn_fence(__ATOMIC_ACQUIRE, "agent");
            xb_add(&bar[XB_XGEN(b.x)], 1u);
            asm volatile("s_waitcnt vmcnt(0)" ::: "memory");
        } else {
            XB_SPIN(xb_ld(&bar[XB_XGEN(b.x)]) == gen, bar);
            __builtin_amdgcn_fence(__ATOMIC_ACQUIRE, "agent");
            asm volatile("s_waitcnt vmcnt(0)" ::: "memory");
        }
    }
    __syncthreads();
}


DI void tr_item(const float* W, int ldw, int col0, bf16_t* WT, int ldt, int dcol0, int drow0, const float* gain, LAS float* scr, int kb, int lane) {
    const int k0 = 64 * kb;
    float tv[32];
    const float* wp = W + (size_t)(k0 + (lane >> 5)) * ldw + col0 + (lane & 31);
#pragma unroll
    for (int i = 0; i < 32; ++i) tv[i] = __builtin_nontemporal_load(wp + (size_t)(2 * i) * ldw);
    if (gain) {
#pragma unroll
        for (int i = 0; i < 32; ++i) tv[i] *= gain[k0 + 2 * i + (lane >> 5)];
    }
#pragma unroll
    for (int i = 0; i < 32; ++i) scr[(2 * i + (lane >> 5)) * 33 + (lane & 31)] = tv[i];
    LDS_WAIT();
    const int c = lane & 7;
#pragma unroll
    for (int j = 0; j < 4; ++j) { const int n = (lane >> 3) + 8 * j; const LAS float* s = scr + (8 * c) * 33 + n;
        u32x4 o; o.x = cvt_pk_bf16(s[0 * 33], s[1 * 33]); o.y = cvt_pk_bf16(s[2 * 33], s[3 * 33]); o.z = cvt_pk_bf16(s[4 * 33], s[5 * 33]); o.w = cvt_pk_bf16(s[6 * 33], s[7 * 33]);
        *(u32x4*)(WT + (size_t)(drow0 + n) * ldt + dcol0 + k0 + 8 * c) = o; }
    LDS_WAIT();
}
DI void kv_item(const Frame& F, int item) {
    const int rt = item >> 3, ct = item & 7, r0 = rt * 64, c0 = ct * 64, tid = F.tid, lane = F.lane, w = F.wave, fr = lane & 15, fq = lane >> 4;
    lptr As = F.lds, Bs = F.lds + 64 * PT; LAS float* rs = (LAS float*)(F.lds + 128 * PT);
    const float* mem = F.in[I_MEM]; const float* W = F.in[I_WKV]; const float* gain = F.in[I_MEMN];
    bf16_t* Kmem = (bf16_t*)(F.ws + WS_KMEM); bf16_t* VmemT = (bf16_t*)(F.ws + WS_VMEMT);
    const int ar = tid >> 3, ka = (tid & 7) * 16;
    const int kb = tid >> 2, nb = (tid & 3) * 16;
    const float* pa = mem + (size_t)(r0 + ar) * 1024 + ka; const float* pb = W + (size_t)kb * 512 + c0 + nb;
    float sq = 0.f;
    f32x4 acc[2]; acc[0] = (f32x4){0.f, 0.f, 0.f, 0.f}; acc[1] = acc[0];
    const bool ktype = ct < 4;
    f32x4 va[4], vb[4]; float gk;
#pragma unroll
    for (int i = 0; i < 4; ++i) { va[i] = *(const f32x4*)(pa + 4 * i); vb[i] = *(const f32x4*)(pb + 4 * i); }
    gk = gain[kb];
    for (int kc = 0; kc < 8; ++kc) {
#pragma unroll
        for (int i = 0; i < 4; ++i) sq += (va[i][0] * va[i][0] + va[i][1] * va[i][1]) + (va[i][2] * va[i][2] + va[i][3] * va[i][3]);
        *(LAS u32x4*)(As + ar * PT + ka * 2) = pack8(va[0], va[1]); *(LAS u32x4*)(As + ar * PT + ka * 2 + 16) = pack8(va[2], va[3]);
#pragma unroll
        for (int i = 0; i < 4; ++i) { const u32x2 pk = pack4(vb[i] * gk);
            *(LAS unsigned short*)(Bs + (nb + 4 * i + 0) * PT + kb * 2) = (unsigned short)(pk[0] & 0xffffu); *(LAS unsigned short*)(Bs + (nb + 4 * i + 1) * PT + kb * 2) = (unsigned short)(pk[0] >> 16);
            *(LAS unsigned short*)(Bs + (nb + 4 * i + 2) * PT + kb * 2) = (unsigned short)(pk[1] & 0xffffu); *(LAS unsigned short*)(Bs + (nb + 4 * i + 3) * PT + kb * 2) = (unsigned short)(pk[1] >> 16); }
        if (kc < 7) {
#pragma unroll
            for (int i = 0; i < 4; ++i) { va[i] = *(const f32x4*)(pa + (kc + 1) * 128 + 4 * i); vb[i] = *(const f32x4*)(pb + (size_t)(kc + 1) * 128 * 512 + 4 * i); }
            gk = gain[(kc + 1) * 128 + kb];
        }
        __syncthreads();
#pragma unroll
        for (int ks = 0; ks < 4; ++ks) {
            if (ktype) { const bf16x8 yf = *(const LAS bf16x8*)(As + (16 * (w >> 1) + fr) * PT + ks * 64 + fq * 16);
#pragma unroll
                for (int i = 0; i < 2; ++i) { const bf16x8 xf = *(const LAS bf16x8*)(Bs + (16 * ((w & 1) * 2 + i) + fr) * PT + ks * 64 + fq * 16); acc[i] = MFMA16(xf, yf, acc[i]); } }
            else { const bf16x8 yf = *(const LAS bf16x8*)(Bs + (16 * (w >> 1) + fr) * PT + ks * 64 + fq * 16);
#pragma unroll
                for (int i = 0; i < 2; ++i) { const bf16x8 xf = *(const LAS bf16x8*)(As + (16 * ((w & 1) * 2 + i) + fr) * PT + ks * 64 + fq * 16); acc[i] = MFMA16(xf, yf, acc[i]); } }
        }
        __syncthreads();
    }
    sq += __shfl_xor(sq, 1); sq += __shfl_xor(sq, 2); sq += __shfl_xor(sq, 4);
    if ((tid & 7) == 0) rs[ar] = rstd_of(sq, 1.f / 1024.f);
    __syncthreads();
    if (ktype) { const int tok = 16 * (w >> 1) + fr; const float r = rs[tok];
#pragma unroll
        for (int i = 0; i < 2; ++i) { const int ch = c0 + 16 * ((w & 1) * 2 + i) + 4 * fq; *(u32x2*)(Kmem + (size_t)(r0 + tok) * 256 + ch) = pack4(acc[i] * r); } }
    else { const int ch = c0 - 256 + 16 * (w >> 1) + fr;
#pragma unroll
        for (int i = 0; i < 2; ++i) { const int tok = 16 * ((w & 1) * 2 + i) + 4 * fq; f32x4 o;
#pragma unroll
            for (int e = 0; e < 4; ++e) o[e] = acc[i][e] * rs[tok + e];
            const int row = r0 + tok; *(u32x2*)(VmemT + (size_t)((row >> 8) * 256 + ch) * 256 + (row & 255)) = pack4(o); } }
    __syncthreads();
}
DI float wave_sum(float v) {
#pragma unroll
    for (int o = 1; o < 64; o <<= 1) v += __shfl_xor(v, o);
    return v;
}
#define SEG(Wp, ldw, c0, nc, Kk, WTp, ldt, dc0, gn, MAP) { const int nblk = (nc) / 32, cnt = ((Kk) / 64) * nblk; if (r < cnt) { const int kb = r / nblk, n0 = (r % nblk) * 32; \
        tr_item(Wp, ldw, (c0) + n0, WTp, ldt, dc0, (MAP), gn, scr, kb, lane); continue; } r -= cnt; }
DI void prologue(const Frame& F) {
    unsigned char* ws = F.ws;
    { u32x4* z = (u32x4*)(ws + WS_SS2); const int n = (int)((WS_CDEC - WS_SS2) / 16); for (int i = F.bid * 512 + F.tid; i < n; i += F.G * 512) z[i] = (u32x4){0u, 0u, 0u, 0u}; }
    LAS float* scr = (LAS float*)(F.lds + F.wave * 16384);
    const int gw = F.bid * 8 + F.wave, NGW = F.G * 8, lane = F.lane;
    bf16_t* W1GU = (bf16_t*)(ws + WS_W1GU);
    bf16_t* W1D = (bf16_t*)(ws + WS_W1D); bf16_t* WIN = (bf16_t*)(ws + WS_WIN);
    constexpr int NITEMS = 3 * 1408 + 16 * ((2048 + 1024 + 256 + 3072) / 32);
    for (int it = gw; it < NITEMS; it += NGW) {
        int r = it;
        SEG(F.in[I_F1G], FF, 0, FF, 1024, W1GU, 1024, 0, F.in[I_F1N], (n0 / 128) * 256 + (n0 % 128))
        SEG(F.in[I_F1U], FF, 0, FF, 1024, W1GU, 1024, 0, F.in[I_F1N], (n0 / 128) * 256 + 128 + (n0 % 128))
        SEG(F.in[I_F1D], 1024, 0, 1024, FF, W1D, FF, 0, (const float*)nullptr, n0)
        SEG(F.in[I_WIN], WIN_LD, 0, 2048, 1024, WIN, 1024, 0, F.in[I_MIXN], n0)
        SEG(F.in[I_WIN], WIN_LD, 5152, 1024, 1024, WIN, 1024, 0, F.in[I_MIXN], 2048 + n0)
        SEG(F.in[I_WIN], WIN_LD, 7200, 256, 1024, WIN, 1024, 0, F.in[I_MIXN], 3072 + n0)
        SEG(F.in[I_WIN], WIN_LD, 2048, 3072, 1024, WIN, 1024, 0, F.in[I_MIXN], 3328 + n0)
    }
    const float* x = F.in[I_X]; bf16_t* hb = (bf16_t*)(ws + WS_HB); float* ss1 = (float*)(ws + WS_SS1);
    for (int m = 2 * gw; m < T; m += 2 * NGW) {
        const f32x4* xr = (const f32x4*)(x + (size_t)m * DM) + lane; float s0 = 0.f, s1 = 0.f; f32x4 v[8];
#pragma unroll
        for (int j = 0; j < 8; ++j) v[j] = __builtin_nontemporal_load(xr + 64 * j);
#pragma unroll
        for (int j = 0; j < 4; ++j) { s0 += (v[j][0] * v[j][0] + v[j][1] * v[j][1]) + (v[j][2] * v[j][2] + v[j][3] * v[j][3]); s1 += (v[4 + j][0] * v[4 + j][0] + v[4 + j][1] * v[4 + j][1]) + (v[4 + j][2] * v[4 + j][2] + v[4 + j][3] * v[4 + j][3]); }
        s0 = wave_sum(s0); s1 = wave_sum(s1); if (lane == 0) { ss1[m] = s0; ss1[m + 1] = s1; }
        u32x2* o = (u32x2*)(hb + (size_t)m * DM) + lane;
#pragma unroll
        for (int j = 0; j < 8; ++j) o[64 * j] = pack4(v[j]);
    }
}
DI void mid_convert(const Frame& F, int first_blk) {
    unsigned char* ws = F.ws;
    if (F.bid - first_blk < 64) kv_item(F, F.bid - first_blk);
    LAS float* scr = (LAS float*)(F.lds + F.wave * 16384); const int lane = F.lane;
    const int nconv = F.G - first_blk - 64;
    if (nconv > 0 && F.bid - first_blk < 64) return;
    const int gw = (nconv > 0 ? F.bid - first_blk - 64 : F.bid - first_blk) * 8 + F.wave, NGW = (nconv > 0 ? nconv : F.G - first_blk) * 8;
    bf16_t* W1D = (bf16_t*)(ws + WS_W1D); bf16_t* WIN = (bf16_t*)(ws + WS_WIN); bf16_t* WG = (bf16_t*)(ws + WS_WG); bf16_t* WBR = (bf16_t*)(ws + WS_WBR);
    constexpr int NITEMS = 16 * ((1024 + 32) / 32) + 16 * 96 + (32 + 16 + 4) * 32;
    for (int it = gw; it < NITEMS; it += NGW) {
        int r = it;
        SEG(F.in[I_WIN], WIN_LD, 6176, 1024, 1024, WIN, 1024, 0, F.in[I_MIXN], 6400 + n0)
        SEG(F.in[I_WIN], WIN_LD, 5120, 32, 1024, WIN, 1024, 0, F.in[I_MIXN], 7424 + n0)
        SEG(F.in[I_WIN], WIN_LD, 7456, 3072, 1024, WG, 1024, 0, F.in[I_MIXN], n0)
        SEG(F.in[I_WBS], 1024, 0, 1024, 2048, WBR, KBR, 0, F.in[I_SSDN], n0)
        SEG(F.in[I_WBG], 1024, 0, 1024, 1024, WBR, KBR, 2048, (const float*)nullptr, n0)
        SEG(F.in[I_WBM], 1024, 0, 1024, 256, WBR, KBR, 3072, (const float*)nullptr, n0)
    }
}
DI void late_convert(const Frame& F, int first_blk) {
    unsigned char* ws = F.ws; LAS float* scr = (LAS float*)(F.lds + F.wave * 16384); const int lane = F.lane;
    const int gw = (F.bid - first_blk) * 8 + F.wave, NGW = (F.G - first_blk) * 8;
    bf16_t* W2GU = (bf16_t*)(ws + WS_W2GU); bf16_t* W2D = (bf16_t*)(ws + WS_W2D); bf16_t* WOUT = (bf16_t*)(ws + WS_WOUT);
    constexpr int NITEMS = (3 * 1408) + 512;
    for (int it = gw; it < NITEMS; it += NGW) {
        int r = it;
        SEG(F.in[I_F2G], FF, 0, FF, 1024, W2GU, 1024, 0, F.in[I_F2N], (n0 / 128) * 256 + (n0 % 128))
        SEG(F.in[I_F2U], FF, 0, FF, 1024, W2GU, 1024, 0, F.in[I_F2N], (n0 / 128) * 256 + 128 + (n0 % 128))
        SEG(F.in[I_F2D], 1024, 0, 1024, FF, W2D, FF, 0, (const float*)nullptr, n0)
        SEG(F.in[I_WOUT], 1024, 0, 1024, 1024, WOUT, 1024, 0, (const float*)nullptr, n0)
    }
}
DI void final_norm(const Frame& F) {
    const float* ss4 = (const float*)(F.ws + WS_SS4); const float* g = F.in[I_FINN];
    const int gw = F.bid * 8 + F.wave, NGW = F.G * 8, lane = F.lane;
    f32x4 gv[4];
#pragma unroll
    for (int j = 0; j < 4; ++j) gv[j] = ((const f32x4*)g)[lane + 64 * j];
    for (int m = gw; m < T; m += NGW) {
        f32x4* xr = (f32x4*)(F.out + (size_t)m * DM) + lane; const float r = rstd_of(ss4[m], 1.f / 1024.f);
#pragma unroll
        for (int j = 0; j < 4; ++j) xr[64 * j] = xr[64 * j] * r * gv[j];
    }
}

DI void ssd_scan_prep(const Frame& F, float d, int h0, LAS float* acs, LAS float* dts, LAS float* wtot) {
    const int hl = F.tid >> 7, l = F.tid & 127, h = h0 + hl;
    const float a = -__expf(F.in[I_ALOG][h]);
    float v = d * a;
#pragma unroll
    for (int o = 1; o < 64; o <<= 1) { const float t = __shfl_up(v, o); if (F.lane >= o) v += t; }
    if (F.lane == 63) wtot[F.wave] = v;
    __syncthreads();
    if (F.wave & 1) v += wtot[F.wave - 1];
    acs[hl * 128 + l] = v; dts[hl * 128 + l] = d;
    __syncthreads();
}
template <bool SCALED, int NCH> DI void stage_conv_T(lptr dst, const bf16_t* xbc, int t0, int chan0, const float* cw, const float* cb, const LAS float* scale, int tid) {
    constexpr int ncp = NCH >> 1, ntask = ncp * 16;
    static_assert(512 % ncp == 0, "a thread keeps its channel pair across tasks");
    const int cp = tid % ncp, ch = chan0 + 2 * cp;
    f32x2 w[4];
#pragma unroll
    for (int k = 0; k < 4; ++k) w[k] = *(const f32x2*)(cw + k * XBC_LD + ch);
    const f32x2 bias = *(const f32x2*)(cb + ch);
#pragma unroll 2
    for (int it_ = 0; it_ < ntask / 512; ++it_) { const int task = tid + 512 * it_;
        const int tb = task / ncp, l0 = tb * 8;
        f32x2 r[11];
#pragma unroll
        for (int i = 0; i < 11; ++i) { const int l = l0 - 3 + i; unsigned v = 0u; if (t0 + l >= 0) v = *(const unsigned*)(xbc + (long)(t0 + l) * XBC_LD + ch); r[i] = (f32x2){bflo(v), bfhi(v)}; }
        f32x4 o0[2], o1[2];
#pragma unroll
        for (int j = 0; j < 8; ++j) {
            f32x2 y = bias + w[0] * r[j] + w[1] * r[j + 1] + w[2] * r[j + 2] + w[3] * r[j + 3];
            f32x2 en = y * -1.4426950408889634f; en.x = __builtin_amdgcn_exp2f(en.x); en.y = __builtin_amdgcn_exp2f(en.y);
            f32x2 d = en + 1.0f; d.x = __builtin_amdgcn_rcpf(d.x); d.y = __builtin_amdgcn_rcpf(d.y);
            y = y * d;
            if (SCALED) { const float s = scale[((2 * cp) >> 6) * 128 + l0 + j]; y = y * s; }
            o0[j >> 2][j & 3] = y.x; o1[j >> 2][j & 3] = y.y;
        }
        *(LAS u32x4*)(dst + (2 * cp) * PT + l0 * 2) = pack8(o0[0], o0[1]);
        *(LAS u32x4*)(dst + (2 * cp + 1) * PT + l0 * 2) = pack8(o1[0], o1[1]);
    }
}
DI void stage_conv_N(lptr dst, const bf16_t* xbc, int t0, int chan0, const float* cw, const float* cb, int tid) {
    const int cg8 = (tid & 15) * 8, ch = chan0 + cg8;
    float w[4][8], b[8];
#pragma unroll
    for (int k = 0; k < 4; ++k) { const f32x4 a = *(const f32x4*)(cw + k * XBC_LD + ch), c = *(const f32x4*)(cw + k * XBC_LD + ch + 4);
#pragma unroll
        for (int e = 0; e < 4; ++e) { w[k][e] = a[e]; w[k][4 + e] = c[e]; } }
    { const f32x4 a = *(const f32x4*)(cb + ch), c = *(const f32x4*)(cb + ch + 4);
#pragma unroll
        for (int e = 0; e < 4; ++e) { b[e] = a[e]; b[4 + e] = c[e]; } }
#pragma unroll
    for (int i = 0; i < 4; ++i) {
        const int l = (tid >> 4) + 32 * i;
        float y[8];
#pragma unroll
        for (int e = 0; e < 8; ++e) y[e] = b[e];
#pragma unroll
        for (int k = 0; k < 4; ++k) { const int t = t0 + l - 3 + k; u32x4 v = (u32x4){0u, 0u, 0u, 0u}; if (t >= 0) v = *(const u32x4*)(xbc + (long)t * XBC_LD + ch);
#pragma unroll
            for (int q = 0; q < 4; ++q) { y[2 * q] += w[k][2 * q] * bflo(v[q]); y[2 * q + 1] += w[k][2 * q + 1] * bfhi(v[q]); } }
        f32x4 o0, o1;
#pragma unroll
        for (int e = 0; e < 4; ++e) { o0[e] = silu(y[e]); o1[e] = silu(y[4 + e]); }
        *(LAS u32x4*)(dst + l * PT + cg8 * 2) = pack8(o0, o1);
    }
}
struct Half { int b; bf16_t* zuq; bf16_t* xbc; bf16_t* gv; bf16_t* st; float* cdec; const float* dt; int row_base; };

#ifdef SPROBE
#define SECT(k) do { if (F.bid == 0 && threadIdx.x == 0) { volatile LAS unsigned long long* sp_ = (volatile LAS unsigned long long*)(F.lds + LDS_BYTES - 32); unsigned long long t_ = __builtin_amdgcn_s_memrealtime(); \
        if ((k) == SPROBE) { const unsigned long long d_ = (t_ - sp_[0]) * SPROBE_MULT; while (__builtin_amdgcn_s_memrealtime() - t_ < d_) __builtin_amdgcn_s_sleep(8); t_ = __builtin_amdgcn_s_memrealtime(); } sp_[0] = t_; } } while (0)
#else
#define SECT(k) do { } while (0)
#endif
DI void ssd_a_item(const Frame& F, const Half& H, int item) {
    const int c = item >> 3, g = (item >> 1) & 3, hh = item & 1, h0 = g * 8 + hh * 4, t0 = c * 128;
    lptr XT = F.lds, BT = F.lds + 69632; LAS float* acs = (LAS float*)(F.lds + 139264); LAS float* dts = acs + 512; LAS float* sc = dts + 512; LAS float* wtot = sc + 512;
    SECT(10);
    const float dpre = H.dt[(size_t)(H.row_base + t0 + (F.tid & 127)) * 32 + h0 + (F.tid >> 7)];
    stage_conv_T<false, 128>(BT, H.xbc, t0, 2048 + g * 128, F.in[I_CONVW], F.in[I_CONVB], nullptr, F.tid);
    ssd_scan_prep(F, dpre, h0, acs, dts, wtot);
    { const int hl = F.tid >> 7, l = F.tid & 127; const float last = acs[hl * 128 + 127]; sc[hl * 128 + l] = dts[hl * 128 + l] * __expf(last - acs[hl * 128 + l]);
      if (l == 127) H.cdec[c * 32 + h0 + hl] = __expf(last); }
    __syncthreads();
    SECT(11);
    stage_conv_T<true, 256>(XT, H.xbc, t0, g * 512 + hh * 256, F.in[I_CONVW], F.in[I_CONVB], sc, F.tid);
    __syncthreads();
    SECT(12);
    const int w = F.wave, hl = w >> 1, nh = w & 1, fr = F.lane & 15, fq = F.lane >> 4;
    f32x4 acc[4][4];
#pragma unroll
    for (int i = 0; i < 4; ++i)
#pragma unroll
        for (int j = 0; j < 4; ++j) acc[i][j] = (f32x4){0.f, 0.f, 0.f, 0.f};
#pragma unroll
    for (int ks = 0; ks < 4; ++ks) {
        bf16x8 xf[4], yf[4];
#pragma unroll
        for (int i = 0; i < 4; ++i) { xf[i] = *(const LAS bf16x8*)(BT + (nh * 64 + 16 * i + fr) * PT + ks * 64 + fq * 16); yf[i] = *(const LAS bf16x8*)(XT + (hl * 64 + 16 * i + fr) * PT + ks * 64 + fq * 16); }
#pragma unroll
        for (int i = 0; i < 4; ++i)
#pragma unroll
            for (int j = 0; j < 4; ++j) acc[i][j] = MFMA16(xf[i], yf[j], acc[i][j]);
    }
    bf16_t* dst = H.st + (size_t)(c * 32 + h0 + hl) * 8192;
    SECT(13);
#pragma unroll
    for (int i = 0; i < 4; ++i)
#pragma unroll
        for (int j = 0; j < 4; ++j) *(u32x2*)(dst + (16 * j + fr) * 128 + nh * 64 + 16 * i + 4 * fq) = pack4(acc[i][j]);
    __syncthreads();
    SECT(14);
}
template <int NP> DI void ssd_scan(const Frame& F, const Half& H, int nblk) {
    const int e0 = F.bid * 512 + F.tid;
    unsigned* p = (unsigned*)H.st + e0; float r0[NP], r1[NP];
#pragma unroll
    for (int q = 0; q < NP; ++q) { r0[q] = 0.f; r1[q] = 0.f; }
#pragma unroll 4
    for (int c = 0; c < 64; ++c) {
        unsigned wv[NP];
#pragma unroll
        for (int q = 0; q < NP; ++q) wv[q] = p[(size_t)c * 131072 + (size_t)q * nblk * 512];
#pragma unroll
        for (int q = 0; q < NP; ++q) { const int h = (e0 + q * nblk * 512) >> 12; const float dec = H.cdec[c * 32 + h];
            p[(size_t)c * 131072 + (size_t)q * nblk * 512] = cvt_pk_bf16(r0[q], r1[q]); r0[q] = r0[q] * dec + bflo(wv[q]); r1[q] = r1[q] * dec + bfhi(wv[q]); }
    }
}
DI void ssd_c_item(const Frame& F, const Half& H, int item) {
    const int c = item >> 2, g = item & 3, t0 = c * 128;
    lptr XT = F.lds, Cn = F.lds + 69632, Bn = F.lds + 104448; SECT(0); LAS float* acs = (LAS float*)(F.lds + 139264); LAS float* dts = acs + 512; LAS float* wtot = dts + 512; LAS float* tss = wtot + 16;
    float dpre[2];
#pragma unroll
    for (int q = 0; q < 2; ++q) dpre[q] = H.dt[(size_t)(H.row_base + t0 + (F.tid & 127)) * 32 + g * 8 + q * 4 + (F.tid >> 7)];
    stage_conv_N(Bn, H.xbc, t0, 2048 + g * 128, F.in[I_CONVW], F.in[I_CONVB], F.tid);
    stage_conv_N(Cn, H.xbc, t0, 2560 + g * 128, F.in[I_CONVW], F.in[I_CONVB], F.tid);
    __syncthreads();
    const int w = F.wave, fr = F.lane & 15, fq = F.lane >> 4;
    SECT(1);
    {
        const int lt0 = (w >> 1) * 2, st0 = (w & 1) * 4;
        f32x4 cb[4][2];
#pragma unroll
        for (int i = 0; i < 4; ++i) { cb[i][0] = (f32x4){0.f, 0.f, 0.f, 0.f}; cb[i][1] = cb[i][0]; }
#pragma unroll
        for (int ks = 0; ks < 4; ++ks) {
            bf16x8 xf[4], yf[2];
#pragma unroll
            for (int i = 0; i < 4; ++i) xf[i] = *(const LAS bf16x8*)(Bn + (16 * (st0 + i) + fr) * PT + ks * 64 + fq * 16);
#pragma unroll
            for (int j = 0; j < 2; ++j) yf[j] = *(const LAS bf16x8*)(Cn + (16 * (lt0 + j) + fr) * PT + ks * 64 + fq * 16);
#pragma unroll
            for (int i = 0; i < 4; ++i)
#pragma unroll
                for (int j = 0; j < 2; ++j) cb[i][j] = MFMA16(xf[i], yf[j], cb[i][j]);
        }
        __syncthreads();
#pragma unroll
        for (int i = 0; i < 4; ++i)
#pragma unroll
            for (int j = 0; j < 2; ++j) *(LAS u32x2*)(Bn + (16 * (lt0 + j) + fr) * PT + (16 * (st0 + i) + 4 * fq) * 2) = pack4(cb[i][j]);
    }
    SECT(2);
    const int hl = w >> 1, lh = w & 1;
#pragma unroll 1
    for (int hh = 0; hh < 2; ++hh) {
        const int h0 = g * 8 + hh * 4, h = h0 + hl;
        __syncthreads();
        ssd_scan_prep(F, hh ? dpre[1] : dpre[0], h0, acs, dts, wtot);
        SECT(3);
        stage_conv_T<false, 256>(XT, H.xbc, t0, g * 512 + hh * 256, F.in[I_CONVW], F.in[I_CONVB], nullptr, F.tid);
        __syncthreads();
        SECT(4);
        f32x4 accd[4][4];
#pragma unroll
        for (int i = 0; i < 4; ++i)
#pragma unroll
            for (int j = 0; j < 4; ++j) accd[i][j] = (f32x4){0.f, 0.f, 0.f, 0.f};
        const LAS float* ah = acs + hl * 128; const LAS float* dh = dts + hl * 128;
        const bf16_t* Sp = H.st + (size_t)(c * 32 + h) * 8192;
#pragma unroll
        for (int ks = 0; ks < 4; ++ks) {
            bf16x8 xf[4], yf[4];
#pragma unroll
            for (int i = 0; i < 4; ++i) { xf[i] = *(const bf16x8*)(Sp + (16 * i + fr) * 128 + ks * 32 + fq * 8); yf[i] = *(const LAS bf16x8*)(Cn + (lh * 64 + 16 * i + fr) * PT + ks * 64 + fq * 16); }
#pragma unroll
            for (int i = 0; i < 4; ++i)
#pragma unroll
                for (int j = 0; j < 4; ++j) accd[i][j] = MFMA16(xf[i], yf[j], accd[i][j]);
        }
#pragma unroll
        for (int j = 0; j < 4; ++j) { const float el = __expf(ah[lh * 64 + 16 * j + fr]);
#pragma unroll
            for (int i = 0; i < 4; ++i) accd[i][j] = accd[i][j] * el; }
        SECT(5);
        const int nks = lh ? 4 : 2;
        for (int ks = 0; ks < nks; ++ks) {
            bf16x8 xf[4], yf[4];
            const int s0 = ks * 32 + fq * 8;
            const f32x4 as0 = *(const LAS f32x4*)(ah + s0), as1 = *(const LAS f32x4*)(ah + s0 + 4), ds0 = *(const LAS f32x4*)(dh + s0), ds1 = *(const LAS f32x4*)(dh + s0 + 4);
#pragma unroll
            for (int j = 0; j < 4; ++j) {
                const int l = lh * 64 + 16 * j + fr; const float al = ah[l];
                const u32x4 cbv = *(const LAS u32x4*)(Bn + l * PT + s0 * 2);
                f32x4 o0, o1;
#pragma unroll
                for (int q = 0; q < 4; ++q) {
                    const int sa = s0 + 2 * q, sb = sa + 1;
                    const float asa = (q < 2) ? as0[2 * q] : as1[2 * q - 4], asb = (q < 2) ? as0[2 * q + 1] : as1[2 * q - 3];
                    const float dsa = (q < 2) ? ds0[2 * q] : ds1[2 * q - 4], dsb = (q < 2) ? ds0[2 * q + 1] : ds1[2 * q - 3];
                    const float va = (sa <= l) ? bflo(cbv[q]) * __expf(al - asa) * dsa : 0.f;
                    const float vb = (sb <= l) ? bfhi(cbv[q]) * __expf(al - asb) * dsb : 0.f;
                    if (q < 2) { o0[2 * q] = va; o0[2 * q + 1] = vb; } else { o1[2 * q - 4] = va; o1[2 * q - 3] = vb; }
                }
                yf[j] = __builtin_bit_cast(bf16x8, pack8(o0, o1));
            }
#pragma unroll
            for (int i = 0; i < 4; ++i) xf[i] = *(const LAS bf16x8*)(XT + (hl * 64 + 16 * i + fr) * PT + ks * 64 + fq * 16);
#pragma unroll
            for (int i = 0; i < 4; ++i)
#pragma unroll
                for (int j = 0; j < 4; ++j) accd[i][j] = MFMA16(xf[i], yf[j], accd[i][j]);
        }
        const float Dh = F.in[I_SSDD][h];
        SECT(6);
#pragma unroll
        for (int j = 0; j < 4; ++j) {
            const int l = lh * 64 + 16 * j + fr; float sq = 0.f;
            bf16_t* zr = H.zuq + (size_t)(t0 + l) * ZUQ_LD + h * 64;
#pragma unroll
            for (int i = 0; i < 4; ++i) {
                const int p = 16 * i + 4 * fq;
                const u32x2 zv = *(const u32x2*)(zr + p);
                f32x4 y;
#pragma unroll
                for (int e = 0; e < 4; ++e) { const float xv = __uint_as_float(((unsigned)*(const LAS unsigned short*)(XT + (hl * 64 + p + e) * PT + l * 2)) << 16); y[e] = accd[i][j][e] + Dh * xv; }
                y[0] *= bflo(zv[0]); y[1] *= bfhi(zv[0]); y[2] *= bflo(zv[1]); y[3] *= bfhi(zv[1]);
                sq += (y[0] * y[0] + y[1] * y[1]) + (y[2] * y[2] + y[3] * y[3]);
                *(u32x2*)(zr + p) = pack4(y);
            }
            sq += __shfl_xor(sq, 16); sq += __shfl_xor(sq, 32);
            if (fq == 0) tss[(hh * 4 + hl) * 128 + l] = sq;
        }
        SECT(7);
    }
    __syncthreads();
    {
        const int wv = F.wave, ln = F.lane;
        u32x4 v[16]; float r[16];
#pragma unroll
        for (int i = 0; i < 16; ++i) v[i] = *((const u32x4*)(H.zuq + (size_t)(t0 + wv * 16 + i) * ZUQ_LD + g * 512) + ln);
#pragma unroll
        for (int i = 0; i < 16; ++i) { float tsum = 0.f;
#pragma unroll
            for (int k = 0; k < 8; ++k) tsum += tss[k * 128 + wv * 16 + i];
            r[i] = rstd_of(tsum, 1.f / 512.f); }
#pragma unroll
        for (int i = 0; i < 16; ++i) { f32x4 a, b; a[0] = bflo(v[i][0]) * r[i]; a[1] = bfhi(v[i][0]) * r[i]; a[2] = bflo(v[i][1]) * r[i]; a[3] = bfhi(v[i][1]) * r[i]; b[0] = bflo(v[i][2]) * r[i]; b[1] = bfhi(v[i][2]) * r[i]; b[2] = bflo(v[i][3]) * r[i]; b[3] = bfhi(v[i][3]) * r[i];
            *((u32x4*)(H.zuq + (size_t)(t0 + wv * 16 + i) * ZUQ_LD + g * 512) + ln) = pack8(a, b); }
    }
    __syncthreads();
    SECT(8);
}


typedef short v4i16_t __attribute__((ext_vector_type(4)));
DI void gmlp_item(const Frame& F, const Half& H, int item) {
    const int c = item >> 3, g = item & 7, t0 = c * 128, d0 = g * 128, tid = F.tid;
    lptr VT = F.lds, WS = F.lds + 34816; LAS float* rv = (LAS float*)(F.lds + 69632);
    const float* ssv = (const float*)(F.ws + WS_SSV);
    SECT(20);
    u32x4 pk[4]; f32x4 w0[4], w1[4];
#pragma unroll
    for (int i = 0; i < 4; ++i) {
        const int v = tid + 512 * i, s = v >> 4, seg = v & 15;
        pk[i] = *(const u32x4*)(H.gv + (size_t)(t0 + s) * DM + d0 + seg * 8);
        const float* wp = F.in[I_GWS] + (size_t)(g * 128 + s) * 128 + seg * 8; w0[i] = *(const f32x4*)wp; w1[i] = *(const f32x4*)(wp + 4);
    }
    if (tid < 128) rv[tid] = rstd_of(ssv[H.row_base + t0 + tid], 1.f / 1024.f);
    __syncthreads();
#pragma unroll
    for (int i = 0; i < 4; ++i) {
        const int v = tid + 512 * i, s = v >> 4, seg = v & 15;
        *(LAS u32x4*)(VT + s * PT + seg * 16) = pk[i];
        const int t = s, s0 = seg * 8;
        f32x4 o0, o1;
#pragma unroll
        for (int e = 0; e < 4; ++e) { o0[e] = (s0 + e <= t) ? w0[i][e] * rv[s0 + e] : 0.f; o1[e] = (s0 + 4 + e <= t) ? w1[i][e] * rv[s0 + 4 + e] : 0.f; }
        *(LAS u32x4*)(WS + t * PT + s0 * 2) = pack8(o0, o1);
    }
    __syncthreads();
    SECT(21);
    const int w = F.wave, fr = F.lane & 15, fq = F.lane >> 4, mtb = (w & 3) * 2, ntb = (w >> 2) * 4;
    f32x4 acc[2][4];
#pragma unroll
    for (int i = 0; i < 2; ++i)
#pragma unroll
        for (int j = 0; j < 4; ++j) acc[i][j] = (f32x4){0.f, 0.f, 0.f, 0.f};
    const int nks = ntb ? 4 : 2;
    for (int ks = 0; ks < nks; ++ks) {
        bf16x8 xf[2], yf[4];
#pragma unroll
        for (int i = 0; i < 2; ++i) {
            const v4i16_t lo = __builtin_amdgcn_ds_read_tr16_b64_v4i16((LAS v4i16_t*)(VT + (ks * 32 + 8 * fq + (fr >> 2)) * PT + (16 * (mtb + i)) * 2 + 8 * (fr & 3)));
            const v4i16_t hi = __builtin_amdgcn_ds_read_tr16_b64_v4i16((LAS v4i16_t*)(VT + (ks * 32 + 8 * fq + 4 + (fr >> 2)) * PT + (16 * (mtb + i)) * 2 + 8 * (fr & 3)));
            xf[i] = __builtin_shufflevector(lo, hi, 0, 1, 2, 3, 4, 5, 6, 7); }
#pragma unroll
        for (int j = 0; j < 4; ++j) yf[j] = *(const LAS bf16x8*)(WS + (16 * (ntb + j) + fr) * PT + ks * 64 + fq * 16);
#pragma unroll
        for (int i = 0; i < 2; ++i)
#pragma unroll
            for (int j = 0; j < 4; ++j) acc[i][j] = MFMA16(xf[i], yf[j], acc[i][j]);
    }
    SECT(22);
#pragma unroll
    for (int j = 0; j < 4; ++j) {
        const int t = 16 * (ntb + j) + fr; const float bias = F.in[I_GBS][g * 128 + t];
#pragma unroll
        for (int i = 0; i < 2; ++i) {
            const int d = d0 + 16 * (mtb + i) + 4 * fq;
            const f32x4 gn = *(const f32x4*)(F.in[I_GVN] + d);
            bf16_t* up = H.zuq + (size_t)(t0 + t) * ZUQ_LD + 2048 + d;
            const u32x2 uv = *(const u32x2*)up;
            f32x4 y;
            y[0] = bflo(uv[0]) * (gn[0] * acc[i][j][0] + bias); y[1] = bfhi(uv[0]) * (gn[1] * acc[i][j][1] + bias);
            y[2] = bflo(uv[1]) * (gn[2] * acc[i][j][2] + bias); y[3] = bfhi(uv[1]) * (gn[3] * acc[i][j][3] + bias);
            *(u32x2*)up = pack4(y);
        }
    }
    __syncthreads();
    SECT(23);
}
DI void memattn_item(const Frame& F, const Half& H, int item) {
    const int h = item & 3, t0 = (item >> 2) * 128, tid = F.tid, w = F.wave, fr = F.lane & 15, fq = F.lane >> 4;
    lptr Ks = F.lds, VT = F.lds + 36864, Pw = F.lds + 70656 + w * 8448;
    const bf16_t* Kmem = (const bf16_t*)(F.ws + WS_KMEM) + (size_t)H.b * 256 * 256; const bf16_t* VmemT = (const bf16_t*)(F.ws + WS_VMEMT) + (size_t)H.b * 256 * 256;
#pragma unroll
    for (int i = 0; i < 4; ++i) {
        const int v = tid + 512 * i;
        { const int m = v >> 3, seg = v & 7; *(LAS u32x4*)(Ks + m * 144 + seg * 16) = *(const u32x4*)(Kmem + (size_t)m * 256 + h * 64 + seg * 8); }
        { const int d = v >> 5, seg = v & 31; *(LAS u32x4*)(VT + d * 528 + seg * 16) = *(const u32x4*)(VmemT + (size_t)(h * 64 + d) * 256 + seg * 8); }
    }
    __syncthreads();
    for (int sub = 0; sub < 1; ++sub) {
        const int tw = t0 + sub * 128 + w * 16;
        bf16_t* qrow = H.zuq + (size_t)(tw + fr) * ZUQ_LD + 3072 + h * 64;
        bf16x8 qf[2];
        qf[0] = *(const bf16x8*)(qrow + fq * 8); qf[1] = *(const bf16x8*)(qrow + 32 + fq * 8);
        f32x4 s[16];
#pragma unroll
        for (int i = 0; i < 16; ++i) { s[i] = (f32x4){0.f, 0.f, 0.f, 0.f};
#pragma unroll
            for (int ks = 0; ks < 2; ++ks) { const bf16x8 kf = *(const LAS bf16x8*)(Ks + (16 * i + fr) * 144 + ks * 64 + fq * 16); s[i] = MFMA16(kf, qf[ks], s[i]); } }
        float mx = -3.0e38f;
#pragma unroll
        for (int i = 0; i < 16; ++i) mx = fmaxf(mx, fmaxf(fmaxf(s[i][0], s[i][1]), fmaxf(s[i][2], s[i][3])));
        mx = fmaxf(mx, __shfl_xor(mx, 16)); mx = fmaxf(mx, __shfl_xor(mx, 32));
        float sum = 0.f;
#pragma unroll
        for (int i = 0; i < 16; ++i) { f32x4 p;
#pragma unroll
            for (int e = 0; e < 4; ++e) { p[e] = __builtin_amdgcn_exp2f(s[i][e] - mx); sum += p[e]; }
            *(LAS u32x2*)(Pw + fr * 528 + (16 * i + 4 * fq) * 2) = pack4(p); }
        sum += __shfl_xor(sum, 16); sum += __shfl_xor(sum, 32);
        LDS_WAIT(); __builtin_amdgcn_wave_barrier();
        f32x4 o[4];
#pragma unroll
        for (int i = 0; i < 4; ++i) o[i] = (f32x4){0.f, 0.f, 0.f, 0.f};
#pragma unroll
        for (int ks = 0; ks < 8; ++ks) { const bf16x8 pf = *(const LAS bf16x8*)(Pw + fr * 528 + ks * 64 + fq * 16);
#pragma unroll
            for (int i = 0; i < 4; ++i) { const bf16x8 vf = *(const LAS bf16x8*)(VT + (16 * i + fr) * 528 + ks * 64 + fq * 16); o[i] = MFMA16(vf, pf, o[i]); } }
        const float inv = __builtin_amdgcn_rcpf(sum);
#pragma unroll
        for (int i = 0; i < 4; ++i) *(u32x2*)(qrow + 16 * i + 4 * fq) = pack4(o[i] * inv);
        LDS_WAIT(); __builtin_amdgcn_wave_barrier();
    }
    __syncthreads();
}

#ifndef WGM_HALF
#define WGM_HALF 8
#endif
#define PH_GEMM(EpiT, Aptr, Bptr, Mm, Nn, Kk, Eobj) do { pg8::Gemm g_{(const bf16_t*)(Aptr), (const bf16_t*)(Bptr), Mm, Nn, Kk}; pg8::StaticOrder S_; S_.init(Mm, Nn, F.G, F.bid, (Mm) == TB ? WGM_HALF : 8); \
        pg8::gemm_phase<EpiT, pg8::StaticOrder, true, true>(F.lds, g_, S_, Eobj); } while (0)

__global__ void __launch_bounds__(512) mega_fwd(Args args) {
    extern __shared__ __attribute__((aligned(16))) unsigned char lds_raw[];
    cg::grid_group grid = cg::this_grid();
    Frame F; F.lds = (lptr)lds_raw; F.ws = args.ws; F.in = args.in; F.out = args.out;
    F.tid = threadIdx.x; F.lane = F.tid & 63; F.wave = __builtin_amdgcn_readfirstlane(F.tid >> 6); F.G = gridDim.x; F.bid = blockIdx.x;
    unsigned char* ws = args.ws;
    const int lo = args.ph_lo, hi = args.ph_hi;
    { volatile LAS unsigned* st_ = (volatile LAS unsigned*)(F.lds + LDS_BARST); if (F.tid < 2) st_[F.tid] = 0u; }
    __syncthreads();
    XcdBarrier xbar; xbar.bar = (unsigned*)(ws + WS_BAR); xbar.x = 0; xbar.st = nullptr;
    if (lo > hi) grid.sync();
    if (hi - lo > 1) xbar = xcd_barrier_post((unsigned*)(ws + WS_BAR), (volatile LAS unsigned*)(F.lds + LDS_BARST));
#define HB ((bf16_t*)(ws + WS_HB))
#define ACT ((bf16_t*)(ws + WS_ACT))
#define MG ((bf16_t*)(ws + WS_MG))
#define SS1 ((float*)(ws + WS_SS1))
#define SS2 ((float*)(ws + WS_SS2))
#define SS3 ((float*)(ws + WS_SS3))
#define SS4 ((float*)(ws + WS_SS4))
#ifndef PHMASK
#define PHMASK 0xFFFFFFFFu
#endif
#define RELAUNDER() do { int t_ = threadIdx.x; asm volatile("" : "+v"(t_)); F.tid = t_; F.lane = t_ & 63; F.wave = __builtin_amdgcn_readfirstlane(t_ >> 6); \
        unsigned long long w_ = (unsigned long long)args.ws; asm volatile("" : "+s"(w_)); ws = (unsigned char*)w_; F.ws = ws; } while (0)
#define IN(k) (((PHMASK >> ((k) > 8 ? (k) - 6 : (k))) & 1u) && lo <= (k) && (k) < hi)
#define SEAM(k) do { if ((k) + 1 < hi) { xcd_barrier(xbar); } } while (0)

    if (IN(0)) { RELAUNDER(); prologue(F); SEAM(0); }
    if (IN(1)) { RELAUNDER(); EpiGLU E{SS1, ACT}; PH_GEMM(EpiGLU, HB, ws + WS_W1GU, T, 2 * FF, DM, E);
        if (F.G >= 256) { if (F.bid >= 128) mid_convert(F, 128); } else mid_convert(F, 0);
        SEAM(1); }
    if (IN(2)) { RELAUNDER(); EpiRes<true> E{(const float*)nullptr, HB, HB, SS2, 0.5f}; PH_GEMM(EpiRes<true>, ACT, ws + WS_W1D, T, DM, FF, E); SEAM(2); }
#pragma unroll 1
    for (int b = 0; b < 2; ++b) {
        const int k0 = 3 + 6 * b;
#define MKHALF() Half H; H.b = b; H.zuq = (bf16_t*)(ws + WS_ZUQ); H.xbc = (bf16_t*)(ws + WS_XBC); H.gv = MG + (size_t)TB * DM; H.st = (bf16_t*)(ws + WS_ST); H.cdec = (float*)(ws + WS_CDEC) + b * 2048; H.dt = (const float*)(ws + WS_DT); H.row_base = b * TB;
        if (IN(k0)) { RELAUNDER(); MKHALF(); if (b == 1) { if (F.G >= 256) { if (F.bid >= 192) late_convert(F, 192); } else late_convert(F, 0); __syncthreads(); }
            EpiWin E{H.row_base, SS2, H.zuq, H.xbc, H.gv, (float*)(ws + WS_DT), F.in[I_DTB], (float*)(ws + WS_SSV)};
            PH_GEMM(EpiWin, HB + (size_t)H.row_base * DM, ws + WS_WIN, TB, NWIN, DM, E); SEAM(k0); }
        if (IN(k0 + 1)) { RELAUNDER(); MKHALF();
            for (int it = F.bid; it < 512; it += F.G) ssd_a_item(F, H, it);
            if (F.G != 256) { for (int it = F.bid; it < 512; it += F.G) gmlp_item(F, H, it); }
            if (F.G < 256) { for (int it = F.bid; it < 256; it += F.G) memattn_item(F, H, it); }
            SEAM(k0 + 1); }
        if (IN(k0 + 2)) { RELAUNDER(); MKHALF();
            if (F.G == 256) { if (F.bid < 64) ssd_scan<4>(F, H, 64); else for (int it = F.bid - 64; it < 512; it += F.G - 64) gmlp_item(F, H, it); }
            else { if (F.bid < 64) ssd_scan<4>(F, H, 64); }
            SEAM(k0 + 2); }
        if (IN(k0 + 3)) { RELAUNDER(); MKHALF(); for (int it = F.bid; it < 256; it += F.G) ssd_c_item(F, H, it); SEAM(k0 + 3); }
        if (IN(k0 + 4)) { RELAUNDER(); MKHALF(); if (F.G >= 256 && F.bid >= 128) { for (int it = F.bid - 128; it < 256; it += F.G - 128) memattn_item(F, H, it); }
            EpiGates E{H.row_base, SS2, H.xbc}; PH_GEMM(EpiGates, HB + (size_t)H.row_base * DM, ws + WS_WG, TB, GATE_LD, DM, E); SEAM(k0 + 4); }
        if (IN(k0 + 5)) { RELAUNDER(); MKHALF(); EpiMerge E{H.xbc, (bf16_t*)(ws + WS_ST), MG + (size_t)b * TB * DM};
            { pg8::Gemm g_{(const bf16_t*)H.zuq, (const bf16_t*)(ws + WS_WBR), TB, DM, KBR}; pg8::SegOrder<3> S_; S_.init(TB, 2 * DM, F.G, F.bid);     pg8::gemm_phase<EpiMerge, pg8::SegOrder<3>, true, true>(F.lds, g_, S_, E); } SEAM(k0 + 5); }
    }
    if (IN(15)) { RELAUNDER(); EpiRes<true> E{(const float*)nullptr, HB, HB, SS3, 1.0f}; PH_GEMM(EpiRes<true>, MG, ws + WS_WOUT, T, DM, DM, E); SEAM(15); }
    if (IN(16)) { RELAUNDER(); EpiGLU E{SS3, ACT}; PH_GEMM(EpiGLU, HB, ws + WS_W2GU, T, 2 * FF, DM, E); SEAM(16); }
    if (IN(17)) { RELAUNDER(); EpiResNorm E{HB, F.out, SS4, (unsigned*)(ws + WS_PCNT), F.in[I_FINN], 0.5f}; PH_GEMM(EpiResNorm, ACT, ws + WS_W2D, T, DM, FF, E); }
}

#ifndef N_PHASES
#define N_PHASES 18
#endif
#ifndef ONE_LAUNCH
#define ONE_LAUNCH 1
#endif
extern "C" void kernel_launch(void* const* d_in, const int* in_sizes, int n_in, void* d_out, int out_size, void* d_ws, size_t ws_size, hipStream_t stream) {
    static int grid = 0;
    if (grid == 0) {
        int dev = 0, cus = 0, per_cu = 0;
        hipGetDevice(&dev); hipDeviceGetAttribute(&cus, hipDeviceAttributeMultiprocessorCount, dev);
        if (hipFuncSetAttribute((const void*)mega_fwd, hipFuncAttributeMaxDynamicSharedMemorySize, LDS_BYTES) != hipSuccess) { fprintf(stderr, "kernel_launch: hipFuncSetAttribute failed\n"); grid = -1; return; }
        if (hipOccupancyMaxActiveBlocksPerMultiprocessor(&per_cu, (const void*)mega_fwd, 512, LDS_BYTES) != hipSuccess || per_cu < 1) { fprintf(stderr, "kernel_launch: occupancy query says %d\n", per_cu); per_cu = 1; }
        (void)hipGetLastError();
        grid = cus;
        if (n_in != 28 || ws_size < WS_END) { fprintf(stderr, "kernel_launch: unexpected n_in %d / ws %zu\n", n_in, ws_size); grid = -1; return; }
    }
    if (grid < 0) return;
    if (hipMemsetAsync((char*)d_ws + WS_BAR, 0, BAR_BYTES, stream) != hipSuccess) { fprintf(stderr, "kernel_launch: memset failed\n"); return; }
    Args a{};
    for (int i = 0; i < 28; ++i) a.in[i] = (const float*)d_in[i];
    a.out = (float*)d_out; a.ws = (unsigned char*)d_ws;
#if ONE_LAUNCH
    a.ph_lo = 0; a.ph_hi = N_PHASES;
    void* kargs[] = {&a};
    hipError_t e = hipLaunchCooperativeKernel((const void*)mega_fwd, dim3(grid), dim3(512), kargs, LDS_BYTES, stream);
    if (e != hipSuccess) fprintf(stderr, "cooperative launch failed: %s (grid %d)\n", hipGetErrorString(e), grid);
#else
    for (int k = 0; k < N_PHASES; ++k) { a.ph_lo = k; a.ph_hi = k + 1; hipLaunchKernelGGL(mega_fwd, dim3(grid), dim3(512), LDS_BYTES, stream, a); }
#endif
}
```
